# Optimizing an MI355X kernel written in HIP

```python
import math
import jax, jax.numpy as jnp
from jax import lax
import numpy as np

D_MODEL = 1024
BATCH = 8
SEQ = 2048
DEPTH = 4

N_MIXERS = 2
HEAD_DIM = 64
SWA_Q_HEADS = D_MODEL // HEAD_DIM
SWA_KV_HEADS = SWA_Q_HEADS // 4
SWA_GROUP = SWA_Q_HEADS // SWA_KV_HEADS
SWA_WINDOW = 128
FOX_HEADS = D_MODEL // HEAD_DIM
BLOCK = 128
ROPE_THETA = 500000.0
ROT_DIM = HEAD_DIM // 4
N_EXPERTS = 16
N_GROUPS = 4
EXPERTS_PER_GROUP = N_EXPERTS // N_GROUPS
TOP_K = 2
D_EXPERT = D_MODEL // 4
ALPHA = (2.0 * DEPTH) ** 0.25
BETA = (8.0 * DEPTH) ** -0.25
LN_EPS = 1e-5
NEG = -1e30
N_SWA_LAYERS = (DEPTH + 1) // 2
N_FOX_LAYERS = DEPTH // 2
SWA_IN = (SWA_Q_HEADS + 2 * SWA_KV_HEADS) * HEAD_DIM
FOX_IN = 3 * FOX_HEADS * HEAD_DIM + FOX_HEADS

kernel_name = "hybrid_swa_sink_fox_deepnorm_group_moe"


def layer_norm(x, gain, bias):
    xf = x.astype(jnp.float32)
    mu = jnp.mean(xf, axis=-1, keepdims=True)
    var = jnp.mean(jnp.square(xf - mu), axis=-1, keepdims=True)
    y = (xf - mu) * lax.rsqrt(var + LN_EPS)
    return (y * gain.astype(jnp.float32) + bias.astype(jnp.float32)).astype(x.dtype)


def partial_rope(x, pos):
    half = ROT_DIM // 2
    inv_freq = jnp.power(ROPE_THETA, -jnp.arange(half, dtype=jnp.float32) * (2.0 / ROT_DIM))
    ang = pos.astype(jnp.float32)[:, None] * inv_freq[None, :]
    cos = jnp.cos(ang)[None, :, None, :]
    sin = jnp.sin(ang)[None, :, None, :]
    xr = x[..., :ROT_DIM].astype(jnp.float32)
    x1, x2 = xr[..., :half], xr[..., half:]
    rot = jnp.concatenate([x1 * cos - x2 * sin, x2 * cos + x1 * sin], axis=-1).astype(x.dtype)
    return jnp.concatenate([rot, x[..., ROT_DIM:]], axis=-1)


def swa_sink_attention(x, w_in, sinks, w_o):
    B, S, _ = x.shape
    nb = S // BLOCK
    qd, kd = SWA_Q_HEADS * HEAD_DIM, SWA_KV_HEADS * HEAD_DIM
    proj = x @ w_in
    q = proj[..., :qd].reshape(B, S, SWA_Q_HEADS, HEAD_DIM)
    k = proj[..., qd:qd + kd].reshape(B, S, SWA_KV_HEADS, HEAD_DIM)
    v = proj[..., qd + kd:].reshape(B, S, SWA_KV_HEADS, HEAD_DIM)
    pos = jnp.arange(S)
    q = partial_rope(q, pos)
    k = partial_rope(k, pos)
    qb = q.reshape(B, nb, BLOCK, SWA_KV_HEADS, SWA_GROUP, HEAD_DIM)

    def with_prev(t):
        tb = t.reshape(B, nb, BLOCK, SWA_KV_HEADS, HEAD_DIM)
        prev = jnp.pad(tb, ((0, 0), (1, 0), (0, 0), (0, 0), (0, 0)))[:, :-1]
        return jnp.concatenate([prev, tb], axis=2)

    kk, vv = with_prev(k), with_prev(v)
    scores = jnp.einsum('bnqhgd,bnshd->bnhgqs', qb, kk).astype(jnp.float32) * (HEAD_DIM ** -0.5)
    q_pos = jnp.arange(nb)[:, None] * BLOCK + jnp.arange(BLOCK)[None, :]
    k_pos = jnp.arange(nb)[:, None] * BLOCK - BLOCK + jnp.arange(2 * BLOCK)[None, :]
    diff = q_pos[:, :, None] - k_pos[:, None, :]
    allowed = (diff >= 0) & (diff < SWA_WINDOW) & (k_pos[:, None, :] >= 0)
    scores = jnp.where(allowed[None, :, None, None], scores, NEG)
    sink = sinks.astype(jnp.float32).reshape(SWA_KV_HEADS, SWA_GROUP)
    sink_col = jnp.broadcast_to(sink[None, None, :, :, None, None], scores.shape[:-1] + (1,))
    probs = jax.nn.softmax(jnp.concatenate([scores, sink_col], axis=-1), axis=-1)[..., :-1]
    out = jnp.einsum('bnhgqs,bnshd->bnqhgd', probs.astype(vv.dtype), vv)
    return out.reshape(B, S, SWA_Q_HEADS * HEAD_DIM) @ w_o


def forgetting_attention(x, w_in, b_f, w_o):
    B, S, _ = x.shape
    hd_all = FOX_HEADS * HEAD_DIM
    proj = x @ w_in
    q = proj[..., :hd_all].reshape(B, S, FOX_HEADS, HEAD_DIM)
    k = proj[..., hd_all:2 * hd_all].reshape(B, S, FOX_HEADS, HEAD_DIM)
    v = proj[..., 2 * hd_all:3 * hd_all].reshape(B, S, FOX_HEADS, HEAD_DIM)
    f_logit = (proj[..., 3 * hd_all:] + b_f).astype(jnp.float32)
    c = jnp.cumsum(jax.nn.log_sigmoid(f_logit), axis=1).transpose(0, 2, 1)
    scale = HEAD_DIM ** -0.5
    outs = []
    for n in range(S // BLOCK):
        q0, end = n * BLOCK, (n + 1) * BLOCK
        s = jnp.einsum('bqhd,bkhd->bhqk', q[:, q0:end], k[:, :end]).astype(jnp.float32) * scale
        s = s + c[:, :, q0:end, None] - c[:, :, None, :end]
        causal = jnp.arange(q0, end)[:, None] >= jnp.arange(end)[None, :]
        p = jax.nn.softmax(jnp.where(causal, s, NEG), axis=-1)
        outs.append(jnp.einsum('bhqk,bkhd->bqhd', p.astype(v.dtype), v[:, :end]))
    out = jnp.concatenate(outs, axis=1).reshape(B, S, hd_all)
    return out @ w_o


def grouped_moe(h, w_router, b_router, w_gate, w_up, w_down):
    B, S, D = h.shape
    h2 = h.reshape(B * S, D)
    T = h2.shape[0]
    logits = (h2 @ w_router).astype(jnp.float32) + b_router.astype(jnp.float32)
    scores = jax.nn.softmax(logits, axis=-1)
    g = scores.reshape(T, N_GROUPS, EXPERTS_PER_GROUP)
    group_score = jnp.sum(lax.top_k(g, TOP_K)[0], axis=-1)
    best = jnp.argmax(group_score, axis=-1)
    in_group = jax.nn.one_hot(best, N_GROUPS, dtype=jnp.bool_)[:, :, None]
    masked = jnp.where(in_group, g, -1.0).reshape(T, N_EXPERTS)
    top_vals, top_idx = lax.top_k(masked, TOP_K)
    gates = top_vals / jnp.sum(top_vals, axis=-1, keepdims=True)
    gate_dense = jnp.sum(jax.nn.one_hot(top_idx, N_EXPERTS, dtype=jnp.float32) * gates[..., None], axis=1)
    hg = jnp.einsum('td,edf->tef', h2, w_gate)
    hu = jnp.einsum('td,edf->tef', h2, w_up)
    act = jax.nn.silu(hg) * hu * gate_dense[:, :, None].astype(h2.dtype)
    y = jnp.einsum('tef,efd->td', act, w_down)
    return y.reshape(B, S, D)


def setup_inputs(seed: int = 0) -> dict:
    key = jax.random.key(seed)
    ks = jax.random.split(key, 20)
    f32 = jnp.float32
    nrm = lambda k, shape, s: jax.random.normal(k, shape, f32) * s
    qk_cols_swa = (SWA_Q_HEADS + SWA_KV_HEADS) * HEAD_DIM
    v_cols_swa = SWA_KV_HEADS * HEAD_DIM
    swa_w_in = jnp.concatenate([
        nrm(ks[1], (N_SWA_LAYERS, D_MODEL, qk_cols_swa), D_MODEL ** -0.5),
        nrm(ks[2], (N_SWA_LAYERS, D_MODEL, v_cols_swa), D_MODEL ** -0.5 * BETA)], axis=-1)
    fox_hd = FOX_HEADS * HEAD_DIM
    fox_w_in = jnp.concatenate([
        nrm(ks[5], (N_FOX_LAYERS, D_MODEL, 2 * fox_hd), D_MODEL ** -0.5),
        nrm(ks[6], (N_FOX_LAYERS, D_MODEL, fox_hd), D_MODEL ** -0.5 * BETA),
        nrm(ks[7], (N_FOX_LAYERS, D_MODEL, FOX_HEADS), 0.5 * D_MODEL ** -0.5)], axis=-1)
    return {
        "x": jax.random.normal(ks[0], (BATCH, SEQ, D_MODEL), f32),
        "ln_gain": 1.0 + nrm(ks[3], (DEPTH, 2, D_MODEL), 0.02),
        "ln_bias": nrm(ks[4], (DEPTH, 2, D_MODEL), 0.02),
        "swa_w_in": swa_w_in,
        "swa_sinks": nrm(ks[8], (N_SWA_LAYERS, SWA_Q_HEADS), 0.5),
        "swa_w_o": nrm(ks[9], (N_SWA_LAYERS, SWA_Q_HEADS * HEAD_DIM, D_MODEL), (SWA_Q_HEADS * HEAD_DIM) ** -0.5 * BETA),
        "fox_w_in": fox_w_in,
        "fox_b_f": jax.random.uniform(ks[10], (N_FOX_LAYERS, FOX_HEADS), f32, 1.0, 6.0),
        "fox_w_o": nrm(ks[11], (N_FOX_LAYERS, fox_hd, D_MODEL), fox_hd ** -0.5 * BETA),
        "w_router": nrm(ks[12], (D_MODEL, N_EXPERTS), D_MODEL ** -0.5),
        "b_router": nrm(ks[13], (N_EXPERTS,), 0.01),
        "w_gate": nrm(ks[14], (DEPTH, N_EXPERTS, D_MODEL, D_EXPERT), D_MODEL ** -0.5),
        "w_up": nrm(ks[15], (DEPTH, N_EXPERTS, D_MODEL, D_EXPERT), D_MODEL ** -0.5),
        "w_down": nrm(ks[16], (DEPTH, N_EXPERTS, D_EXPERT, D_MODEL), D_EXPERT ** -0.5 * BETA),
    }


def reference(x, ln_gain, ln_bias, swa_w_in, swa_sinks, swa_w_o, fox_w_in, fox_b_f, fox_w_o,
              w_router, b_router, w_gate, w_up, w_down):
    for i in range(DEPTH):
        j = i // N_MIXERS
        if i % N_MIXERS == 0:
            mix = swa_sink_attention(x, swa_w_in[j], swa_sinks[j], swa_w_o[j])
        else:
            mix = forgetting_attention(x, fox_w_in[j], fox_b_f[j], fox_w_o[j])
        x = layer_norm(ALPHA * x + mix, ln_gain[i, 0], ln_bias[i, 0])
        ffn = grouped_moe(x, w_router, b_router, w_gate[i], w_up[i], w_down[i])
        x = layer_norm(ALPHA * x + ffn, ln_gain[i, 1], ln_bias[i, 1])
    return x
```

```cpp
#include <hip/hip_runtime.h>
#include <cstdio>
#include <cstdint>
#include <cmath>

#define GAS __attribute__((address_space(1)))
#define LAS __attribute__((address_space(3)))
typedef unsigned short bf16;
typedef short bf16x8 __attribute__((ext_vector_type(8)));
typedef float f32x4 __attribute__((ext_vector_type(4)));
typedef float f32x2 __attribute__((ext_vector_type(2)));
typedef unsigned u32x4 __attribute__((ext_vector_type(4)));
typedef unsigned u32x2 __attribute__((ext_vector_type(2)));
typedef GAS unsigned gu32;

#ifndef MK_ONE_LAUNCH
#define MK_ONE_LAUNCH 0
#endif

constexpr int M = 16384, D = 1024, S = 2048, NB = 8, DEPTH = 4, NE = 16, DE = 256, NCLS = 24;
constexpr int SWA_N = 1536, FOX_N = 3072, FOX_NALL = 3088;
constexpr float ALPHA = 1.6817928305074290f;
constexpr float LOG2E = 1.4426950408889634f;
constexpr float C2 = 0.125f * LOG2E;
constexpr float LN_EPS = 1e-5f;
constexpr int ACT_ROWS = 22528;

constexpr size_t MiB = 1u << 20;
constexpr size_t WS_CTL = 0, CTL_BYTES = 1 * MiB;
constexpr size_t WS_ROPE = 1 * MiB;
constexpr size_t WS_VEC = 2 * MiB;
constexpr size_t V_PROJ_CS = 0, V_PROJ_CB = 64 * 1024, V_RT_CS = 128 * 1024, V_RT_CB = 129 * 1024, V_GU_CS = 256 * 1024, V_GU_CB = 768 * 1024;
constexpr size_t WS_STATS = 4 * MiB;
constexpr size_t STATS_INST = (size_t)M * 8 * 4;
constexpr size_t WS_CLS = 8 * MiB;
constexpr size_t WS_GATES = 8 * MiB + 64 * 1024;
constexpr size_t WS_LIST = 8 * MiB + 256 * 1024;
constexpr size_t WS_LG = 10 * MiB;
constexpr size_t WS_CUM = 11 * MiB;
constexpr size_t WS_WIN_SWA = 12 * MiB;
constexpr size_t WS_WIN_FOX = 18 * MiB;
constexpr size_t WS_WF = 30 * MiB;
constexpr size_t WS_WR = 30 * MiB + 256 * 1024;
constexpr size_t WS_WO = 31 * MiB;
constexpr size_t WS_WGU = 39 * MiB;
constexpr size_t WS_WD = 103 * MiB;
constexpr size_t WS_Z = 135 * MiB;
constexpr size_t WS_Q = 167 * MiB, WS_K = 199 * MiB, WS_V = 231 * MiB;
constexpr size_t WS_ACT = 263 * MiB;
constexpr size_t WS_END = 285 * MiB;
constexpr int CW_TMO = 0, CW_CODE = 1, CW_BAR = 4096, CW_CNT = 16384;

constexpr int LDS_BYTES = 147456;
constexpr int MISC_OFF = 131072 + 320;
constexpr int NWAVES = 8;

#define RLX_AGENT __ATOMIC_RELAXED, __HIP_MEMORY_SCOPE_AGENT
#define LDS_WAIT() asm volatile("s_waitcnt lgkmcnt(0)" ::: "memory")
__device__ __forceinline__ float bf2f(bf16 v) { return __uint_as_float((unsigned)v << 16); }
__device__ __forceinline__ unsigned f2bf(float f) { unsigned u = __float_as_uint(f); return (u + 0x7fffu + ((u >> 16) & 1u)) >> 16; }
__device__ __forceinline__ unsigned pk2(float lo, float hi) { return f2bf(lo) | (f2bf(hi) << 16); }
__device__ __forceinline__ float wave_sum(float v) {
#pragma unroll
    for (int o = 1; o < 64; o <<= 1) v += __shfl_xor(v, o);
    return v;
}
__device__ __forceinline__ float wave_max(float v) {
#pragma unroll
    for (int o = 1; o < 64; o <<= 1) v = fmaxf(v, __shfl_xor(v, o));
    return v;
}
__device__ __forceinline__ f32x4 mfma16(bf16x8 a, bf16x8 b, f32x4 c) { return __builtin_amdgcn_mfma_f32_16x16x32_bf16(a, b, c, 0, 0, 0); }

#define XB_TMO      128
#define XB_XCNT(j)  (256  + 64 * (j))
#define XB_XSUB(j)  (1280 + 64 * (j))
#define XB_XGEN(j)  (2304 + 64 * (j))
#define XB_TOP      3328
#define XB_TOPGEN   3392
#define XCD_BAR_WORDS 3456
#define XB_SPIN_CAP (1u << 18)
__device__ __forceinline__ unsigned xb_ld(unsigned* p)              { return __hip_atomic_load(p, __ATOMIC_RELAXED, __HIP_MEMORY_SCOPE_AGENT); }
__device__ __forceinline__ unsigned xb_add(unsigned* p, unsigned v) { return __hip_atomic_fetch_add(p, v, __ATOMIC_RELAXED, __HIP_MEMORY_SCOPE_AGENT); }
__device__ __forceinline__ unsigned xb_xcc_id() { return (unsigned)__builtin_amdgcn_s_getreg((3 << 11) | 20) & 0xFu; }
#define XB_SPIN(cond, bar) do { unsigned _sp = 0; while (cond) { __builtin_amdgcn_s_sleep(1); \
    if ((++_sp & 255u) == 0u) { if (xb_ld(&(bar)[XB_TMO])) break; if (_sp > XB_SPIN_CAP) { atomicAdd(&(bar)[XB_TMO], 1u); break; } } } } while (0)
struct XcdBarrier { unsigned* bar; unsigned x; volatile LAS unsigned* st; };
__device__ __forceinline__ XcdBarrier xcd_barrier_post(unsigned* bar, volatile LAS unsigned* st) {
    XcdBarrier b; b.bar = bar; b.x = xb_xcc_id(); b.st = st;
    if (threadIdx.x == 0) (void)xb_add(&bar[XB_XCNT(b.x)], 1u);
    return b;
}
__device__ __forceinline__ void xcd_barrier_complete(unsigned* bar, unsigned x, unsigned& nloc, unsigned& nx) {
    const unsigned G = gridDim.x * gridDim.y * gridDim.z;
    unsigned sum, cnt, mine, sp = 0u;
    for (;;) {
        sum = 0u; cnt = 0u; mine = 0u;
#pragma unroll
        for (unsigned j = 0; j < 16; ++j) { const unsigned c = xb_ld(&bar[XB_XCNT(j)]); sum += c; cnt += (c > 0u) ? 1u : 0u; mine = (j == x) ? c : mine; }
        if (sum == G) break;
        __builtin_amdgcn_s_sleep(1);
        if ((++sp & 255u) == 0u) { if (xb_ld(&bar[XB_TMO])) break; if (sp > XB_SPIN_CAP) { atomicAdd(&bar[XB_TMO], 1u); break; } }
    }
    nloc = mine > 0u ? mine : 1u; nx = cnt > 0u ? cnt : 1u;
}
__device__ __forceinline__ void xcd_barrier(const XcdBarrier& b) {
    asm volatile("s_waitcnt vmcnt(0)" ::: "memory");
    __syncthreads();
    if (threadIdx.x == 0) {
        unsigned* bar = b.bar;
        __builtin_amdgcn_s_waitcnt(0);
        unsigned nloc = b.st[0], nx = b.st[1];
        if (nloc == 0u) { xcd_barrier_complete(bar, b.x, nloc, nx); b.st[0] = nloc; b.st[1] = nx; }
        const unsigned old = xb_add(&bar[XB_XSUB(b.x)], 1u);
        const unsigned gen = old / nloc;
        if (old + 1u == (gen + 1u) * nloc) {
            __builtin_amdgcn_fence(__ATOMIC_RELEASE, "agent");
            asm volatile("s_waitcnt vmcnt(0)" ::: "memory");
            const unsigned og = xb_add(&bar[XB_TOP], 1u);
            const unsigned tg = og / nx;
            if (og + 1u == (tg + 1u) * nx) xb_add(&bar[XB_TOPGEN], 1u);
            else XB_SPIN(xb_ld(&bar[XB_TOPGEN]) == tg, bar);
            __builtin_amdgcn_fence(__ATOMIC_ACQUIRE, "agent");
            xb_add(&bar[XB_XGEN(b.x)], 1u);
            asm volatile("s_waitcnt vmcnt(0)" ::: "memory");
        } else {
            XB_SPIN(xb_ld(&bar[XB_XGEN(b.x)]) == gen, bar);
            __builtin_amdgcn_fence(__ATOMIC_ACQUIRE, "agent");
            asm volatile("s_waitcnt vmcnt(0)" ::: "memory");
        }
    }
    __syncthreads();
}

struct Args { const float* in[14]; float* out; unsigned char* ws; int ph_lo, ph_hi; };
struct Ctx {
    const float *x, *ln_g, *ln_b, *swa_w_in, *swa_sinks, *swa_w_o, *fox_w_in, *fox_b_f, *fox_w_o, *w_router, *b_router, *w_gate, *w_up, *w_down;
    float* out; unsigned char* ws;
    LAS unsigned char* lds;
    int tid, lane, wave, wg, nwg, gw, ngw;
    __device__ __forceinline__ bf16* Z() const { return (bf16*)(ws + WS_Z); }
    __device__ __forceinline__ bf16* Q() const { return (bf16*)(ws + WS_Q); }
    __device__ __forceinline__ bf16* Kb() const { return (bf16*)(ws + WS_K); }
    __device__ __forceinline__ bf16* Vb() const { return (bf16*)(ws + WS_V); }
    __device__ __forceinline__ bf16* ACT() const { return (bf16*)(ws + WS_ACT); }
    __device__ __forceinline__ float* stats(int inst) const { return (float*)(ws + WS_STATS + (size_t)inst * STATS_INST); }
    __device__ __forceinline__ float* vec(size_t off) const { return (float*)(ws + WS_VEC + off); }
    __device__ __forceinline__ unsigned* ctl() const { return (unsigned*)(ws + WS_CTL); }
    __device__ __forceinline__ int* cls() const { return (int*)(ws + WS_CLS); }
    __device__ __forceinline__ f32x2* gates() const { return (f32x2*)(ws + WS_GATES); }
    __device__ __forceinline__ int* list() const { return (int*)(ws + WS_LIST); }
};
__device__ __forceinline__ f32x2 row_stats(const float* st, int r) {
    if (!st) return (f32x2){0.f, 1.f};
    const f32x4 a = *(const f32x4*)(st + (size_t)r * 8), b = *(const f32x4*)(st + (size_t)r * 8 + 4);
    const float s = (a[0] + a[2]) + (b[0] + b[2]), q = (a[1] + a[3]) + (b[1] + b[3]);
    const float mu = s * (1.f / D), var = fmaxf(q * (1.f / D) - mu * mu, 0.f);
    return (f32x2){mu, 1.0f / sqrtf(var + LN_EPS)};
}
__device__ __forceinline__ void cls_experts(int c, int& e1, int& e2) {
    const int g = c / 6, p = c % 6;
    const int lo = p < 3 ? 0 : (p < 5 ? 1 : 2), hi = p < 3 ? p + 1 : (p < 5 ? p - 1 : 3);
    e1 = 4 * g + lo; e2 = 4 * g + hi;
}

struct CvtItem { const float* src; int K, N, n0, ncols; bf16* dst; int dpitch; const float* g; const float* b; float* cs; float* cb; };
__device__ __forceinline__ void cvt_item(const CvtItem& it, LAS float* scr, int lane) {
    float cs[4] = {0.f, 0.f, 0.f, 0.f}, cb[4] = {0.f, 0.f, 0.f, 0.f};
    const int c = lane & 7, nb = lane >> 3, ncol = lane & 31; const bool colok = ncol < it.ncols;
    for (int k0 = 0; k0 < it.K; k0 += 64) {
#pragma unroll 8
        for (int i = 0; i < 32; ++i) { const int kk = 2 * i + (lane >> 5); scr[kk * 33 + ncol] = colok ? it.src[(size_t)(k0 + kk) * it.N + it.n0 + ncol] : 0.f; }
        LDS_WAIT(); asm volatile("" ::: "memory");
        float gq[8], bq[8];
#pragma unroll
        for (int q = 0; q < 8; ++q) { gq[q] = it.g ? it.g[k0 + 8 * c + q] : 1.f; bq[q] = it.b ? it.b[k0 + 8 * c + q] : 0.f; }
#pragma unroll
        for (int j = 0; j < 4; ++j) {
            const int n = nb + 8 * j; const LAS float* s = scr + (8 * c) * 33 + n;
            unsigned r[8]; float csp = 0.f, cbp = 0.f;
#pragma unroll
            for (int q = 0; q < 8; ++q) { const float w = s[q * 33]; r[q] = f2bf(w * gq[q]); csp += __uint_as_float(r[q] << 16); cbp += w * bq[q]; }
            cs[j] += csp; cb[j] += cbp;
            if (n < it.ncols) { u32x4 o; o.x = r[0] | (r[1] << 16); o.y = r[2] | (r[3] << 16); o.z = r[4] | (r[5] << 16); o.w = r[6] | (r[7] << 16);
                *(u32x4*)(it.dst + (size_t)n * it.dpitch + k0 + 8 * c) = o; }
        }
        LDS_WAIT(); asm volatile("" ::: "memory");
    }
    if (it.cs) {
#pragma unroll
        for (int j = 0; j < 4; ++j) {
            float a = cs[j], b = cb[j];
            a += __shfl_xor(a, 1); a += __shfl_xor(a, 2); a += __shfl_xor(a, 4);
            b += __shfl_xor(b, 1); b += __shfl_xor(b, 2); b += __shfl_xor(b, 4);
            const int n = nb + 8 * j;
            if (c == 0 && n < it.ncols) { it.cs[n] = a; it.cb[n] = b; }
        }
    }
}
__device__ __forceinline__ CvtItem big_item(const Ctx& C, int idx) {
    CvtItem it; it.K = 1024; it.dpitch = 1024; it.ncols = 32; it.g = nullptr; it.b = nullptr; it.cs = nullptr; it.cb = nullptr;
    if (idx < 1024) {
        const int i = idx >> 8, e = (idx >> 4) & 15, gu = (idx >> 3) & 1, blk = idx & 7;
        it.src = (gu ? C.w_up : C.w_gate) + (size_t)(i * 16 + e) * 1024 * 256; it.N = 256; it.n0 = blk * 32;
        const int row = (it.n0 >> 7) * 256 + gu * 128 + (it.n0 & 127);
        it.dst = (bf16*)(C.ws + WS_WGU) + ((size_t)(i * 16 + e) * 512 + row) * 1024;
        it.g = C.ln_g + (i * 2 + 0) * 1024; it.b = C.ln_b + (i * 2 + 0) * 1024;
        it.cs = C.vec(V_GU_CS) + (i * 16 + e) * 512 + row; it.cb = C.vec(V_GU_CB) + (i * 16 + e) * 512 + row;
        return it; }
    idx -= 1024;
    if (idx < 194) {
        const int j = idx / 97, blk = idx % 97, i = 2 * j + 1;
        it.src = C.fox_w_in + (size_t)j * 1024 * FOX_NALL; it.N = FOX_NALL; it.n0 = blk * 32; it.ncols = blk < 96 ? 32 : 16;
        it.dst = blk < 96 ? (bf16*)(C.ws + WS_WIN_FOX) + ((size_t)j * FOX_N + it.n0) * 1024 : (bf16*)(C.ws + WS_WF) + (size_t)j * 16 * 1024;
        it.g = C.ln_g + ((i - 1) * 2 + 1) * 1024; it.b = C.ln_b + ((i - 1) * 2 + 1) * 1024;
        it.cs = C.vec(V_PROJ_CS) + i * FOX_NALL + it.n0; it.cb = C.vec(V_PROJ_CB) + i * FOX_NALL + it.n0;
        return it; }
    idx -= 194;
    if (idx < 96) {
        const int j = idx / 48, blk = idx % 48, i = 2 * j;
        it.src = C.swa_w_in + (size_t)j * 1024 * SWA_N; it.N = SWA_N; it.n0 = blk * 32;
        it.dst = (bf16*)(C.ws + WS_WIN_SWA) + ((size_t)j * SWA_N + it.n0) * 1024;
        if (i > 0) { it.g = C.ln_g + ((i - 1) * 2 + 1) * 1024; it.b = C.ln_b + ((i - 1) * 2 + 1) * 1024; }
        it.cs = C.vec(V_PROJ_CS) + i * FOX_NALL + it.n0; it.cb = C.vec(V_PROJ_CB) + i * FOX_NALL + it.n0;
        return it; }
    idx -= 96;
    if (idx < 128) {
        const int i = idx >> 5, blk = idx & 31, j = i >> 1;
        it.src = ((i & 1) ? C.fox_w_o : C.swa_w_o) + (size_t)j * 1024 * 1024; it.N = 1024; it.n0 = blk * 32;
        it.dst = (bf16*)(C.ws + WS_WO) + ((size_t)i * 1024 + it.n0) * 1024;
        return it; }
    idx -= 128;
    { const int i = idx; it.src = C.w_router; it.N = 16; it.n0 = 0; it.ncols = 16;
      it.dst = (bf16*)(C.ws + WS_WR) + (size_t)i * 16 * 1024;
      it.g = C.ln_g + (i * 2 + 0) * 1024; it.b = C.ln_b + (i * 2 + 0) * 1024;
      it.cs = C.vec(V_RT_CS) + i * 16; it.cb = C.vec(V_RT_CB) + i * 16; }
    return it;
}
constexpr int N_BIG = 1024 + 194 + 96 + 128 + 4;
__device__ __forceinline__ CvtItem small_item(const Ctx& C, int q) {
    CvtItem it; const int i = q >> 9, e = (q >> 5) & 15, blk = q & 31;
    it.src = C.w_down + (size_t)(i * 16 + e) * 256 * 1024; it.K = 256; it.N = 1024; it.n0 = blk * 32; it.ncols = 32;
    it.dst = (bf16*)(C.ws + WS_WD) + ((size_t)(i * 16 + e) * 1024 + it.n0) * 256; it.dpitch = 256;
    it.g = nullptr; it.b = nullptr; it.cs = nullptr; it.cb = nullptr; return it;
}
__device__ __forceinline__ void p_prologue(const Ctx& C) {
    LAS float* scr = (LAS float*)(C.lds + C.wave * 8704);
    for (int sl = C.gw; sl < N_BIG + 512; sl += C.ngw) {
        if (sl < N_BIG) { const CvtItem it = big_item(C, sl); cvt_item(it, scr, C.lane); }
        else { for (int u = 0; u < 4; ++u) { const CvtItem it = small_item(C, (sl - N_BIG) * 4 + u); cvt_item(it, scr, C.lane); } }
    }
    { const int nth = C.nwg * 512, gt = C.wg * 512 + C.tid; bf16* Z = C.Z();
      for (int i = gt; i < M * D / 8; i += nth) { const f32x4 a = *(const f32x4*)(C.x + (size_t)i * 8), b = *(const f32x4*)(C.x + (size_t)i * 8 + 4);
          u32x4 o; o.x = pk2(a[0], a[1]); o.y = pk2(a[2], a[3]); o.z = pk2(b[0], b[1]); o.w = pk2(b[2], b[3]); *(u32x4*)(Z + (size_t)i * 8) = o; } }
    { const int nth = C.nwg * 512, gt = C.wg * 512 + C.tid; float* T = (float*)(C.ws + WS_ROPE);
      for (int i = gt; i < S * 8; i += nth) { const int pos = i >> 3, j = i & 7; const double inv = pow(500000.0, -(double)j / 8.0), ang = (double)pos * inv;
          T[i] = (float)cos(ang); T[S * 8 + i] = (float)sin(ang); } }
}

template <bool DUAL, int K, class Setup, class AF, class BF, class EP>
__device__ __forceinline__ void sgemm(int gw, int ngw, int Mt, int Nt, Setup setup, AF af, BF bf, EP ep) {
    const int lane = threadIdx.x & 63, lr = lane & 15, lq = lane >> 4;
    for (int t = gw; t < Mt * Nt; t += ngw) {
        const int tm = t / Nt, tn = t % Nt, r0 = tm * 32, c0 = tn * 32;
        const auto tc = setup(tm, tn);
        f32x4 acc[2][2], acc2[2][2];
#pragma unroll
        for (int i = 0; i < 2; ++i)
#pragma unroll
            for (int j = 0; j < 2; ++j) { acc[i][j] = (f32x4){0.f, 0.f, 0.f, 0.f}; acc2[i][j] = (f32x4){0.f, 0.f, 0.f, 0.f}; }
        const bf16* ap[2]; ap[0] = af(tc, r0 + lr) + 8 * lq; ap[1] = af(tc, r0 + 16 + lr) + 8 * lq;
#pragma unroll 4
        for (int k0 = 0; k0 < K; k0 += 32) {
            bf16x8 a[2], b[2], b2[2];
#pragma unroll
            for (int i = 0; i < 2; ++i) a[i] = *(const bf16x8*)(ap[i] + k0);
#pragma unroll
            for (int j = 0; j < 2; ++j) { b[j] = *(const bf16x8*)bf(tc, c0 + 16 * j + lr, k0 + 8 * lq, 0); if (DUAL) b2[j] = *(const bf16x8*)bf(tc, c0 + 16 * j + lr, k0 + 8 * lq, 1); }
#pragma unroll
            for (int i = 0; i < 2; ++i)
#pragma unroll
                for (int j = 0; j < 2; ++j) { acc[i][j] = mfma16(a[i], b[j], acc[i][j]); if (DUAL) acc2[i][j] = mfma16(a[i], b2[j], acc2[i][j]); }
        }
#pragma unroll
        for (int i = 0; i < 2; ++i)
#pragma unroll
            for (int j = 0; j < 2; ++j)
#pragma unroll
                for (int rg = 0; rg < 4; ++rg) ep(tc, r0 + 16 * i + 4 * lq + rg, c0 + 16 * j + lr, acc[i][j][rg], acc2[i][j][rg]);
    }
}
struct NoTile {};
__device__ __forceinline__ f32x4 thin16(const bf16* Zr, int r0, const bf16* WT, int lane) {
    f32x4 acc = (f32x4){0.f, 0.f, 0.f, 0.f};
    const bf16* ap = Zr + (size_t)(r0 + (lane & 15)) * D + 8 * (lane >> 4); const bf16* bp = WT + (size_t)(lane & 15) * D + 8 * (lane >> 4);
#pragma unroll 8
    for (int k0 = 0; k0 < D; k0 += 32) acc = mfma16(*(const bf16x8*)(ap + k0), *(const bf16x8*)(bp + k0), acc);
    return acc;
}

__device__ __forceinline__ void p_proj(const Ctx& C, int layer) {
    const int j = layer >> 1; const bool fox = layer & 1;
    const float* st = layer ? C.stats(2 * (layer - 1) + 1) : nullptr;
    const float* cs = C.vec(V_PROJ_CS) + layer * FOX_NALL; const float* cb = C.vec(V_PROJ_CB) + layer * FOX_NALL;
    const bf16* Z = C.Z(); bf16 *Q = C.Q(), *Kp = C.Kb(), *Vp = C.Vb();
    const bf16* W = fox ? (const bf16*)(C.ws + WS_WIN_FOX) + (size_t)j * FOX_N * 1024 : (const bf16*)(C.ws + WS_WIN_SWA) + (size_t)j * SWA_N * 1024;
    const int N = fox ? FOX_N : SWA_N;
    sgemm<false, 1024>(C.gw, C.ngw, M / 32, N / 32,
        [](int, int) { return NoTile{}; },
        [=](NoTile, int r) { return Z + (size_t)r * D; },
        [=](NoTile, int n, int k, int) { return W + (size_t)n * D + k; },
        [=](NoTile, int r, int c, float v, float) {
            const f32x2 ms = row_stats(st, r); const float x = ms.y * (v - ms.x * cs[c]) + cb[c];
            if (fox) { const int t = c >> 10, cc = c & 1023; bf16* dst = Q + (size_t)t * ((WS_K - WS_Q) / 2); dst[(size_t)r * 1024 + cc] = (bf16)f2bf(t == 0 ? x * C2 : x); }
            else { if (c < 1024) Q[(size_t)r * 1024 + c] = (bf16)f2bf(x * C2); else if (c < 1280) Kp[(size_t)r * 256 + c - 1024] = (bf16)f2bf(x); else Vp[(size_t)r * 256 + c - 1280] = (bf16)f2bf(x); }
        });
    if (fox) {
        const bf16* WF = (const bf16*)(C.ws + WS_WF) + (size_t)j * 16 * 1024; float* LG = (float*)(C.ws + WS_LG);
        const int lr = C.lane & 15, lq = C.lane >> 4;
        for (int t = C.gw; t < M / 16; t += C.ngw) {
            const int r0 = t * 16; const f32x4 acc = thin16(Z, r0, WF, C.lane);
            const float bf_ = C.fox_b_f[j * 16 + lr], csv = cs[FOX_N + lr], cbv = cb[FOX_N + lr];
            f32x4 o;
#pragma unroll
            for (int rg = 0; rg < 4; ++rg) { const int r = r0 + 4 * lq + rg; const f32x2 ms = row_stats(st, r);
                const float xg = ms.y * (acc[rg] - ms.x * csv) + cbv + bf_;
                o[rg] = fminf(xg, 0.f) - log1pf(expf(-fabsf(xg))); }
            const int b = r0 / S, s = (r0 % S) + 4 * lq;
            *(f32x4*)(LG + (size_t)(b * 16 + lr) * S + s) = o;
        }
    }
}
__device__ __forceinline__ void p_rope_or_scan(const Ctx& C, int layer) {
    if (!(layer & 1)) {
        const float* T = (const float*)(C.ws + WS_ROPE); bf16 *Q = C.Q(), *Kp = C.Kb();
        const int nth = C.nwg * 512, gt = C.wg * 512 + C.tid;
        for (int i = gt; i < M * 20 * 8; i += nth) { const int jj = i & 7, hs = (i >> 3) % 20, r = i / 160, pos = r % S;
            bf16* p = hs < 16 ? Q + (size_t)r * 1024 + hs * 64 + jj : Kp + (size_t)r * 256 + (hs - 16) * 64 + jj;
            const float x1 = bf2f(p[0]), x2 = bf2f(p[8]), cs = T[pos * 8 + jj], sn = T[S * 8 + pos * 8 + jj];
            p[0] = (bf16)f2bf(x1 * cs - x2 * sn); p[8] = (bf16)f2bf(x2 * cs + x1 * sn); }
    } else {
        const float* LG = (const float*)(C.ws + WS_LG); float* CU = (float*)(C.ws + WS_CUM);
        for (int bh = C.gw; bh < NB * 16; bh += C.ngw) {
            double carry = 0.0;
            for (int ch = 0; ch < S / 64; ++ch) { double v = (double)LG[(size_t)bh * S + ch * 64 + C.lane];
#pragma unroll
                for (int o = 1; o < 64; o <<= 1) { const double u = __shfl_up(v, o); if (C.lane >= o) v += u; }
                v += carry; CU[(size_t)bh * S + ch * 64 + C.lane] = (float)(v * (double)LOG2E); carry = __shfl(v, 63); }
        }
    }
}
__device__ __forceinline__ void p_attn(const Ctx& C, int layer) {
    const int j = layer >> 1; bf16* Q = C.Q(); const bf16 *Kp = C.Kb(), *Vp = C.Vb(); const int lane = C.lane;
    if (!(layer & 1)) {
        for (int t = C.gw; t < M * 16; t += C.ngw) {
            const int r = t >> 4, h = t & 15, kh = h >> 2, b = r / S, pos = r % S;
            float q[64];
#pragma unroll
            for (int d0 = 0; d0 < 8; ++d0) { const bf16x8 v = *(const bf16x8*)(Q + (size_t)r * 1024 + h * 64 + d0 * 8);
#pragma unroll
                for (int e = 0; e < 8; ++e) q[d0 * 8 + e] = bf2f((bf16)v[e]); }
            float sc[2]; int srow[2];
#pragma unroll
            for (int u = 0; u < 2; ++u) { const int s = pos - 127 + 64 * u + lane; srow[u] = b * S + (s < 0 ? 0 : s); float a = 0.f;
#pragma unroll
                for (int d0 = 0; d0 < 8; ++d0) { const bf16x8 v = *(const bf16x8*)(Kp + (size_t)srow[u] * 256 + kh * 64 + d0 * 8);
#pragma unroll
                    for (int e = 0; e < 8; ++e) a += q[d0 * 8 + e] * bf2f((bf16)v[e]); }
                sc[u] = s < 0 ? -INFINITY : a; }
            const float sink2 = C.swa_sinks[j * 16 + h] * LOG2E;
            const float m = fmaxf(wave_max(fmaxf(sc[0], sc[1])), sink2);
            const float p0 = exp2f(sc[0] - m), p1 = exp2f(sc[1] - m);
            const float l = wave_sum(p0 + p1) + exp2f(sink2 - m);
            float o = 0.f;
            for (int i = 0; i < 64; ++i) { const float pa = __shfl(p0, i), pb = __shfl(p1, i); const int ra = __shfl(srow[0], i), rb = __shfl(srow[1], i);
                o += pa * bf2f(Vp[(size_t)ra * 256 + kh * 64 + lane]) + pb * bf2f(Vp[(size_t)rb * 256 + kh * 64 + lane]); }
            Q[(size_t)r * 1024 + h * 64 + lane] = (bf16)f2bf(o / l);
        }
    } else {
        const float* CU = (const float*)(C.ws + WS_CUM); LAS float* sc = (LAS float*)(C.lds + C.wave * 8192);
        for (int t = C.gw; t < M * 16; t += C.ngw) {
            const int r = t >> 4, h = t & 15, b = r / S, pos = r % S, nk = pos + 1; const float* cu = CU + (size_t)(b * 16 + h) * S;
            float q[64];
#pragma unroll
            for (int d0 = 0; d0 < 8; ++d0) { const bf16x8 v = *(const bf16x8*)(Q + (size_t)r * 1024 + h * 64 + d0 * 8);
#pragma unroll
                for (int e = 0; e < 8; ++e) q[d0 * 8 + e] = bf2f((bf16)v[e]); }
            const float ct = cu[pos]; float mx = -INFINITY;
            for (int s = lane; s < nk; s += 64) { float a = 0.f;
#pragma unroll
                for (int d0 = 0; d0 < 8; ++d0) { const bf16x8 v = *(const bf16x8*)(Kp + (size_t)(b * S + s) * 1024 + h * 64 + d0 * 8);
#pragma unroll
                    for (int e = 0; e < 8; ++e) a += q[d0 * 8 + e] * bf2f((bf16)v[e]); }
                a += ct - cu[s]; sc[s] = a; mx = fmaxf(mx, a); }
            const float m = wave_max(mx); float sum = 0.f;
            for (int s = lane; s < nk; s += 64) { const float p = exp2f(sc[s] - m); sc[s] = p; sum += p; }
            const float l = wave_sum(sum);
            LDS_WAIT(); asm volatile("" ::: "memory");
            float o = 0.f; const bf16* vp = Vp + (size_t)(b * S) * 1024 + h * 64 + lane;
            int s = 0;
            for (; s + 4 <= nk; s += 4) { const float v0 = bf2f(vp[(size_t)s * 1024]), v1 = bf2f(vp[(size_t)(s + 1) * 1024]), v2 = bf2f(vp[(size_t)(s + 2) * 1024]), v3 = bf2f(vp[(size_t)(s + 3) * 1024]);
                o += sc[s] * v0; o += sc[s + 1] * v1; o += sc[s + 2] * v2; o += sc[s + 3] * v3; }
            for (; s < nk; ++s) o += sc[s] * bf2f(vp[(size_t)s * 1024]);
            Q[(size_t)r * 1024 + h * 64 + lane] = (bf16)f2bf(o / l);
            LDS_WAIT(); asm volatile("" ::: "memory");
        }
    }
}
__device__ __forceinline__ void p_oproj(const Ctx& C, int layer) {
    const float* stp = layer ? C.stats(2 * (layer - 1) + 1) : nullptr;
    const float* gp = layer ? C.ln_g + ((layer - 1) * 2 + 1) * 1024 : nullptr; const float* bp = layer ? C.ln_b + ((layer - 1) * 2 + 1) * 1024 : nullptr;
    const bf16* O = C.Q(); bf16* Z = C.Z(); const bf16* W = (const bf16*)(C.ws + WS_WO) + (size_t)layer * 1024 * 1024;
    sgemm<false, 1024>(C.gw, C.ngw, M / 32, D / 32,
        [](int, int) { return NoTile{}; },
        [=](NoTile, int r) { return O + (size_t)r * D; },
        [=](NoTile, int n, int k, int) { return W + (size_t)n * D + k; },
        [=](NoTile, int r, int c, float v, float) {
            const f32x2 ms = row_stats(stp, r); const float zb = bf2f(Z[(size_t)r * D + c]);
            const float xin = gp ? (zb - ms.x) * ms.y * gp[c] + bp[c] : zb;
            Z[(size_t)r * D + c] = (bf16)f2bf(ALPHA * xin + v);
        });
}
__device__ __forceinline__ void p_stats(const Ctx& C, int inst) {
    const bf16* Z = C.Z(); float* st = C.stats(inst);
    for (int r = C.gw; r < M; r += C.ngw) {
        const bf16x8 a = *(const bf16x8*)(Z + (size_t)r * D + C.lane * 16), b = *(const bf16x8*)(Z + (size_t)r * D + C.lane * 16 + 8);
        float s = 0.f, q = 0.f;
#pragma unroll
        for (int e = 0; e < 8; ++e) { const float x = bf2f((bf16)a[e]), y = bf2f((bf16)b[e]); s += x + y; q += x * x + y * y; }
        s = wave_sum(s); q = wave_sum(q);
        if (C.lane == 0) { *(f32x4*)(st + (size_t)r * 8) = (f32x4){s, q, 0.f, 0.f}; *(f32x4*)(st + (size_t)r * 8 + 4) = (f32x4){0.f, 0.f, 0.f, 0.f}; }
    }
}
__device__ __forceinline__ void p_router(const Ctx& C, int layer) {
    const float* st = C.stats(2 * layer); const bf16* Z = C.Z(); const bf16* WR = (const bf16*)(C.ws + WS_WR) + (size_t)layer * 16 * 1024;
    const float* cs = C.vec(V_RT_CS) + layer * 16; const float* cb = C.vec(V_RT_CB) + layer * 16;
    LAS float* lg = (LAS float*)(C.lds + C.wave * 1280);
    LAS int* hist = (LAS int*)(C.lds + 16384); LAS int* base = hist + 32;
    unsigned* gcnt = C.ctl() + CW_CNT + 32 * layer; int* cls_o = C.cls(); f32x2* gates = C.gates(); int* list = C.list();
    const int lane = C.lane, lr = lane & 15, lq = lane >> 4;
    for (int blk = C.wg; blk < M / 64; blk += C.nwg) {
        if (C.tid < 32) hist[C.tid] = 0;
        __syncthreads();
        int tok = -1, cl = 0, lslot = 0;
        if (C.wave < 4) {
            const int r0 = blk * 64 + C.wave * 16; const f32x4 acc = thin16(Z, r0, WR, lane);
            const float csv = cs[lr], cbv = cb[lr] + C.b_router[lr];
#pragma unroll
            for (int rg = 0; rg < 4; ++rg) { const int row = 4 * lq + rg; const f32x2 ms = row_stats(st, r0 + row); lg[row * 17 + lr] = ms.y * (acc[rg] - ms.x * csv) + cbv; }
            LDS_WAIT(); asm volatile("" ::: "memory");
            if (lane < 16) {
                float l[16], mx = -INFINITY;
#pragma unroll
                for (int e = 0; e < 16; ++e) { l[e] = lg[lane * 17 + e]; mx = fmaxf(mx, l[e]); }
#pragma unroll
                for (int e = 0; e < 16; ++e) l[e] = expf(l[e] - mx);
                float gs[4];
#pragma unroll
                for (int g = 0; g < 4; ++g) { const float a0 = l[4 * g], a1 = l[4 * g + 1], a2 = l[4 * g + 2], a3 = l[4 * g + 3];
                    gs[g] = fmaxf(fmaxf(fmaxf(a0 + a1, a0 + a2), fmaxf(a0 + a3, a1 + a2)), fmaxf(a1 + a3, a2 + a3)); }
                int best = 0; float bv = gs[0];
#pragma unroll
                for (int g = 1; g < 4; ++g) if (gs[g] > bv) { bv = gs[g]; best = g; }
                float a[4];
#pragma unroll
                for (int k = 0; k < 4; ++k) a[k] = best == 0 ? l[k] : (best == 1 ? l[4 + k] : (best == 2 ? l[8 + k] : l[12 + k]));
                int i1 = 0; float v1 = a[0];
#pragma unroll
                for (int k = 1; k < 4; ++k) if (a[k] > v1) { v1 = a[k]; i1 = k; }
                int i2 = -1; float v2 = -1.f;
#pragma unroll
                for (int k = 0; k < 4; ++k) if (k != i1 && a[k] > v2) { v2 = a[k]; i2 = k; }
                const int lo = i1 < i2 ? i1 : i2, hi = i1 < i2 ? i2 : i1;
                const int pidx = lo == 0 ? hi - 1 : (lo == 1 ? hi + 1 : 5);
                const float inv = 1.f / (v1 + v2), g1 = v1 * inv, g2 = v2 * inv;
                cl = best * 6 + pidx; tok = r0 + lane;
                cls_o[tok] = cl; gates[tok] = i1 < i2 ? (f32x2){g1, g2} : (f32x2){g2, g1};
                lslot = atomicAdd((int*)(hist + cl), 1);
            }
        }
        __syncthreads();
        if (C.tid < NCLS) base[C.tid] = (int)atomicAdd(gcnt + C.tid, (unsigned)hist[C.tid]);
        __syncthreads();
        if (tok >= 0) list[cl * M + base[cl] + lslot] = tok;
        __syncthreads();
    }
}
struct ClsTile { int c, base, cnt, e1, e2; };
__device__ __forceinline__ int cls_layout(const Ctx& C, int layer, LAS int* cbase  , LAS int* ccnt  ) {
    if (C.tid == 0) { const unsigned* gcnt = C.ctl() + CW_CNT + 32 * layer; int acc = 0;
        for (int c = 0; c < NCLS; ++c) { const int n = (int)__hip_atomic_load(gcnt + c, RLX_AGENT); cbase[c] = acc; ccnt[c] = n; acc += (n + 255) & ~255; }
        cbase[NCLS] = acc; }
    __syncthreads();
    return cbase[NCLS];
}
__device__ __forceinline__ ClsTile find_cls(const LAS int* cbase, const LAS int* ccnt, int R0) {
    ClsTile t; t.c = 0;
    for (int c = 1; c < NCLS; ++c) if (R0 >= cbase[c]) t.c = c;
    t.base = cbase[t.c]; t.cnt = ccnt[t.c]; cls_experts(t.c, t.e1, t.e2); return t;
}
__device__ __forceinline__ void p_moe_up(const Ctx& C, int layer) {
    LAS int* cbase = (LAS int*)(C.lds + 32768); LAS int* ccnt = cbase + 32;
    const int rows = cls_layout(C, layer, cbase, ccnt);
    const float* st = C.stats(2 * layer); const bf16* Z = C.Z(); bf16* ACT = C.ACT(); const int* list = C.list(); const f32x2* gates = C.gates();
    const bf16* WGU = (const bf16*)(C.ws + WS_WGU) + (size_t)layer * 16 * 512 * 1024;
    const float* gcs = C.vec(V_GU_CS) + layer * 16 * 512; const float* gcb = C.vec(V_GU_CB) + layer * 16 * 512;
    sgemm<true, 1024>(C.gw, C.ngw, rows / 32, 512 / 32,
        [=](int tm, int) { return find_cls(cbase, ccnt, tm * 32); },
        [=](const ClsTile& t, int R) { const int li = R - t.base; const int tok = list[t.c * M + (li < t.cnt ? li : 0)]; return Z + (size_t)tok * D; },
        [=](const ClsTile& t, int n, int k, int which) { const int e = (n >> 8) ? t.e2 : t.e1, f = n & 255; return WGU + ((size_t)e * 512 + (f >> 7) * 256 + which * 128 + (f & 127)) * D + k; },
        [=](const ClsTile& t, int R, int n, float vg, float vu) {
            const int li = R - t.base; const bool valid = li < t.cnt; const int tok = list[t.c * M + (valid ? li : 0)];
            const int wh = n >> 8, e = wh ? t.e2 : t.e1, f = n & 255, row = (f >> 7) * 256 + (f & 127);
            const f32x2 ms = row_stats(st, tok);
            const float hg = ms.y * (vg - ms.x * gcs[e * 512 + row]) + gcb[e * 512 + row], hu = ms.y * (vu - ms.x * gcs[e * 512 + row + 128]) + gcb[e * 512 + row + 128];
            const f32x2 gt = gates[tok]; const float gate = wh ? gt.y : gt.x;
            const float act = valid ? hg / (1.f + expf(-hg)) * hu * gate : 0.f;
            ACT[(size_t)R * 512 + n] = (bf16)f2bf(act);
        });
}
__device__ __forceinline__ void p_moe_down(const Ctx& C, int layer) {
    LAS int* cbase = (LAS int*)(C.lds + 32768); LAS int* ccnt = cbase + 32;
    const int rows = cls_layout(C, layer, cbase, ccnt);
    const float* st = C.stats(2 * layer); const float* g1 = C.ln_g + (layer * 2) * 1024; const float* b1 = C.ln_b + (layer * 2) * 1024;
    bf16* Z = C.Z(); const bf16* ACT = C.ACT(); const int* list = C.list();
    const bf16* WD = (const bf16*)(C.ws + WS_WD) + (size_t)layer * 16 * 1024 * 256;
    sgemm<false, 512>(C.gw, C.ngw, rows / 32, D / 32,
        [=](int tm, int) { return find_cls(cbase, ccnt, tm * 32); },
        [=](const ClsTile&, int R) { return ACT + (size_t)R * 512; },
        [=](const ClsTile& t, int n, int k, int) { return WD + ((size_t)(k < 256 ? t.e1 : t.e2) * 1024 + n) * 256 + (k & 255); },
        [=](const ClsTile& t, int R, int n, float v, float) {
            const int li = R - t.base; if (li >= t.cnt) return; const int tok = list[t.c * M + li];
            const f32x2 ms = row_stats(st, tok); const float zb = bf2f(Z[(size_t)tok * D + n]);
            const float x1 = (zb - ms.x) * ms.y * g1[n] + b1[n];
            Z[(size_t)tok * D + n] = (bf16)f2bf(ALPHA * x1 + v);
        });
}
__device__ __forceinline__ void p_final(const Ctx& C) {
    const float* st = C.stats(7); const float* g = C.ln_g + 7 * 1024; const float* b = C.ln_b + 7 * 1024; const bf16* Z = C.Z();
    for (int r = C.gw; r < M; r += C.ngw) {
        const f32x2 ms = row_stats(st, r);
#pragma unroll
        for (int u = 0; u < 2; ++u) { const int c0 = u * 512 + C.lane * 8; const bf16x8 a = *(const bf16x8*)(Z + (size_t)r * D + c0);
            const f32x4 g0 = *(const f32x4*)(g + c0), g1 = *(const f32x4*)(g + c0 + 4), b0 = *(const f32x4*)(b + c0), b1 = *(const f32x4*)(b + c0 + 4);
            f32x4 o0, o1;
#pragma unroll
            for (int e = 0; e < 4; ++e) { o0[e] = (bf2f((bf16)a[e]) - ms.x) * ms.y * g0[e] + b0[e]; o1[e] = (bf2f((bf16)a[4 + e]) - ms.x) * ms.y * g1[e] + b1[e]; }
            *(f32x4*)(C.out + (size_t)r * D + c0) = o0; *(f32x4*)(C.out + (size_t)r * D + c0 + 4) = o1; }
    }
}

constexpr int PH_PER_LAYER = 9, N_PHASES = 1 + DEPTH * PH_PER_LAYER + 1;
__global__ void __launch_bounds__(NWAVES * 64, 2) mk_fwd(Args args) {
    extern __shared__ __attribute__((aligned(16))) unsigned char lds_raw[];
    const int tid0 = threadIdx.x;
#define BUILD_CTX(C, zo) Ctx C; C.x = args.in[0] + zo; C.ln_g = args.in[1] + zo; C.ln_b = args.in[2] + zo; C.swa_w_in = args.in[3] + zo; C.swa_sinks = args.in[4] + zo; C.swa_w_o = args.in[5] + zo; C.fox_w_in = args.in[6] + zo; \
    C.fox_b_f = args.in[7] + zo; C.fox_w_o = args.in[8] + zo; C.w_router = args.in[9] + zo; C.b_router = args.in[10] + zo; C.w_gate = args.in[11] + zo; C.w_up = args.in[12] + zo; C.w_down = args.in[13] + zo; \
    C.out = args.out + zo; C.ws = args.ws + zo; C.lds = (LAS unsigned char*)lds_raw; \
    C.tid = tidv; C.lane = C.tid & 63; C.wave = __builtin_amdgcn_readfirstlane(C.tid >> 6); C.wg = blockIdx.x; C.nwg = gridDim.x; C.gw = C.wg * NWAVES + C.wave; C.ngw = C.nwg * NWAVES;
    LAS unsigned char* const lds0 = (LAS unsigned char*)lds_raw;
    volatile LAS unsigned* MISC = (volatile LAS unsigned*)(lds0 + MISC_OFF);
    if (tid0 < 32) MISC[tid0] = 0u;
    __syncthreads();
    unsigned* const ctl0 = (unsigned*)(args.ws + WS_CTL);
    XcdBarrier bar; bar.bar = ctl0 + CW_BAR; bar.x = 0; bar.st = nullptr;
    const bool one = (args.ph_hi - args.ph_lo) > 1;
    if (one) bar = xcd_barrier_post(ctl0 + CW_BAR, MISC + 8);
    for (int ph = args.ph_lo; ph < args.ph_hi; ++ph) {
#define RUN(body) do { long zo = 0; int tidv = threadIdx.x; asm volatile("" : "+s"(zo), "+v"(tidv)); BUILD_CTX(C, zo) body; } while (0)
        if (ph == 0) RUN(p_prologue(C));
        else if (ph == N_PHASES - 1) RUN(p_final(C));
        else {
            const int layer = (ph - 1) / PH_PER_LAYER, sub = (ph - 1) % PH_PER_LAYER;
            switch (sub) {
                case 0: RUN(p_proj(C, layer)); break;
                case 1: RUN(p_rope_or_scan(C, layer)); break;
                case 2: RUN(p_attn(C, layer)); break;
                case 3: RUN(p_oproj(C, layer)); break;
                case 4: RUN(p_stats(C, 2 * layer)); break;
                case 5: RUN(p_router(C, layer)); break;
                case 6: RUN(p_moe_up(C, layer)); break;
                case 7: RUN(p_moe_down(C, layer)); break;
                default: RUN(p_stats(C, 2 * layer + 1)); break;
            }
        }
        if (ph + 1 < args.ph_hi) xcd_barrier(bar);
    }
}

extern "C" void kernel_launch(void* const* d_in, const int* in_sizes, int n_in, void* d_out, int out_size, void* d_ws, size_t ws_size, hipStream_t stream) {
    static int grid = 0;
    if (grid == 0) {
        if (n_in != 14 || in_sizes[0] != M * D || out_size != M * D || ws_size < WS_END) { fprintf(stderr, "kernel_launch: unexpected shapes / workspace (n_in %d, ws %zu)\n", n_in, ws_size); grid = -1; return; }
        int dev = 0, cus = 0, per_cu = 0;
        if (hipGetDevice(&dev) != hipSuccess || hipDeviceGetAttribute(&cus, hipDeviceAttributeMultiprocessorCount, dev) != hipSuccess) { grid = -1; return; }
        if (hipFuncSetAttribute((const void*)mk_fwd, hipFuncAttributeMaxDynamicSharedMemorySize, LDS_BYTES) != hipSuccess) { fprintf(stderr, "kernel_launch: hipFuncSetAttribute failed\n"); grid = -1; return; }
        if (hipOccupancyMaxActiveBlocksPerMultiprocessor(&per_cu, (const void*)mk_fwd, NWAVES * 64, LDS_BYTES) != hipSuccess || per_cu < 1) { fprintf(stderr, "kernel_launch: occupancy query says %d\n", per_cu); per_cu = 1; }
        (void)hipGetLastError();
        grid = cus * 1;
    }
    if (grid < 0) return;
    (void)hipMemsetAsync((char*)d_ws + WS_CTL, 0, CTL_BYTES, stream);
    Args a{};
    for (int i = 0; i < 14; ++i) a.in[i] = (const float*)d_in[i];
    a.out = (float*)d_out; a.ws = (unsigned char*)d_ws;
#if MK_ONE_LAUNCH
    a.ph_lo = 0; a.ph_hi = N_PHASES;
    hipLaunchKernelGGL(mk_fwd, dim3(grid), dim3(NWAVES * 64), LDS_BYTES, stream, a);
#else
    for (int ph = 0; ph < N_PHASES; ++ph) { a.ph_lo = ph; a.ph_hi = ph + 1; hipLaunchKernelGGL(mk_fwd, dim3(grid), dim3(NWAVES * 64), LDS_BYTES, stream, a); }
#endif
}
```

```cpp
#include <hip/hip_runtime.h>
#include <cstdio>
#include <cstdint>
#include <cmath>

#define GAS __attribute__((address_space(1)))
#define LAS __attribute__((address_space(3)))
typedef unsigned short bf16;
typedef short bf16x8 __attribute__((ext_vector_type(8)));
typedef float f32x4 __attribute__((ext_vector_type(4)));
typedef float f32x2 __attribute__((ext_vector_type(2)));
typedef unsigned u32x4 __attribute__((ext_vector_type(4)));
typedef unsigned u32x2 __attribute__((ext_vector_type(2)));
typedef GAS unsigned gu32;

#ifndef MK_ONE_LAUNCH
#define MK_ONE_LAUNCH 1
#endif

constexpr int M = 16384, D = 1024, S = 2048, NB = 8, DEPTH = 4, NE = 16, DE = 256, NCLS = 24;
constexpr int SWA_N = 1536, FOX_N = 3072, FOX_NALL = 3088;
constexpr float ALPHA = 1.6817928305074290f;
constexpr float LOG2E = 1.4426950408889634f;
constexpr float C2 = 0.125f * LOG2E;
constexpr float LN_EPS = 1e-5f;
constexpr int ACT_ROWS = 22528;

constexpr size_t MiB = 1u << 20;
constexpr size_t WS_CTL = 0, CTL_BYTES = 1 * MiB;
constexpr size_t WS_ROPE = 1 * MiB;
constexpr size_t WS_VEC = 2 * MiB;
constexpr size_t V_PROJ_CS = 0, V_PROJ_CB = 64 * 1024, V_RT_CS = 128 * 1024, V_RT_CB = 129 * 1024, V_GU_CS = 256 * 1024, V_GU_CB = 768 * 1024;
constexpr size_t WS_STATS = 4 * MiB;
constexpr size_t STATS_INST = (size_t)M * 8 * 4;
constexpr size_t WS_CLS = 8 * MiB;
constexpr size_t WS_GATES = 8 * MiB + 64 * 1024;
constexpr size_t WS_LIST = 8 * MiB + 256 * 1024;
constexpr size_t WS_LG = 10 * MiB;
constexpr size_t WS_CUM = 11 * MiB;
constexpr size_t WS_WIN_SWA = 12 * MiB;
constexpr size_t WS_WIN_FOX = 18 * MiB;
constexpr size_t WS_WF = 30 * MiB;
constexpr size_t WS_WR = 30 * MiB + 256 * 1024;
constexpr size_t WS_WO = 31 * MiB;
constexpr size_t WS_WGU = 39 * MiB;
constexpr size_t WS_WD = 103 * MiB;
constexpr size_t WS_Z = 135 * MiB;
constexpr size_t WS_Q = 167 * MiB, WS_K = 199 * MiB, WS_V = 231 * MiB;
constexpr size_t WS_ACT = 263 * MiB;
constexpr size_t WS_END = 285 * MiB;
constexpr int CW_TMO = 0, CW_CODE = 1, CW_BAR = 4096, CW_CNT = 16384;

constexpr int LDS_BYTES = 147456;
constexpr int MISC_OFF = 131072 + 320;
constexpr int NWAVES = 8;

#define RLX_AGENT __ATOMIC_RELAXED, __HIP_MEMORY_SCOPE_AGENT
#define LDS_WAIT() asm volatile("s_waitcnt lgkmcnt(0)" ::: "memory")
__device__ __forceinline__ float bf2f(bf16 v) { return __uint_as_float((unsigned)v << 16); }
__device__ __forceinline__ unsigned f2bf(float f) { unsigned u = __float_as_uint(f); return (u + 0x7fffu + ((u >> 16) & 1u)) >> 16; }
__device__ __forceinline__ unsigned pk2(float lo, float hi) { return f2bf(lo) | (f2bf(hi) << 16); }
__device__ __forceinline__ float wave_sum(float v) {
#pragma unroll
    for (int o = 1; o < 64; o <<= 1) v += __shfl_xor(v, o);
    return v;
}
__device__ __forceinline__ float wave_max(float v) {
#pragma unroll
    for (int o = 1; o < 64; o <<= 1) v = fmaxf(v, __shfl_xor(v, o));
    return v;
}
__device__ __forceinline__ f32x4 mfma16(bf16x8 a, bf16x8 b, f32x4 c) { return __builtin_amdgcn_mfma_f32_16x16x32_bf16(a, b, c, 0, 0, 0); }

#define XB_TMO      128
#define XB_XCNT(j)  (256  + 64 * (j))
#define XB_XSUB(j)  (1280 + 64 * (j))
#define XB_XGEN(j)  (2304 + 64 * (j))
#define XB_TOP      3328
#define XB_TOPGEN   3392
#define XCD_BAR_WORDS 3456
#define XB_SPIN_CAP (1u << 18)
__device__ __forceinline__ unsigned xb_ld(unsigned* p)              { return __hip_atomic_load(p, __ATOMIC_RELAXED, __HIP_MEMORY_SCOPE_AGENT); }
__device__ __forceinline__ unsigned xb_add(unsigned* p, unsigned v) { return __hip_atomic_fetch_add(p, v, __ATOMIC_RELAXED, __HIP_MEMORY_SCOPE_AGENT); }
__device__ __forceinline__ unsigned xb_xcc_id() { return (unsigned)__builtin_amdgcn_s_getreg((3 << 11) | 20) & 0xFu; }
#define XB_SPIN(cond, bar) do { unsigned _sp = 0; while (cond) { __builtin_amdgcn_s_sleep(1); \
    if ((++_sp & 255u) == 0u) { if (xb_ld(&(bar)[XB_TMO])) break; if (_sp > XB_SPIN_CAP) { atomicAdd(&(bar)[XB_TMO], 1u); break; } } } } while (0)
struct XcdBarrier { unsigned* bar; unsigned x; volatile LAS unsigned* st; };
__device__ __forceinline__ XcdBarrier xcd_barrier_post(unsigned* bar, volatile LAS unsigned* st, int tid) {
    XcdBarrier b; b.bar = bar; b.x = xb_xcc_id(); b.st = st;
    if (tid == 0) (void)xb_add(&bar[XB_XCNT(b.x)], 1u);
    return b;
}
__device__ __forceinline__ void xcd_barrier_complete(unsigned* bar, unsigned x, unsigned& nloc, unsigned& nx) {
    const unsigned G = gridDim.x * gridDim.y * gridDim.z;
    unsigned sum, cnt, mine, sp = 0u;
    for (;;) {
        sum = 0u; cnt = 0u; mine = 0u;
        asm volatile("" : "+s"(bar), "+s"(x));
#pragma unroll
        for (unsigned j = 0; j < 16; ++j) { const unsigned c = xb_ld(&bar[XB_XCNT(j)]); sum += c; cnt += (c > 0u) ? 1u : 0u; mine = (j == x) ? c : mine; }
        if (sum == G) break;
        __builtin_amdgcn_s_sleep(1);
        if ((++sp & 255u) == 0u) { if (xb_ld(&bar[XB_TMO])) break; if (sp > XB_SPIN_CAP) { atomicAdd(&bar[XB_TMO], 1u); break; } }
    }
    nloc = mine > 0u ? mine : 1u; nx = cnt > 0u ? cnt : 1u;
}
__device__ __forceinline__ void xcd_barrier(const XcdBarrier& b, int tid) {
    asm volatile("s_waitcnt vmcnt(0)" ::: "memory");
    __syncthreads();
    if (tid == 0) {
        unsigned* bar = b.bar;
        __builtin_amdgcn_s_waitcnt(0);
        unsigned nloc = b.st[0], nx = b.st[1];
        if (nloc == 0u) { xcd_barrier_complete(bar, b.x, nloc, nx); b.st[0] = nloc; b.st[1] = nx; }
        const unsigned old = xb_add(&bar[XB_XSUB(b.x)], 1u);
        const unsigned gen = old / nloc;
        if (old + 1u == (gen + 1u) * nloc) {
            __builtin_amdgcn_fence(__ATOMIC_RELEASE, "agent");
            asm volatile("s_waitcnt vmcnt(0)" ::: "memory");
            const unsigned og = xb_add(&bar[XB_TOP], 1u);
            const unsigned tg = og / nx;
            if (og + 1u == (tg + 1u) * nx) xb_add(&bar[XB_TOPGEN], 1u);
            else XB_SPIN(xb_ld(&bar[XB_TOPGEN]) == tg, bar);
            __builtin_amdgcn_fence(__ATOMIC_ACQUIRE, "agent");
            xb_add(&bar[XB_XGEN(b.x)], 1u);
            asm volatile("s_waitcnt vmcnt(0)" ::: "memory");
        } else {
            XB_SPIN(xb_ld(&bar[XB_XGEN(b.x)]) == gen, bar);
            __builtin_amdgcn_fence(__ATOMIC_ACQUIRE, "agent");
            asm volatile("s_waitcnt vmcnt(0)" ::: "memory");
        }
    }
    __syncthreads();
}

struct Args { const float* in[14]; float* out; unsigned char* ws; int ph_lo, ph_hi; };
struct Ctx {
    const float *x, *ln_g, *ln_b, *swa_w_in, *swa_sinks, *swa_w_o, *fox_w_in, *fox_b_f, *fox_w_o, *w_router, *b_router, *w_gate, *w_up, *w_down;
    float* out; unsigned char* ws;
    LAS unsigned char* lds; char* ldsg;
    int tid, lane, wave, wg, nwg, gw, ngw;
    __device__ __forceinline__ bf16* Z() const { return (bf16*)(ws + WS_Z); }
    __device__ __forceinline__ bf16* Q() const { return (bf16*)(ws + WS_Q); }
    __device__ __forceinline__ bf16* Kb() const { return (bf16*)(ws + WS_K); }
    __device__ __forceinline__ bf16* Vb() const { return (bf16*)(ws + WS_V); }
    __device__ __forceinline__ bf16* ACT() const { return (bf16*)(ws + WS_ACT); }
    __device__ __forceinline__ float* stats(int inst) const { return (float*)(ws + WS_STATS + (size_t)inst * STATS_INST); }
    __device__ __forceinline__ float* vec(size_t off) const { return (float*)(ws + WS_VEC + off); }
    __device__ __forceinline__ unsigned* ctl() const { return (unsigned*)(ws + WS_CTL); }
    __device__ __forceinline__ int* cls() const { return (int*)(ws + WS_CLS); }
    __device__ __forceinline__ f32x2* gates() const { return (f32x2*)(ws + WS_GATES); }
    __device__ __forceinline__ int* list() const { return (int*)(ws + WS_LIST); }
};
__device__ __forceinline__ f32x2 row_stats(const float* st, int r) {
    if (!st) return (f32x2){0.f, 1.f};
    const f32x4 a = *(const f32x4*)(st + (size_t)r * 8), b = *(const f32x4*)(st + (size_t)r * 8 + 4);
    const float s = (a[0] + a[2]) + (b[0] + b[2]), q = (a[1] + a[3]) + (b[1] + b[3]);
    const float mu = s * (1.f / D), var = fmaxf(q * (1.f / D) - mu * mu, 0.f);
    return (f32x2){mu, 1.0f / sqrtf(var + LN_EPS)};
}
__device__ __forceinline__ void cls_experts(int c, int& e1, int& e2) {
    const int g = c / 6, p = c % 6;
    const int lo = p < 3 ? 0 : (p < 5 ? 1 : 2), hi = p < 3 ? p + 1 : (p < 5 ? p - 1 : 3);
    e1 = 4 * g + lo; e2 = 4 * g + hi;
}

__constant__ double ROPE_W[16] = {0.5403023058681397174, 0.8414709848078965067, 0.9812558362840285743, 0.1927095839820420340, 0.9992929765482185140, 0.0375971677311151056,
    0.9999734086383661963, 0.007292600096474082358, 0.9999990000001666667, 0.001414213090968621398, 0.9999999623939693048, 0.0002742481722384122054,
    0.9999999985857864380, 0.00005318295894437919888, 0.9999999999468170410, 0.00001031338537702962674};
struct CvtItem { const float* src; int K, N, n0, ncols; bf16* dst; int dpitch; const float* g; const float* b; float* cs; float* cb; };
__device__ __forceinline__ void cvt_item(const CvtItem& it, LAS float* scr, int lane) {
    float cs[4] = {0.f, 0.f, 0.f, 0.f}, cb[4] = {0.f, 0.f, 0.f, 0.f};
    const int c = lane & 7, nb = lane >> 3, ncol = lane & 31; const bool colok = ncol < it.ncols;
    for (int k0 = 0; k0 < it.K; k0 += 64) {
#pragma unroll 8
        for (int i = 0; i < 32; ++i) { const int kk = 2 * i + (lane >> 5); scr[kk * 33 + ncol] = colok ? it.src[(size_t)(k0 + kk) * it.N + it.n0 + ncol] : 0.f; }
        LDS_WAIT(); asm volatile("" ::: "memory");
        float gq[8], bq[8];
#pragma unroll
        for (int q = 0; q < 8; ++q) { gq[q] = it.g ? it.g[k0 + 8 * c + q] : 1.f; bq[q] = it.b ? it.b[k0 + 8 * c + q] : 0.f; }
#pragma unroll
        for (int j = 0; j < 4; ++j) {
            const int n = nb + 8 * j; const LAS float* s = scr + (8 * c) * 33 + n;
            unsigned r[8]; float csp = 0.f, cbp = 0.f;
#pragma unroll
            for (int q = 0; q < 8; ++q) { const float w = s[q * 33]; r[q] = f2bf(w * gq[q]); csp += __uint_as_float(r[q] << 16); cbp += w * bq[q]; }
            cs[j] += csp; cb[j] += cbp;
            if (n < it.ncols) { u32x4 o; o.x = r[0] | (r[1] << 16); o.y = r[2] | (r[3] << 16); o.z = r[4] | (r[5] << 16); o.w = r[6] | (r[7] << 16);
                *(u32x4*)(it.dst + (size_t)n * it.dpitch + k0 + 8 * c) = o; }
        }
        LDS_WAIT(); asm volatile("" ::: "memory");
    }
    if (it.cs) {
#pragma unroll
        for (int j = 0; j < 4; ++j) {
            float a = cs[j], b = cb[j];
            a += __shfl_xor(a, 1); a += __shfl_xor(a, 2); a += __shfl_xor(a, 4);
            b += __shfl_xor(b, 1); b += __shfl_xor(b, 2); b += __shfl_xor(b, 4);
            const int n = nb + 8 * j;
            if (c == 0 && n < it.ncols) { it.cs[n] = a; it.cb[n] = b; }
        }
    }
}
__device__ __forceinline__ CvtItem big_item(const Ctx& C, int idx) {
    CvtItem it; it.K = 1024; it.dpitch = 1024; it.ncols = 32; it.g = nullptr; it.b = nullptr; it.cs = nullptr; it.cb = nullptr;
    if (idx < 1024) {
        const int i = idx >> 8, e = (idx >> 4) & 15, gu = (idx >> 3) & 1, blk = idx & 7;
        it.src = (gu ? C.w_up : C.w_gate) + (size_t)(i * 16 + e) * 1024 * 256; it.N = 256; it.n0 = blk * 32;
        const int row = (it.n0 >> 7) * 256 + gu * 128 + (it.n0 & 127);
        it.dst = (bf16*)(C.ws + WS_WGU) + ((size_t)(i * 16 + e) * 512 + row) * 1024;
        it.g = C.ln_g + (i * 2 + 0) * 1024; it.b = C.ln_b + (i * 2 + 0) * 1024;
        it.cs = C.vec(V_GU_CS) + (i * 16 + e) * 512 + row; it.cb = C.vec(V_GU_CB) + (i * 16 + e) * 512 + row;
        return it; }
    idx -= 1024;
    if (idx < 194) {
        const int j = idx / 97, blk = idx % 97, i = 2 * j + 1;
        it.src = C.fox_w_in + (size_t)j * 1024 * FOX_NALL; it.N = FOX_NALL; it.n0 = blk * 32; it.ncols = blk < 96 ? 32 : 16;
        it.dst = blk < 96 ? (bf16*)(C.ws + WS_WIN_FOX) + ((size_t)j * FOX_N + it.n0) * 1024 : (bf16*)(C.ws + WS_WF) + (size_t)j * 16 * 1024;
        it.g = C.ln_g + ((i - 1) * 2 + 1) * 1024; it.b = C.ln_b + ((i - 1) * 2 + 1) * 1024;
        it.cs = C.vec(V_PROJ_CS) + i * FOX_NALL + it.n0; it.cb = C.vec(V_PROJ_CB) + i * FOX_NALL + it.n0;
        return it; }
    idx -= 194;
    if (idx < 96) {
        const int j = idx / 48, blk = idx % 48, i = 2 * j;
        it.src = C.swa_w_in + (size_t)j * 1024 * SWA_N; it.N = SWA_N; it.n0 = blk * 32;
        it.dst = (bf16*)(C.ws + WS_WIN_SWA) + ((size_t)j * SWA_N + it.n0) * 1024;
        if (i > 0) { it.g = C.ln_g + ((i - 1) * 2 + 1) * 1024; it.b = C.ln_b + ((i - 1) * 2 + 1) * 1024; }
        it.cs = C.vec(V_PROJ_CS) + i * FOX_NALL + it.n0; it.cb = C.vec(V_PROJ_CB) + i * FOX_NALL + it.n0;
        return it; }
    idx -= 96;
    if (idx < 128) {
        const int i = idx >> 5, blk = idx & 31, j = i >> 1;
        it.src = ((i & 1) ? C.fox_w_o : C.swa_w_o) + (size_t)j * 1024 * 1024; it.N = 1024; it.n0 = blk * 32;
        it.dst = (bf16*)(C.ws + WS_WO) + ((size_t)i * 1024 + it.n0) * 1024;
        return it; }
    idx -= 128;
    { const int i = idx; it.src = C.w_router; it.N = 16; it.n0 = 0; it.ncols = 16;
      it.dst = (bf16*)(C.ws + WS_WR) + (size_t)i * 16 * 1024;
      it.g = C.ln_g + (i * 2 + 0) * 1024; it.b = C.ln_b + (i * 2 + 0) * 1024;
      it.cs = C.vec(V_RT_CS) + i * 16; it.cb = C.vec(V_RT_CB) + i * 16; }
    return it;
}
constexpr int N_BIG = 1024 + 194 + 96 + 128 + 4;
__device__ __forceinline__ CvtItem small_item(const Ctx& C, int q) {
    CvtItem it; const int i = q >> 9, e = (q >> 5) & 15, blk = q & 31;
    it.src = C.w_down + (size_t)(i * 16 + e) * 256 * 1024; it.K = 256; it.N = 1024; it.n0 = blk * 32; it.ncols = 32;
    it.dst = (bf16*)(C.ws + WS_WD) + ((size_t)(i * 16 + e) * 1024 + it.n0) * 256; it.dpitch = 256;
    it.g = nullptr; it.b = nullptr; it.cs = nullptr; it.cb = nullptr; return it;
}
__device__ __forceinline__ void p_prologue(const Ctx& C) {
    LAS float* scr = (LAS float*)(C.lds + C.wave * 8704);
    for (int sl = C.gw; sl < N_BIG + 512; sl += C.ngw) {
        if (sl < N_BIG) { const CvtItem it = big_item(C, sl); cvt_item(it, scr, C.lane); }
        else { for (int u = 0; u < 4; ++u) { const CvtItem it = small_item(C, (sl - N_BIG) * 4 + u); cvt_item(it, scr, C.lane); } }
    }
    { const int nth = C.nwg * 512, gt = C.wg * 512 + C.tid; bf16* Z = C.Z();
      for (int i = gt; i < M * D / 8; i += nth) { const f32x4 a = *(const f32x4*)(C.x + (size_t)i * 8), b = *(const f32x4*)(C.x + (size_t)i * 8 + 4);
          u32x4 o; o.x = pk2(a[0], a[1]); o.y = pk2(a[2], a[3]); o.z = pk2(b[0], b[1]); o.w = pk2(b[2], b[3]); *(u32x4*)(Z + (size_t)i * 8) = o; } }
    { const int gt = C.wg * 512 + C.tid;
      if (gt < 256) { float* T = (float*)(C.ws + WS_ROPE); const int j = gt & 7, a = gt >> 3;
          const double wr = ROPE_W[2 * j], wi = ROPE_W[2 * j + 1];
          double pr = wr, pi = wi;
          for (int q = 0; q < 6; ++q) { const double t = pr * pr - pi * pi; pi = 2.0 * pr * pi; pr = t; }
          double zr = 1.0, zi = 0.0;
          for (int bit = 0; bit < 5; ++bit) { if ((a >> bit) & 1) { const double t = zr * pr - zi * pi; zi = zr * pi + zi * pr; zr = t; } const double t2 = pr * pr - pi * pi; pi = 2.0 * pr * pi; pr = t2; }
          for (int b = 0; b < 64; ++b) { const int pos = 64 * a + b; T[pos * 8 + j] = (float)zr; T[S * 8 + pos * 8 + j] = (float)zi; const double t = zr * wr - zi * wi; zi = zr * wi + zi * wr; zr = t; } } }
}

template <bool DUAL, int K, class Setup, class AF, class BF, class EP>
__device__ __forceinline__ void sgemm(int lane, int gw, int ngw, int Mt, int Nt, Setup setup, AF af, BF bf, EP ep) {
    const int lr = lane & 15, lq = lane >> 4;
    for (int t = gw; t < Mt * Nt; t += ngw) {
        const int tm = t / Nt, tn = t % Nt, r0 = tm * 32, c0 = tn * 32;
        const auto tc = setup(tm, tn);
        f32x4 acc[2][2], acc2[2][2];
#pragma unroll
        for (int i = 0; i < 2; ++i)
#pragma unroll
            for (int j = 0; j < 2; ++j) { acc[i][j] = (f32x4){0.f, 0.f, 0.f, 0.f}; acc2[i][j] = (f32x4){0.f, 0.f, 0.f, 0.f}; }
        const bf16* ap[2]; ap[0] = af(tc, r0 + lr) + 8 * lq; ap[1] = af(tc, r0 + 16 + lr) + 8 * lq;
#pragma unroll 4
        for (int k0 = 0; k0 < K; k0 += 32) {
            bf16x8 a[2], b[2], b2[2];
#pragma unroll
            for (int i = 0; i < 2; ++i) a[i] = *(const bf16x8*)(ap[i] + k0);
#pragma unroll
            for (int j = 0; j < 2; ++j) { b[j] = *(const bf16x8*)bf(tc, c0 + 16 * j + lr, k0 + 8 * lq, 0); if (DUAL) b2[j] = *(const bf16x8*)bf(tc, c0 + 16 * j + lr, k0 + 8 * lq, 1); }
#pragma unroll
            for (int i = 0; i < 2; ++i)
#pragma unroll
                for (int j = 0; j < 2; ++j) { acc[i][j] = mfma16(a[i], b[j], acc[i][j]); if (DUAL) acc2[i][j] = mfma16(a[i], b2[j], acc2[i][j]); }
        }
#pragma unroll
        for (int i = 0; i < 2; ++i)
#pragma unroll
            for (int j = 0; j < 2; ++j)
#pragma unroll
                for (int rg = 0; rg < 4; ++rg) ep(tc, r0 + 16 * i + 4 * lq + rg, c0 + 16 * j + lr, acc[i][j][rg], acc2[i][j][rg]);
    }
}
struct NoTile {};
__device__ __forceinline__ f32x4 thin16(const bf16* Zr, int r0, const bf16* WT, int lane) {
    f32x4 acc = (f32x4){0.f, 0.f, 0.f, 0.f};
    const bf16* ap = Zr + (size_t)(r0 + (lane & 15)) * D + 8 * (lane >> 4); const bf16* bp = WT + (size_t)(lane & 15) * D + 8 * (lane >> 4);
#pragma unroll 8
    for (int k0 = 0; k0 < D; k0 += 32) acc = mfma16(*(const bf16x8*)(ap + k0), *(const bf16x8*)(bp + k0), acc);
    return acc;
}

namespace pg8 {
constexpr int BM = 256, BK = 64, HALF = 128, HTB = HALF * BK * 2, STAGE_BYTES = 8 * HTB;
__device__ __forceinline__ int lds_byte(int r, int c) { const int st = (r >> 4) * 2 + (c >> 5), rr = r & 15, cc = c & 31, ob = rr * 64 + cc * 2; return st * 1024 + (ob ^ (((ob >> 9) & 1) << 5)); }
__device__ __forceinline__ void stage_rc(int b, int& R, int& C) { const int st = b / 1024, sb = b % 1024, swz = sb ^ (((sb >> 9) & 1) << 5); R = (st >> 1) * 16 + swz / 64; C = (st & 1) * 32 + (swz % 64) / 2; }
__device__ __forceinline__ int perm32(int rho) { const int n = rho >> 4, i = rho & 15; return 8 * (i >> 2) + 4 * n + (i & 3); }
struct Unit { int pm, pn, cls, base, cnt, e1, e2; };
typedef f32x4 Acc[2][2][4][2];
constexpr int LDS_TAB = 131072 + 1024;
constexpr int LDS_CLS = 131072 + 512;

template <class Prob, class Epi>
__device__ __forceinline__ void gemm_phase(const Ctx& C, const Prob& P, const Epi& E) {
    LAS unsigned char* lds = C.lds;
    const int tid = C.tid, wid = C.wave, lane = C.lane, wr = wid >> 2, wc = wid & 3, fr = lane & 15, fq = lane >> 4;
    constexpr int nt = Prob::K / BK, LDBE = Prob::LDB;
    unsigned voffA[2], voffB[2];
#pragma unroll
    for (int i = 0; i < 2; ++i) { int R_, C_; stage_rc(tid * 16 + i * 8192, R_, C_); const int Rb = (R_ & ~31) + perm32(R_ & 31); voffA[i] = (unsigned)(R_ * Prob::LDA + C_) * 2u; voffB[i] = (unsigned)(Rb * LDBE + C_) * 2u; }
    constexpr size_t hstepB = (size_t)HALF * LDBE * 2;
    const unsigned ldsw = (unsigned)wid * 1024u;
    const int aoff = lds_byte(wr * 64 + fr, fq * 8), boff = lds_byte(wc * 32 + fr, fq * 8);
#define PG8_SA(b, h) (((b) * 2 + (h)) * HTB)
#define PG8_SB(b, h) ((4 + (b) * 2 + (h)) * HTB)
#define PG8_STAGE_B(bufoff, gbase) do { _Pragma("unroll") for (int _i = 0; _i < 2; ++_i) { unsigned _v = voffB[_i]; const char* _b = (const char*)(gbase); asm volatile("" : "+v"(_v), "+s"(_b));     \
        __builtin_amdgcn_global_load_lds((const unsigned*)(_b + _v), (LAS unsigned*)(lds + (bufoff) + ldsw + _i * 8192), 16, 0, 0); } } while (0)
#define PG8_STAGE_A(bufoff, un, vo, h, tt) do { _Pragma("unroll") for (int _i = 0; _i < 2; ++_i) { unsigned _v = Prob::GATHER ? (vo)[h][_i] : voffA[_i]; const char* _b = P.a_tile(un, h) + (size_t)(tt) * (BK * 2); asm volatile("" : "+v"(_v), "+s"(_b)); \
        __builtin_amdgcn_global_load_lds((const unsigned*)(_b + _v), (LAS unsigned*)(lds + (bufoff) + ldsw + _i * 8192), 16, 0, 0); } } while (0)
#define PG8_LDA(dst, b, h) do { _Pragma("unroll") for (int m = 0; m < 4; ++m) _Pragma("unroll") for (int k = 0; k < 2; ++k) dst[m][k] = *(const LAS bf16x8*)(lds + PG8_SA(b, h) + aoff + m * 2048 + k * 1024); } while (0)
#define PG8_LDB(dst, b, h) do { _Pragma("unroll") for (int n = 0; n < 2; ++n) _Pragma("unroll") for (int k = 0; k < 2; ++k) dst[n][k] = *(const LAS bf16x8*)(lds + PG8_SB(b, h) + boff + n * 2048 + k * 1024); } while (0)
#define PG8_MMA(ai, bj, At, Bt) do { __builtin_amdgcn_s_setprio(1); _Pragma("unroll") for (int m = 0; m < 4; ++m) _Pragma("unroll") for (int n = 0; n < 2; ++n) _Pragma("unroll") for (int k = 0; k < 2; ++k) \
        acc[ai][bj][m][n] = __builtin_amdgcn_mfma_f32_16x16x32_bf16(Bt[n][k], At[m][k], acc[ai][bj][m][n], 0, 0, 0); __builtin_amdgcn_s_setprio(0); } while (0)
#define PG8_WAIT_V(n) asm volatile("s_waitcnt vmcnt(" #n ")" ::: "memory")
#define PG8_WAIT_L(n) asm volatile("s_waitcnt lgkmcnt(" #n ")" ::: "memory")
#define PG8_BAR __builtin_amdgcn_s_barrier()
#define PG8_SCHED __builtin_amdgcn_sched_barrier(0)
#define PG8_KSTEP(t, un2, vo2, t2, b2, b3) do { \
        PG8_LDB(B0, 0, 0); PG8_LDB(B1, 0, 1); PG8_SCHED; PG8_LDA(At, 0, 0); PG8_STAGE_A(PG8_SA(1, 1), cur, voC, 1, (t) + 1); \
        PG8_WAIT_V(8); PG8_WAIT_L(0); PG8_BAR; PG8_MMA(0, 0, At, B0); PG8_MMA(0, 1, At, B1); PG8_BAR; PG8_SCHED; \
        PG8_LDA(At, 0, 1); PG8_STAGE_B(PG8_SB(0, 0), b2); PG8_STAGE_B(PG8_SB(0, 1), (b2) + hstepB); PG8_STAGE_A(PG8_SA(0, 0), un2, vo2, 0, t2); \
        PG8_WAIT_V(8); PG8_WAIT_L(0); PG8_BAR; PG8_MMA(1, 0, At, B0); PG8_MMA(1, 1, At, B1); PG8_BAR; PG8_SCHED; \
        PG8_LDB(B0, 1, 0); PG8_LDB(B1, 1, 1); PG8_SCHED; PG8_LDA(At, 1, 0); PG8_STAGE_A(PG8_SA(0, 1), un2, vo2, 1, t2); \
        PG8_WAIT_V(8); PG8_WAIT_L(0); PG8_BAR; PG8_MMA(0, 0, At, B0); PG8_MMA(0, 1, At, B1); PG8_BAR; PG8_SCHED; \
        PG8_LDA(At, 1, 1); PG8_STAGE_B(PG8_SB(1, 0), b3); PG8_STAGE_B(PG8_SB(1, 1), (b3) + hstepB); PG8_STAGE_A(PG8_SA(1, 0), un2, vo2, 0, (t2) + 1); \
        PG8_WAIT_V(8); PG8_WAIT_L(0); PG8_BAR; PG8_MMA(1, 0, At, B0); PG8_MMA(1, 1, At, B1); PG8_BAR; PG8_SCHED; } while (0)
    Unit cur = {0, 0, 0, 0, 0, 0, 0}, nxt = {0, 0, 0, 0, 0, 0, 0}; int ui = 0;
    if (!P.next(0, cur)) return;
    Acc acc;
#define PG8_ZERO() do { _Pragma("unroll") for (int a = 0; a < 2; ++a) _Pragma("unroll") for (int b = 0; b < 2; ++b) _Pragma("unroll") for (int m = 0; m < 4; ++m) _Pragma("unroll") for (int n = 0; n < 2; ++n) acc[a][b][m][n] = (f32x4){0.f, 0.f, 0.f, 0.f}; } while (0)
    PG8_ZERO();
    bf16x8 At[4][2], B0[2][2], B1[2][2];
    unsigned voC[2][2], voN[2][2];
    if (Prob::GATHER) P.a_offsets(cur, tid, voC);
    {
        const char* pb0 = P.b_tile(cur, 0); const char* pb1 = P.b_tile(cur, 1);
        PG8_STAGE_B(PG8_SB(0, 0), pb0); PG8_STAGE_B(PG8_SB(0, 1), pb0 + hstepB); PG8_STAGE_A(PG8_SA(0, 0), cur, voC, 0, 0); PG8_STAGE_A(PG8_SA(0, 1), cur, voC, 1, 0);
        if (wr == 1) PG8_BAR;
        PG8_WAIT_V(2); PG8_BAR;
        PG8_STAGE_B(PG8_SB(1, 0), pb1); PG8_STAGE_A(PG8_SA(1, 0), cur, voC, 0, 1); PG8_STAGE_B(PG8_SB(1, 1), pb1 + hstepB);
        PG8_WAIT_V(6); PG8_BAR;
    }
    for (;;) {
        const bool has_next = P.next(ui + 1, nxt);
        if (has_next) { if (Prob::GATHER) P.a_offsets(nxt, tid, voN); }
        else { nxt = cur;
#pragma unroll
            for (int h = 0; h < 2; ++h)
#pragma unroll
                for (int i = 0; i < 2; ++i) voN[h][i] = voC[h][i]; }
#pragma unroll 1
        for (int t = 0; t < nt - 2; t += 2) { const char* b2 = P.b_tile(cur, t + 2); const char* b3 = P.b_tile(cur, t + 3); PG8_KSTEP(t, cur, voC, t + 2, b2, b3); }
        { const char* b2 = P.b_tile(nxt, 0); const char* b3 = P.b_tile(nxt, 1); PG8_KSTEP(nt - 2, nxt, voN, 0, b2, b3); }
        if (wr == 0) PG8_BAR;
        E(acc, cur, C, wr, wc, fr, fq);
        if (!has_next) break;
        PG8_ZERO();
        cur = nxt;
#pragma unroll
        for (int h = 0; h < 2; ++h)
#pragma unroll
            for (int i = 0; i < 2; ++i) voC[h][i] = voN[h][i];
        ++ui;
        if (wr == 1) PG8_BAR;
    }
    PG8_WAIT_V(0);
    PG8_BAR;
#undef PG8_SA
#undef PG8_SB
#undef PG8_STAGE_A
#undef PG8_STAGE_B
#undef PG8_LDA
#undef PG8_LDB
#undef PG8_MMA
#undef PG8_WAIT_V
#undef PG8_WAIT_L
#undef PG8_BAR
#undef PG8_SCHED
#undef PG8_KSTEP
#undef PG8_ZERO
}
__device__ __forceinline__ unsigned cvt_pk_bf16(float lo, float hi) { unsigned r; asm volatile("v_cvt_pk_bf16_f32 %0, %1, %2" : "=v"(r) : "v"(lo), "v"(hi)); return r; }
__device__ __forceinline__ void epi_bar() { asm volatile("s_waitcnt lgkmcnt(0)" ::: "memory"); __builtin_amdgcn_s_barrier(); asm volatile("" ::: "memory"); }

__device__ __forceinline__ bool static_next(int i, int G, int c, int nM, int nN, Unit& u) {
    const int nwg = nM * nN; const long L = (long)i * G + c; if (L >= nwg) return false;
    int wgid = (int)L; { const int q = nwg / 8, r = nwg % 8, xcd = wgid % 8, off = wgid / 8; wgid = (xcd < r ? xcd * (q + 1) : r * (q + 1) + (xcd - r) * q) + off; }
    const int nig = 8 * nN, gid = wgid / nig, fm = gid * 8, gsz = (nM - fm) < 8 ? (nM - fm) : 8;
    u.pm = fm + ((wgid % nig) % gsz); u.pn = (wgid % nig) / gsz; u.cls = 0; u.base = 0; u.cnt = 0; u.e1 = 0; u.e2 = 0; return true;
}
struct ProbPlain {
    static constexpr int K = 1024, LDA = 1024, LDB = 1024; static constexpr bool GATHER = false;
    const bf16* A; const bf16* Bt; int nM, nN, G, c;
    __device__ __forceinline__ bool next(int i, Unit& u) const { return static_next(i, G, c, nM, nN, u); }
    __device__ __forceinline__ const char* a_tile(const Unit& u, int h) const { return (const char*)A + (size_t)(u.pm * 256 + h * 128) * (1024 * 2); }
    __device__ __forceinline__ void a_offsets(const Unit&, int, unsigned (&)[2][2]) const {}
    __device__ __forceinline__ const char* b_tile(const Unit& u, int t) const { return (const char*)Bt + (size_t)u.pn * (256 * 1024 * 2) + (size_t)t * (BK * 2); }
};
__device__ __forceinline__ bool cls_next(int i, int G, int c, int ntiles, const LAS int* cbase, const LAS int* ccnt, Unit& u) {
    const int nwg = ntiles * 4; const long L = (long)i * G + c; if (L >= nwg) return false;
    int wgid = (int)L; { const int q = nwg / 8, r = nwg % 8, xcd = wgid % 8, off = wgid / 8; wgid = (xcd < r ? xcd * (q + 1) : r * (q + 1) + (xcd - r) * q) + off; }
    u.pm = wgid >> 2; u.pn = wgid & 3;
    const int R0 = u.pm * 256; int cl = 0;
#pragma unroll 1
    for (int k = 1; k < NCLS; ++k) if (R0 >= cbase[k]) cl = k;
    cl = __builtin_amdgcn_readfirstlane(cl);
    u.cls = cl; u.base = __builtin_amdgcn_readfirstlane(cbase[cl]); u.cnt = __builtin_amdgcn_readfirstlane(ccnt[cl]); cls_experts(cl, u.e1, u.e2); return true;
}
struct ProbUp {
    static constexpr int K = 1024, LDA = 1024, LDB = 1024; static constexpr bool GATHER = true;
    const bf16* Z; const bf16* WGU; const int* list; const LAS int* cbase; const LAS int* ccnt; int ntiles, G, c;
    __device__ __forceinline__ bool next(int i, Unit& u) const { return cls_next(i, G, c, ntiles, cbase, ccnt, u); }
    __device__ __forceinline__ const char* a_tile(const Unit&, int) const { return (const char*)Z; }
    __device__ __forceinline__ void a_offsets(const Unit& u, int tid, unsigned (&vo)[2][2]) const {
#pragma unroll
        for (int i = 0; i < 2; ++i) { int R_, C_; stage_rc(tid * 16 + i * 8192, R_, C_);
#pragma unroll
            for (int h = 0; h < 2; ++h) { int li = u.pm * 256 + h * 128 + R_ - u.base; li = li < u.cnt ? li : u.cnt - 1; const int tok = list[u.cls * M + li]; vo[h][i] = (unsigned)(tok * 1024 + C_) * 2u; } } }
    __device__ __forceinline__ const char* b_tile(const Unit& u, int t) const { const int e = (u.pn >> 1) ? u.e2 : u.e1; return (const char*)WGU + (size_t)(e * 2 + (u.pn & 1)) * (256 * 1024 * 2) + (size_t)t * (BK * 2); }
};
struct ProbDown {
    static constexpr int K = 512, LDA = 512, LDB = 256; static constexpr bool GATHER = false;
    const bf16* ACT; const bf16* WD; const LAS int* cbase; const LAS int* ccnt; int ntiles, G, c;
    __device__ __forceinline__ bool next(int i, Unit& u) const { return cls_next(i, G, c, ntiles, cbase, ccnt, u); }
    __device__ __forceinline__ const char* a_tile(const Unit& u, int h) const { return (const char*)ACT + (size_t)(u.pm * 256 + h * 128) * (512 * 2); }
    __device__ __forceinline__ void a_offsets(const Unit&, int, unsigned (&)[2][2]) const {}
    __device__ __forceinline__ const char* b_tile(const Unit& u, int t) const { const int e = t < 4 ? u.e1 : u.e2; return (const char*)WD + ((size_t)e * 1024 + (size_t)u.pn * 256) * (256 * 2) + (size_t)(t & 3) * (BK * 2); }
};

__device__ __forceinline__ void unpack8(const u32x4 w, float (&f)[8]) {
    f[0] = __uint_as_float(w.x << 16); f[1] = __uint_as_float(w.x & 0xffff0000u); f[2] = __uint_as_float(w.y << 16); f[3] = __uint_as_float(w.y & 0xffff0000u);
    f[4] = __uint_as_float(w.z << 16); f[5] = __uint_as_float(w.z & 0xffff0000u); f[6] = __uint_as_float(w.w << 16); f[7] = __uint_as_float(w.w & 0xffff0000u); }
struct EpiProj {
    bool fox; const float* st; const float* cs; const float* cb; const float* rope; bf16* Q;
    __device__ __forceinline__ void operator()(Acc& acc, const Unit& u, const Ctx& C, int wr, int wc, int fr, int fq) const {
        const int row0 = u.pm * 256 + wr * 64 + fr, colt = u.pn * 256 + wc * 32 + 8 * fq;
        f32x4 csv[2][2], cbv[2][2];
#pragma unroll
        for (int bj = 0; bj < 2; ++bj)
#pragma unroll
            for (int n = 0; n < 2; ++n) { csv[bj][n] = *(const f32x4*)(cs + colt + 128 * bj + 4 * n); cbv[bj][n] = *(const f32x4*)(cb + colt + 128 * bj + 4 * n); }
        size_t doff; int ldc, dcol; float sc = 1.f;
        if (fox) { const int t = u.pn >> 2; doff = (size_t)t * ((WS_K - WS_Q) / 2); ldc = 1024; dcol = (u.pn & 3) * 256; if (t == 0) sc = C2; }
        else { if (u.pn < 4) { doff = 0; ldc = 1024; dcol = u.pn * 256; sc = C2; } else { doff = (u.pn == 4) ? (WS_K - WS_Q) / 2 : (WS_V - WS_Q) / 2; ldc = 256; dcol = 0; } }
        bf16* dst = Q + doff + dcol + wc * 32 + 8 * fq;
        const bool rope_on = !fox && u.pn < 5 && !(wc & 1);
        const float sgn = fq == 0 ? -1.f : 1.f;
#pragma unroll
        for (int ai = 0; ai < 2; ++ai)
#pragma unroll
            for (int m = 0; m < 4; ++m) {
                const int r = row0 + 128 * ai + 16 * m; const f32x2 ms = row_stats(st, r);
                f32x4 v[2][2];
#pragma unroll
                for (int bj = 0; bj < 2; ++bj)
#pragma unroll
                    for (int n = 0; n < 2; ++n) v[bj][n] = (acc[ai][bj][m][n] - ms.x * csv[bj][n]) * ms.y + cbv[bj][n];
                if (rope_on) {
                    const int pos = r & (S - 1); f32x4 co[2], si[2];
                    co[0] = *(const f32x4*)(rope + pos * 8); co[1] = *(const f32x4*)(rope + pos * 8 + 4); si[0] = *(const f32x4*)(rope + S * 8 + pos * 8); si[1] = *(const f32x4*)(rope + S * 8 + pos * 8 + 4);
#pragma unroll
                    for (int bj = 0; bj < 2; ++bj)
#pragma unroll
                        for (int n = 0; n < 2; ++n)
#pragma unroll
                            for (int e = 0; e < 4; ++e) { const float x = v[bj][n][e], o = __shfl_xor(x, 16); const float y = x * co[n][e] + sgn * o * si[n][e]; v[bj][n][e] = fq < 2 ? y : x; }
                }
#pragma unroll
                for (int bj = 0; bj < 2; ++bj) { const f32x4 a = v[bj][0] * sc, b = v[bj][1] * sc; u32x4 w; w.x = cvt_pk_bf16(a[0], a[1]); w.y = cvt_pk_bf16(a[2], a[3]); w.z = cvt_pk_bf16(b[0], b[1]); w.w = cvt_pk_bf16(b[2], b[3]);
                    *(u32x4*)(dst + (size_t)r * ldc + 128 * bj) = w; }
            }
    }
};
struct EpiOut {
    const float* stp; const float* gp; const float* bp; bf16* Z; float* sto;
    __device__ __forceinline__ void operator()(Acc& acc, const Unit& u, const Ctx& C, int wr, int wc, int fr, int fq) const {
        const int colt = u.pn * 256 + wc * 32 + 8 * fq;
        f32x4 gv[2][2], bv[2][2];
#pragma unroll
        for (int bj = 0; bj < 2; ++bj)
#pragma unroll
            for (int n = 0; n < 2; ++n) { gv[bj][n] = gp ? *(const f32x4*)(gp + colt + 128 * bj + 4 * n) : (f32x4){1.f, 1.f, 1.f, 1.f}; bv[bj][n] = gp ? *(const f32x4*)(bp + colt + 128 * bj + 4 * n) : (f32x4){0.f, 0.f, 0.f, 0.f}; }
        LAS f32x2* T = (LAS f32x2*)(C.lds + LDS_TAB);
#pragma unroll
        for (int ai = 0; ai < 2; ++ai)
#pragma unroll
            for (int m = 0; m < 4; ++m) {
                const int rl = 128 * ai + 64 * wr + 16 * m + fr, r = u.pm * 256 + rl; const f32x2 ms = row_stats(stp, r);
                float s = 0.f, q = 0.f;
#pragma unroll
                for (int bj = 0; bj < 2; ++bj) {
                    bf16* p = Z + (size_t)r * D + colt + 128 * bj; float zi[8]; unpack8(*(const u32x4*)p, zi); float zo[8];
#pragma unroll
                    for (int n = 0; n < 2; ++n)
#pragma unroll
                        for (int e = 0; e < 4; ++e) { const float xin = gp ? (zi[4 * n + e] - ms.x) * ms.y * gv[bj][n][e] + bv[bj][n][e] : zi[4 * n + e]; zo[4 * n + e] = ALPHA * xin + acc[ai][bj][m][n][e]; }
                    u32x4 w; w.x = cvt_pk_bf16(zo[0], zo[1]); w.y = cvt_pk_bf16(zo[2], zo[3]); w.z = cvt_pk_bf16(zo[4], zo[5]); w.w = cvt_pk_bf16(zo[6], zo[7]);
                    *(u32x4*)p = w; float zr[8]; unpack8(w, zr);
#pragma unroll
                    for (int e = 0; e < 8; ++e) { s += zr[e]; q += zr[e] * zr[e]; }
                }
                s += __shfl_xor(s, 16); s += __shfl_xor(s, 32); q += __shfl_xor(q, 16); q += __shfl_xor(q, 32);
                if (fq == 0) T[rl * 4 + wc] = (f32x2){s, q};
                asm volatile("" ::: "memory");
            }
        epi_bar();
        if (C.tid < 256) { const f32x2 a = T[C.tid * 4 + 0], b = T[C.tid * 4 + 1], c = T[C.tid * 4 + 2], d = T[C.tid * 4 + 3];
            *(f32x2*)(sto + (size_t)(u.pm * 256 + C.tid) * 8 + u.pn * 2) = (f32x2){(a.x + b.x) + (c.x + d.x), (a.y + b.y) + (c.y + d.y)}; }
    }
};
struct EpiUp {
    const float* st; const int* list; const f32x2* gates; const float* gcs; const float* gcb; bf16* ACT;
    __device__ __forceinline__ void operator()(Acc& acc, const Unit& u, const Ctx& C, int wr, int wc, int fr, int fq) const {
        const int which = u.pn >> 1, half = u.pn & 1, e = which ? u.e2 : u.e1;
        const float* pcs = gcs + e * 512 + half * 256 + wc * 32 + 8 * fq; const float* pcb = gcb + e * 512 + half * 256 + wc * 32 + 8 * fq;
        f32x4 csg[2], csu[2], cbg[2], cbu[2];
#pragma unroll
        for (int n = 0; n < 2; ++n) { csg[n] = *(const f32x4*)(pcs + 4 * n); csu[n] = *(const f32x4*)(pcs + 128 + 4 * n); cbg[n] = *(const f32x4*)(pcb + 4 * n); cbu[n] = *(const f32x4*)(pcb + 128 + 4 * n); }
        bf16* dst = ACT + which * 256 + half * 128 + wc * 32 + 8 * fq;
#pragma unroll
        for (int ai = 0; ai < 2; ++ai)
#pragma unroll
            for (int m = 0; m < 4; ++m) {
                const int rl = 128 * ai + 64 * wr + 16 * m + fr, R = u.pm * 256 + rl, li = R - u.base; const bool valid = li < u.cnt;
                const int tok = list[u.cls * M + (valid ? li : 0)]; const f32x2 ms = row_stats(st, tok); const f32x2 gt = gates[tok];
                const float gate = valid ? (which ? gt.y : gt.x) : 0.f;
                float a[8];
#pragma unroll
                for (int n = 0; n < 2; ++n)
#pragma unroll
                    for (int k = 0; k < 4; ++k) { const float hg = ms.y * (acc[ai][0][m][n][k] - ms.x * csg[n][k]) + cbg[n][k], hu = ms.y * (acc[ai][1][m][n][k] - ms.x * csu[n][k]) + cbu[n][k];
                        a[4 * n + k] = hg * __builtin_amdgcn_rcpf(1.f + __expf(-hg)) * hu * gate; }
                u32x4 w; w.x = cvt_pk_bf16(a[0], a[1]); w.y = cvt_pk_bf16(a[2], a[3]); w.z = cvt_pk_bf16(a[4], a[5]); w.w = cvt_pk_bf16(a[6], a[7]);
                *(u32x4*)(dst + (size_t)R * 512) = w;
            }
    }
};
struct EpiDown {
    const float* st1; const float* g1; const float* b1; const int* list; bf16* Z; float* sto;
    __device__ __forceinline__ void operator()(Acc& acc, const Unit& u, const Ctx& C, int wr, int wc, int fr, int fq) const {
        const int colt = u.pn * 256 + wc * 32 + 8 * fq;
        f32x4 gv[2][2], bv[2][2];
#pragma unroll
        for (int bj = 0; bj < 2; ++bj)
#pragma unroll
            for (int n = 0; n < 2; ++n) { gv[bj][n] = *(const f32x4*)(g1 + colt + 128 * bj + 4 * n); bv[bj][n] = *(const f32x4*)(b1 + colt + 128 * bj + 4 * n); }
        LAS f32x2* T = (LAS f32x2*)(C.lds + LDS_TAB);
#pragma unroll
        for (int ai = 0; ai < 2; ++ai)
#pragma unroll
            for (int m = 0; m < 4; ++m) {
                const int rl = 128 * ai + 64 * wr + 16 * m + fr, li = u.pm * 256 + rl - u.base; const bool valid = li < u.cnt;
                const int tok = list[u.cls * M + (valid ? li : 0)]; const f32x2 ms = row_stats(st1, tok);
                float s = 0.f, q = 0.f;
#pragma unroll
                for (int bj = 0; bj < 2; ++bj) {
                    bf16* p = Z + (size_t)tok * D + colt + 128 * bj; float zi[8]; unpack8(*(const u32x4*)p, zi); float zo[8];
#pragma unroll
                    for (int n = 0; n < 2; ++n)
#pragma unroll
                        for (int e = 0; e < 4; ++e) { const float x1 = (zi[4 * n + e] - ms.x) * ms.y * gv[bj][n][e] + bv[bj][n][e]; zo[4 * n + e] = ALPHA * x1 + acc[ai][bj][m][n][e]; }
                    u32x4 w; w.x = cvt_pk_bf16(zo[0], zo[1]); w.y = cvt_pk_bf16(zo[2], zo[3]); w.z = cvt_pk_bf16(zo[4], zo[5]); w.w = cvt_pk_bf16(zo[6], zo[7]);
                    if (valid) *(u32x4*)p = w;
                    float zr[8]; unpack8(w, zr);
#pragma unroll
                    for (int e = 0; e < 8; ++e) { s += zr[e]; q += zr[e] * zr[e]; }
                }
                s += __shfl_xor(s, 16); s += __shfl_xor(s, 32); q += __shfl_xor(q, 16); q += __shfl_xor(q, 32);
                if (fq == 0) T[rl * 4 + wc] = (f32x2){s, q};
                asm volatile("" ::: "memory");
            }
        epi_bar();
        if (C.tid < 256) { const int li = u.pm * 256 + C.tid - u.base;
            if (li < u.cnt) { const int tok = list[u.cls * M + li]; const f32x2 a = T[C.tid * 4 + 0], b = T[C.tid * 4 + 1], c = T[C.tid * 4 + 2], d = T[C.tid * 4 + 3];
                *(f32x2*)(sto + (size_t)tok * 8 + u.pn * 2) = (f32x2){(a.x + b.x) + (c.x + d.x), (a.y + b.y) + (c.y + d.y)}; } }
    }
};
}

#ifndef USE8_PROJ
#define USE8_PROJ 1
#endif
#ifndef USE8_OPROJ
#define USE8_OPROJ 1
#endif
#ifndef USE8_UP
#define USE8_UP 1
#endif
#ifndef USE8_DOWN
#define USE8_DOWN 1
#endif
namespace fox {
using bf16=unsigned short;
using s16x4=__attribute__((ext_vector_type(4)))short;
using f32x16=__attribute__((ext_vector_type(16)))float;
constexpr int BATCH=8,NHEAD=16,SEQ=2048,D=64,DM=NHEAD*D;
constexpr int NW=8,QBLK=32,QB=QBLK*NW,KVBLK=64,NQB=SEQ/QB;
constexpr int ATTN_PITCH=DM, ATTN_UNIT_ROWS=QB;
__device__ __forceinline__ int crow(int r,int hi){return (r&3)+8*(r>>2)+4*hi;}
#define SBAR() __builtin_amdgcn_sched_barrier(0)
__device__ __forceinline__ void cmask(f32x16&p0,f32x16&p1,int jb,int qrel,int hi){
  const float NEG=-INFINITY; int kb=64*jb+4*hi;
  #pragma unroll
  for(int r=0;r<16;++r){int kv=kb+(r&3)+8*(r>>2); if(kv>qrel)p0[r]=NEG; if(kv+32>qrel)p1[r]=NEG;}
}

constexpr int NSLOT=3, SLOTB=8192;
constexpr int LDS_K=0, LDS_V=NSLOT*SLOTB, LDS_WS=2*NSLOT*SLOTB, LDS_OST=LDS_WS+NW*64*4, LDS_C=LDS_OST+NW*4096, LDS_BYTES=LDS_C+SEQ*4;
__device__ __forceinline__ void glds16(const void*gsrc,unsigned lds_dst){unsigned keep;
  asm volatile("s_mov_b32 %0, m0\n\ts_mov_b32 m0, %2\n\ts_nop 0\n\tglobal_load_lds_dwordx4 %1, off\n\ts_mov_b32 m0, %0":"=&s"(keep):"v"(gsrc),"s"(lds_dst):"memory");}
__device__ __forceinline__ float max3f(float a,float b,float c){float r;asm("v_max3_f32 %0, %1, %2, %3":"=v"(r):"v"(a),"v"(b),"v"(c));return r;}
__device__ __forceinline__ float max2f(float a,float b){float r;asm("v_max_f32_e32 %0, %1, %2":"=v"(r):"v"(a),"v"(b));return r;}
__device__ __forceinline__ float fadd_s(float a,float b){float r;asm("v_add_f32_e32 %0, %1, %2":"=v"(r):"v"(a),"v"(b));return r;}
__device__ __forceinline__ float fsub_s(float a,float b){float r;asm("v_sub_f32_e32 %0, %1, %2":"=v"(r):"v"(a),"v"(b));return r;}
typedef float f32x2_t __attribute__((ext_vector_type(2))); typedef float f32x4_t __attribute__((ext_vector_type(4))); typedef __bf16 bf16x2_t __attribute__((ext_vector_type(2)));
__device__ __forceinline__ unsigned cvtpk_s(float lo,float hi){f32x2_t v={lo,hi};bf16x2_t b=__builtin_convertvector(v,bf16x2_t);return __builtin_bit_cast(unsigned,b);}
#define WAIT_BAR(N) asm volatile("s_waitcnt vmcnt(" #N ") lgkmcnt(0)\n\ts_barrier":::"memory")

__device__ __forceinline__ void qkt(f32x16&p0,f32x16&p1,const char*Kslot,const bf16x8*qr,int r32,int hi){
  const char*kb=Kslot+hi*1024+r32*16;
  #pragma unroll
  for(int d0=0;d0<4;++d0){
    const bf16x8 b0=*reinterpret_cast<const bf16x8*>(kb+d0*2048);
    const bf16x8 b1=*reinterpret_cast<const bf16x8*>(kb+d0*2048+512);
    p0=__builtin_amdgcn_mfma_f32_32x32x16_bf16(b0,qr[d0],p0,0,0,0);p1=__builtin_amdgcn_mfma_f32_32x32x16_bf16(b1,qr[d0],p1,0,0,0);}
}
typedef __attribute__((address_space(3))) const char* lds_cptr;
typedef short v4i16_t __attribute__((ext_vector_type(4)));
__device__ __forceinline__ void kload8(bf16x8*kf,lds_cptr kp){
  kf[0]=*(const __attribute__((address_space(3))) bf16x8*)(kp);      kf[1]=*(const __attribute__((address_space(3))) bf16x8*)(kp+512);
  kf[2]=*(const __attribute__((address_space(3))) bf16x8*)(kp+2048); kf[3]=*(const __attribute__((address_space(3))) bf16x8*)(kp+2560);
  kf[4]=*(const __attribute__((address_space(3))) bf16x8*)(kp+4096); kf[5]=*(const __attribute__((address_space(3))) bf16x8*)(kp+4608);
  kf[6]=*(const __attribute__((address_space(3))) bf16x8*)(kp+6144); kf[7]=*(const __attribute__((address_space(3))) bf16x8*)(kp+6656);
}
__device__ __forceinline__ void kload2(bf16x8*kf,lds_cptr kp,int j){ kf[2*j]=*(const __attribute__((address_space(3))) bf16x8*)(kp+j*2048); kf[2*j+1]=*(const __attribute__((address_space(3))) bf16x8*)(kp+j*2048+512); }
__device__ __forceinline__ s16x4 vtr(lds_cptr p){ return __builtin_bit_cast(s16x4,__builtin_amdgcn_ds_read_tr16_b64_v4i16((__attribute__((address_space(3))) v4i16_t*)p)); }
__device__ __forceinline__ float rowmax(const f32x16&p0,const f32x16&p1){
  float a=max3f(p0[0],p0[1],p1[0]),b=max3f(p0[2],p0[3],p1[1]);a=max3f(a,p1[2],p1[3]);
  #pragma unroll
  for(int r=4;r<16;r+=4){a=max3f(a,p0[r],p0[r+1]);b=max3f(b,p0[r+2],p0[r+3]);a=max3f(a,p1[r],p1[r+1]);b=max3f(b,p1[r+2],p1[r+3]);}
  const float m=max2f(a,b);
  auto rr=__builtin_amdgcn_permlane32_swap(__float_as_uint(m),__float_as_uint(m),false,false);
  return max2f(__uint_as_float(rr[0]),__uint_as_float(rr[1]));
}
__device__ __forceinline__ void pv(f32x16*o,int vb,bf16x8 pa0,bf16x8 pa1,bf16x8 pa2,bf16x8 pa3){
  #pragma unroll
  for(int d0=0;d0<2;++d0){s16x4 lo[4],hi[4];
    #pragma unroll
    for(int ks=0;ks<4;++ks){
      asm volatile("ds_read_b64_tr_b16 %0,%1 offset:%c2":"=&v"(lo[ks]):"v"(vb),"i"(d0*4096+ks*1024):"memory");
      asm volatile("ds_read_b64_tr_b16 %0,%1 offset:%c2":"=&v"(hi[ks]):"v"(vb),"i"(d0*4096+ks*1024+512):"memory");}
    asm volatile("s_waitcnt lgkmcnt(0)":::"memory");SBAR();
    #define PK(k) (bf16x8){lo[k][0],lo[k][1],lo[k][2],lo[k][3],hi[k][0],hi[k][1],hi[k][2],hi[k][3]}
    o[d0]=__builtin_amdgcn_mfma_f32_32x32x16_bf16(pa0,PK(0),o[d0],0,0,0);
    o[d0]=__builtin_amdgcn_mfma_f32_32x32x16_bf16(pa1,PK(1),o[d0],0,0,0);
    o[d0]=__builtin_amdgcn_mfma_f32_32x32x16_bf16(pa2,PK(2),o[d0],0,0,0);
    o[d0]=__builtin_amdgcn_mfma_f32_32x32x16_bf16(pa3,PK(3),o[d0],0,0,0);
    #undef PK
  }
}

#ifndef ATTN_STORE16
#define ATTN_STORE16(p,v) (*(u32x4*)(p)=(v))
#endif
template<int THRL> __device__ __forceinline__ void attn_unit(int tid,int b,int h,int qb,const bf16*Q,const bf16*__restrict__ K,const bf16*__restrict__ V,bf16*O,const float*__restrict__ CU,char*shm){
  const int lane=tid&63,r32=lane&31,hi=lane>>5; const int wid=__builtin_amdgcn_readfirstlane(tid>>6);
  const long rowbase=(long)b*SEQ; const int q0=qb*QB;
  const bf16*Qw=Q+(rowbase+q0+wid*QBLK)*DM+h*D;
  const bf16*Kh=K+rowbase*DM+h*D,*Vh=V+rowbase*DM+h*D;
  const unsigned lds0=(unsigned)(uintptr_t)shm;
  float*wsf=(float*)(shm+LDS_WS)+wid*64;
  const bf16*ksrc=Kh+(long)lane*DM+wid*8;
  const bf16*vsrc=Vh+(long)(16*(wid&3)+(lane>>2))*DM+(wid>>2)*32+(lane&3)*8;
  const unsigned kdst=lds0+LDS_K+wid*1024, vdst=lds0+LDS_V+wid*1024;
  #define DMA_K(t,slot) glds16(ksrc+(long)(t)*KVBLK*DM,(unsigned)__builtin_amdgcn_readfirstlane(kdst+(slot)))
  #define DMA_V(t,slot) glds16(vsrc+(long)(t)*KVBLK*DM,(unsigned)__builtin_amdgcn_readfirstlane(vdst+(slot)))
  const int vb0=(int)(lds0+LDS_V)+((lane>>4)&1)*32+(lane&3)*8+(4*hi+((lane&15)>>2))*64;
  const char*Kbase=shm+LDS_K; bf16x8 kf[8];
  const lds_cptr shm3=(lds_cptr)shm; const lds_cptr kp0=shm3+LDS_K+hi*1024+r32*16; const lds_cptr vp0=shm3+LDS_V+((lane>>4)&1)*32+(lane&3)*8+(4*hi+((lane&15)>>2))*64;
  const int NT=(q0+QB)/KVBLK;
  { const f32x4_t cv=*(const f32x4_t*)(CU+tid*4); *(__attribute__((address_space(3))) f32x4_t*)((lds_cptr)shm+LDS_C+tid*16)=cv; }
  DMA_K(0,0);DMA_V(0,0);DMA_K(1,SLOTB);
  const lds_cptr cpl=(lds_cptr)shm+LDS_C+hi*16;
  bf16x8 qr[4];
  #pragma unroll
  for(int d0=0;d0<4;++d0)qr[d0]=*reinterpret_cast<const bf16x8*>(&Qw[(long)r32*DM+d0*16+hi*8]);
  float l_reg=0.f;f32x16 o[2];o[0]=f32x16{};o[1]=f32x16{};float bm=0.f;
  const int qrel=wid*QBLK+r32;
  #define CMASK(P0,P1,t) do{int jb_=(t)-(NT-4); if(jb_>=0)cmask(P0,P1,jb_,qrel,hi);}while(0)
  bool resc=false;
  #define START(P0,P1) do{ const float rm=rowmax(P0,P1); resc=false; \
    { const float dl=rm; \
      _Pragma("unroll") for(int r=0;r<16;++r){P0[r]=fsub_s(P0[r],dl);P1[r]=fsub_s(P1[r],dl);} \
      bm=fsub_s(bm,dl); } \
    _Pragma("unroll") for(int r=0;r<16;++r)P0[r]=__builtin_amdgcn_exp2f(P0[r]); }while(0)
  #define RESC() do{ if(resc){ asm volatile("s_waitcnt lgkmcnt(0)":::"memory"); \
      _Pragma("unroll") for(int d_=0;d_<2;++d_) _Pragma("unroll") for(int r=0;r<16;++r)o[d_][r]*=wsf[crow(r,hi)]; } }while(0)
  typedef __attribute__((address_space(3))) const f32x4_t* lds_f4p;
  #define CPRE(X0,X1,tt) do{ const lds_cptr cp_=cpl+(tt)*256; _Pragma("unroll") for(int g_=0;g_<4;++g_){ const f32x4_t a_=*(lds_f4p)(cp_+32*g_), b_=*(lds_f4p)(cp_+128+32*g_); \
      X0[4*g_]=a_[0];X0[4*g_+1]=a_[1];X0[4*g_+2]=a_[2];X0[4*g_+3]=a_[3]; X1[4*g_]=b_[0];X1[4*g_+1]=b_[1];X1[4*g_+2]=b_[2];X1[4*g_+3]=b_[3]; } }while(0)
  #define CFIN(X0,X1) do{ _Pragma("unroll") for(int r=0;r<16;++r){X0[r]=bm-X0[r];X1[r]=bm-X1[r];} }while(0)
  f32x16 pA0,pA1,pB0,pB1;
  int sl_prev=0,sl_cur=0,sl_next=SLOTB;
  #define ROT() do{sl_prev=sl_cur;sl_cur=sl_next;sl_next=(sl_next==(NSLOT-1)*SLOTB)?0:sl_next+SLOTB;}while(0)
  DMA_K(2,2*SLOTB);
  WAIT_BAR(3);
  bm=*(const __attribute__((address_space(3))) float*)((lds_cptr)shm+LDS_C+(q0+qrel)*4);
  CPRE(pA0,pA1,0); CFIN(pA0,pA1);
  qkt(pA0,pA1,Kbase,qr,r32,hi);asm volatile("s_nop 15\n\ts_nop 7":"+v"(pA0),"+v"(pA1));CMASK(pA0,pA1,0);
  START(pA0,pA1);
  CPRE(pB0,pB1,1);
  _Pragma("unroll") for(int r=0;r<16;++r)pA1[r]=__builtin_amdgcn_exp2f(pA1[r]);
  WAIT_BAR(0);
  DMA_K(3,0);DMA_V(1,SLOTB);
  ROT();
  kload8(kf,kp0+sl_cur);
  WAIT_BAR(2);
  s16x4 vlo[8],vhi[8]; u32x4 pw0,pw1,pw2,pw3;
  #define PKW(P,B) cvtpk_s(P[B],P[B+1])
  #define PAF(k) __builtin_bit_cast(bf16x8,pw##k)
  #define VFR(i) (bf16x8){vlo[i][0],vlo[i][1],vlo[i][2],vlo[i][3],vhi[i][0],vhi[i][1],vhi[i][2],vhi[i][3]}
  #define PIN(x) asm volatile("":"+v"(x))
  #define MX3(a,b,c) __builtin_fmaxf(__builtin_fmaxf((a),(b)),(c))
  #define GAPA(MF,A0,A1,A2,A3,W0,W1,PW) do{ MF; sacc+=A0; sacc+=A1; sacc+=A2; sacc+=A3; PIN(sacc); W0; W1; PIN(PW); SBAR(); }while(0)
  #define EX(v) __builtin_amdgcn_exp2f(v)
  #define GAPB(MF,X,B) do{ MF; X[B]=EX(X[B]); X[B+1]=EX(X[B+1]); X[B+2]=EX(X[B+2]); X[B+3]=EX(X[B+3]); PIN(X); SBAR(); }while(0)
  #define VRD(i) do{ vlo[i]=vtr(vp_+(((i)>>2)*4096+((i)&3)*1024)); vhi[i]=vtr(vp_+(((i)>>2)*4096+((i)&3)*1024+512)); }while(0)
  #define KRD(G,j) do{ if(G){ kload2(kf,kp0+sl_next,j); SBAR(); } }while(0)
  #define STEP(C0,C1,P0,P1,t,GK,GV,GL) do{ SBAR(); \
    CFIN(C0,C1); SBAR(); \
    const lds_cptr vp_=vp0+sl_prev; \
    VRD(0); SBAR(); float sacc=(P0[0]+P0[1]); \
    GAPA(C0=__builtin_amdgcn_mfma_f32_32x32x16_bf16(kf[0],qr[0],C0,0,0,0), P0[2],P0[3],P0[4],P0[5],     pw0[0]=PKW(P0,0), pw0[1]=PKW(P0,2), pw0); \
    VRD(4); SBAR(); GAPA(C1=__builtin_amdgcn_mfma_f32_32x32x16_bf16(kf[1],qr[0],C1,0,0,0), P0[6],P0[7],P0[8],P0[9],     pw0[2]=PKW(P0,4), pw0[3]=PKW(P0,6), pw0); \
    VRD(1); SBAR(); GAPA(C0=__builtin_amdgcn_mfma_f32_32x32x16_bf16(kf[2],qr[1],C0,0,0,0),   P0[10],P0[11],P0[12],P0[13], pw1[0]=PKW(P0,8), pw1[1]=PKW(P0,10), pw1); \
    VRD(5); SBAR(); GAPA(C1=__builtin_amdgcn_mfma_f32_32x32x16_bf16(kf[3],qr[1],C1,0,0,0),   P0[14],P0[15],P1[0],P1[1],   pw1[2]=PKW(P0,12),pw1[3]=PKW(P0,14), pw1); \
    VRD(2); SBAR(); GAPA(C0=__builtin_amdgcn_mfma_f32_32x32x16_bf16(kf[4],qr[2],C0,0,0,0),   P1[2],P1[3],P1[4],P1[5],     pw2[0]=PKW(P1,0), pw2[1]=PKW(P1,2), pw2); \
    VRD(6); SBAR(); GAPA(C1=__builtin_amdgcn_mfma_f32_32x32x16_bf16(kf[5],qr[2],C1,0,0,0),   P1[6],P1[7],P1[8],P1[9],     pw2[2]=PKW(P1,4), pw2[3]=PKW(P1,6), pw2); \
    VRD(3); SBAR(); GAPA(C0=__builtin_amdgcn_mfma_f32_32x32x16_bf16(kf[6],qr[3],C0,0,0,0),   P1[10],P1[11],P1[12],P1[13], pw3[0]=PKW(P1,8), pw3[1]=PKW(P1,10), pw3); \
    VRD(7); SBAR(); GAPA(C1=__builtin_amdgcn_mfma_f32_32x32x16_bf16(kf[7],qr[3],C1,0,0,0),   P1[14],P1[15],0.f,0.f,       pw3[2]=PKW(P1,12),pw3[3]=PKW(P1,14), pw3); \
    l_reg+=sacc; \
    if(GK){DMA_K((t)+3,sl_cur);} if(GV){DMA_V((t)+1,sl_next);} \
    CMASK(C0,C1,t); \
    { float a=MX3(C0[0],C0[1],C1[0]),b=MX3(C0[2],C0[3],C1[1]); a=MX3(a,C1[2],C1[3]); \
      _Pragma("unroll") for(int r=4;r<16;r+=4){a=MX3(a,C0[r],C0[r+1]);b=MX3(b,C0[r+2],C0[r+3]);a=MX3(a,C1[r],C1[r+1]);b=MX3(b,C1[r+2],C1[r+3]);} \
      float rm=__builtin_fmaxf(a,b); { auto rr=__builtin_amdgcn_permlane32_swap(__float_as_uint(rm),__float_as_uint(rm),false,false); rm=__builtin_fmaxf(__uint_as_float(rr[0]),__uint_as_float(rr[1])); } \
      resc=false; \
      if(__builtin_expect(__any(rm>(float)THRL),0)){ const float dl=__builtin_fmaxf(rm,0.f); \
        _Pragma("unroll") for(int r=0;r<16;++r){C0[r]-=dl;C1[r]-=dl;} \
        bm-=dl; \
        const float f=__builtin_amdgcn_exp2f(-dl); l_reg*=f; if(hi==0)wsf[r32]=f; resc=true; } } \
    SBAR(); \
    GAPB(o[0]=__builtin_amdgcn_mfma_f32_32x32x16_bf16(PAF(0),VFR(0),o[0],0,0,0), C0,0); \
    GAPB(o[1]=__builtin_amdgcn_mfma_f32_32x32x16_bf16(PAF(0),VFR(4),o[1],0,0,0), C0,4); \
    KRD(GL,0); GAPB(o[0]=__builtin_amdgcn_mfma_f32_32x32x16_bf16(PAF(1),VFR(1),o[0],0,0,0), C0,8); \
    KRD(GL,1); GAPB(o[1]=__builtin_amdgcn_mfma_f32_32x32x16_bf16(PAF(1),VFR(5),o[1],0,0,0), C0,12); \
    KRD(GL,2); GAPB(o[0]=__builtin_amdgcn_mfma_f32_32x32x16_bf16(PAF(2),VFR(2),o[0],0,0,0), C1,0); \
    KRD(GL,3); GAPB(o[1]=__builtin_amdgcn_mfma_f32_32x32x16_bf16(PAF(2),VFR(6),o[1],0,0,0), C1,4); \
    GAPB(o[0]=__builtin_amdgcn_mfma_f32_32x32x16_bf16(PAF(3),VFR(3),o[0],0,0,0), C1,8); \
    GAPB(o[1]=__builtin_amdgcn_mfma_f32_32x32x16_bf16(PAF(3),VFR(7),o[1],0,0,0), C1,12); \
    if(GL){ CPRE(P0,P1,(t)+1); SBAR(); } \
    }while(0)
  int t=1;
  #undef CMASK
  #define CMASK(P0,P1,t) do{}while(0)
  for(;t+5<NT;t+=2){
    STEP(pB0,pB1,pA0,pA1,t,true,true,true);     WAIT_BAR(2); RESC(); ROT();
    STEP(pA0,pA1,pB0,pB1,t+1,true,true,true);   WAIT_BAR(2); RESC(); ROT();
  }
  #undef CMASK
  #define CMASK(P0,P1,t) do{int jb_=(t)-(NT-4); if(jb_>=0)cmask(P0,P1,jb_,qrel,hi);}while(0)
  #define ENDW(tt) do{ if((tt)+3<NT){WAIT_BAR(2);} else if((tt)+2<NT){WAIT_BAR(1);} else {WAIT_BAR(0);} }while(0)
  for(;t+1<NT;t+=2){
    STEP(pB0,pB1,pA0,pA1,t,(t+3<NT),(t+1<NT),(t+1<NT));       ENDW(t);   RESC(); ROT();
    STEP(pA0,pA1,pB0,pB1,t+1,(t+4<NT),(t+2<NT),(t+2<NT));     ENDW(t+1); RESC(); ROT();
  }
  STEP(pB0,pB1,pA0,pA1,NT-1,false,false,false); RESC();
  { float sacc=pB0[0]+pB0[1]; _Pragma("unroll") for(int r=2;r<16;++r)sacc+=pB0[r]; _Pragma("unroll") for(int r=0;r<16;++r)sacc+=pB1[r]; l_reg+=sacc;
    pw0=(u32x4){PKW(pB0,0),PKW(pB0,2),PKW(pB0,4),PKW(pB0,6)};pw1=(u32x4){PKW(pB0,8),PKW(pB0,10),PKW(pB0,12),PKW(pB0,14)};pw2=(u32x4){PKW(pB1,0),PKW(pB1,2),PKW(pB1,4),PKW(pB1,6)};pw3=(u32x4){PKW(pB1,8),PKW(pB1,10),PKW(pB1,12),PKW(pB1,14)};
    SBAR(); pv(o,vb0+sl_cur,PAF(0),PAF(1),PAF(2),PAF(3)); }
  #undef PKW
  #undef PAF
  #undef VFR
  #undef PIN
  #undef MX3
  #undef GAPA
  #undef GAPB
  #undef EX
  #undef VRD
  #undef KRD
  #undef STEP
  #undef ENDW
  {auto rr=__builtin_amdgcn_permlane32_swap(__float_as_uint(l_reg),__float_as_uint(l_reg),false,false);l_reg=__uint_as_float(rr[0])+__uint_as_float(rr[1]);}
  if(hi==0)wsf[32+r32]=l_reg;asm volatile("s_waitcnt lgkmcnt(0)":::"memory");
  float rli[16];
  #pragma unroll
  for(int r=0;r<16;++r)rli[r]=__builtin_amdgcn_rcpf(wsf[32+crow(r,hi)]);
  bf16*Ow=O+(rowbase+q0+wid*QBLK)*DM+h*D;
  { bf16*stg=(bf16*)(shm+LDS_OST)+wid*2048;
    #pragma unroll
    for(int r=0;r<16;++r){const int orow=crow(r,hi);
      #pragma unroll
      for(int d0=0;d0<2;++d0)stg[orow*64+d0*32+r32]=(bf16)f2bf(o[d0][r]*rli[r]);}
    asm volatile("s_waitcnt lgkmcnt(0)":::"memory");
    #pragma unroll
    for(int i=0;i<4;++i){const int row=i*8+(lane>>3),ch=lane&7; const u32x4 v=*(const u32x4*)(stg+row*64+ch*8); ATTN_STORE16(Ow+(long)row*DM+ch*8,v);} }
  asm volatile("s_waitcnt lgkmcnt(0)\n\ts_barrier":::"memory");
  #undef DMA_K
  #undef DMA_V
  #undef CMASK
  #undef START
  #undef RESC
  #undef ROT
  #undef CPRE
  #undef CFIN
}
constexpr int ATTN_LDS_BYTES=LDS_BYTES;
struct AttnTensors { const bf16* Q; const bf16* K; const bf16* V; bf16* O; };
struct AttnUnit { int bh; int qb; };
struct StaticOrder {
  int vcu;
  __device__ __forceinline__ explicit StaticOrder(int grid,int block):vcu((grid%8==0)?(block%8)*(grid/8)+block/8:block){}
  __device__ __forceinline__ bool next(int i,AttnUnit&u)const{ if(i>=4)return false; const int s=vcu&1; u.bh=vcu>>1; u.qb=(i==0)?7-s:(i==1)?s:(i==2)?4+s:3-s; return u.bh<BATCH*NHEAD; }
};
template<class Sched,int THRL=8> __device__ __forceinline__ void attn_phase(int tid,char*lds,const AttnTensors&T,const float*CUM,const Sched&S){
  AttnUnit u;
  for(int i=0;S.next(i,u);++i){ attn_unit<THRL>(tid,u.bh/NHEAD,u.bh%NHEAD,u.qb,T.Q,T.K,T.V,T.O,CUM+(size_t)u.bh*SEQ,lds); }
}
#undef SBAR
#undef WAIT_BAR
}

#ifndef USE8_FOX
#define USE8_FOX 1
#endif
__device__ __forceinline__ void p_proj(const Ctx& C, int layer) {
    const int j = layer >> 1; const bool fox = layer & 1;
    const float* st = layer ? C.stats(2 * (layer - 1) + 1) : nullptr;
    const float* cs = C.vec(V_PROJ_CS) + layer * FOX_NALL; const float* cb = C.vec(V_PROJ_CB) + layer * FOX_NALL;
    const bf16* Z = C.Z(); bf16 *Q = C.Q(), *Kp = C.Kb(), *Vp = C.Vb();
    const bf16* W = fox ? (const bf16*)(C.ws + WS_WIN_FOX) + (size_t)j * FOX_N * 1024 : (const bf16*)(C.ws + WS_WIN_SWA) + (size_t)j * SWA_N * 1024;
    const int N = fox ? FOX_N : SWA_N;
    sgemm<false, 1024>(C.lane, C.gw, C.ngw, M / 32, N / 32,
        [](int, int) { return NoTile{}; },
        [=](NoTile, int r) { return Z + (size_t)r * D; },
        [=](NoTile, int n, int k, int) { return W + (size_t)n * D + k; },
        [=](NoTile, int r, int c, float v, float) {
            const f32x2 ms = row_stats(st, r); const float x = ms.y * (v - ms.x * cs[c]) + cb[c];
            if (fox) { const int t = c >> 10, cc = c & 1023; bf16* dst = Q + (size_t)t * ((WS_K - WS_Q) / 2); dst[(size_t)r * 1024 + cc] = (bf16)f2bf(t == 0 ? x * C2 : x); }
            else { if (c < 1024) Q[(size_t)r * 1024 + c] = (bf16)f2bf(x * C2); else if (c < 1280) Kp[(size_t)r * 256 + c - 1024] = (bf16)f2bf(x); else Vp[(size_t)r * 256 + c - 1280] = (bf16)f2bf(x); }
        });
    if (fox) {
        const bf16* WF = (const bf16*)(C.ws + WS_WF) + (size_t)j * 16 * 1024; float* LG = (float*)(C.ws + WS_LG);
        const int lr = C.lane & 15, lq = C.lane >> 4;
        for (int t = C.gw; t < M / 16; t += C.ngw) {
            const int r0 = t * 16; const f32x4 acc = thin16(Z, r0, WF, C.lane);
            const float bf_ = C.fox_b_f[j * 16 + lr], csv = cs[FOX_N + lr], cbv = cb[FOX_N + lr];
            f32x4 o;
#pragma unroll
            for (int rg = 0; rg < 4; ++rg) { const int r = r0 + 4 * lq + rg; const f32x2 ms = row_stats(st, r);
                const float xg = ms.y * (acc[rg] - ms.x * csv) + cbv + bf_;
                o[rg] = fminf(xg, 0.f) - log1pf(expf(-fabsf(xg))); }
            const int b = r0 / S, s = (r0 % S) + 4 * lq;
            *(f32x4*)(LG + (size_t)(b * 16 + lr) * S + s) = o;
        }
    }
}
__device__ __forceinline__ void p_rope_or_scan(const Ctx& C, int layer) {
    if (!(layer & 1)) {
        const float* T = (const float*)(C.ws + WS_ROPE); bf16 *Q = C.Q(), *Kp = C.Kb();
        const int nth = C.nwg * 512, gt = C.wg * 512 + C.tid;
        for (int i = gt; i < M * 20 * 8; i += nth) { const int jj = i & 7, hs = (i >> 3) % 20, r = i / 160, pos = r % S;
            bf16* p = hs < 16 ? Q + (size_t)r * 1024 + hs * 64 + jj : Kp + (size_t)r * 256 + (hs - 16) * 64 + jj;
            const float x1 = bf2f(p[0]), x2 = bf2f(p[8]), cs = T[pos * 8 + jj], sn = T[S * 8 + pos * 8 + jj];
            p[0] = (bf16)f2bf(x1 * cs - x2 * sn); p[8] = (bf16)f2bf(x2 * cs + x1 * sn); }
    } else {
        const float* LG = (const float*)(C.ws + WS_LG); float* CU = (float*)(C.ws + WS_CUM);
        for (int bh = C.gw; bh < NB * 16; bh += C.ngw) {
            double carry = 0.0;
            for (int ch = 0; ch < S / 64; ++ch) { double v = (double)LG[(size_t)bh * S + ch * 64 + C.lane];
#pragma unroll
                for (int o = 1; o < 64; o <<= 1) { const double u = __shfl_up(v, o); if (C.lane >= o) v += u; }
                v += carry; CU[(size_t)bh * S + ch * 64 + C.lane] = (float)(v * (double)LOG2E); carry = __shfl(v, 63); }
        }
    }
}
__device__ __forceinline__ void p_attn_fox8(const Ctx& C) {
    const fox::AttnTensors AT{(const fox::bf16*)C.Q(), (const fox::bf16*)C.Kb(), (const fox::bf16*)C.Vb(), (fox::bf16*)C.Q()};
    const fox::StaticOrder S(C.nwg, C.wg);
    fox::attn_phase<fox::StaticOrder>(C.tid, C.ldsg, AT, (const float*)(C.ws + WS_CUM), S);
}
__device__ __forceinline__ void p_attn(const Ctx& C, int layer) {
    const int j = layer >> 1; bf16* Q = C.Q(); const bf16 *Kp = C.Kb(), *Vp = C.Vb(); const int lane = C.lane;
    if (!(layer & 1)) {
        for (int t = C.gw; t < M * 16; t += C.ngw) {
            const int r = t >> 4, h = t & 15, kh = h >> 2, b = r / S, pos = r % S;
            float q[64];
#pragma unroll
            for (int d0 = 0; d0 < 8; ++d0) { const bf16x8 v = *(const bf16x8*)(Q + (size_t)r * 1024 + h * 64 + d0 * 8);
#pragma unroll
                for (int e = 0; e < 8; ++e) q[d0 * 8 + e] = bf2f((bf16)v[e]); }
            float sc[2]; int srow[2];
#pragma unroll
            for (int u = 0; u < 2; ++u) { const int s = pos - 127 + 64 * u + lane; srow[u] = b * S + (s < 0 ? 0 : s); float a = 0.f;
#pragma unroll
                for (int d0 = 0; d0 < 8; ++d0) { const bf16x8 v = *(const bf16x8*)(Kp + (size_t)srow[u] * 256 + kh * 64 + d0 * 8);
#pragma unroll
                    for (int e = 0; e < 8; ++e) a += q[d0 * 8 + e] * bf2f((bf16)v[e]); }
                sc[u] = s < 0 ? -INFINITY : a; }
            const float sink2 = C.swa_sinks[j * 16 + h] * LOG2E;
            const float m = fmaxf(wave_max(fmaxf(sc[0], sc[1])), sink2);
            const float p0 = exp2f(sc[0] - m), p1 = exp2f(sc[1] - m);
            const float l = wave_sum(p0 + p1) + exp2f(sink2 - m);
            float o = 0.f;
            for (int i = 0; i < 64; ++i) { const float pa = __shfl(p0, i), pb = __shfl(p1, i); const int ra = __shfl(srow[0], i), rb = __shfl(srow[1], i);
                o += pa * bf2f(Vp[(size_t)ra * 256 + kh * 64 + lane]) + pb * bf2f(Vp[(size_t)rb * 256 + kh * 64 + lane]); }
            Q[(size_t)r * 1024 + h * 64 + lane] = (bf16)f2bf(o / l);
        }
    } else {
        const float* CU = (const float*)(C.ws + WS_CUM); LAS float* sc = (LAS float*)(C.lds + C.wave * 8192);
        for (int t = C.gw; t < M * 16; t += C.ngw) {
            const int r = t >> 4, h = t & 15, b = r / S, pos = r % S, nk = pos + 1; const float* cu = CU + (size_t)(b * 16 + h) * S;
            float q[64];
#pragma unroll
            for (int d0 = 0; d0 < 8; ++d0) { const bf16x8 v = *(const bf16x8*)(Q + (size_t)r * 1024 + h * 64 + d0 * 8);
#pragma unroll
                for (int e = 0; e < 8; ++e) q[d0 * 8 + e] = bf2f((bf16)v[e]); }
            const float ct = cu[pos]; float mx = -INFINITY;
            for (int s = lane; s < nk; s += 64) { float a = 0.f;
#pragma unroll
                for (int d0 = 0; d0 < 8; ++d0) { const bf16x8 v = *(const bf16x8*)(Kp + (size_t)(b * S + s) * 1024 + h * 64 + d0 * 8);
#pragma unroll
                    for (int e = 0; e < 8; ++e) a += q[d0 * 8 + e] * bf2f((bf16)v[e]); }
                a += ct - cu[s]; sc[s] = a; mx = fmaxf(mx, a); }
            const float m = wave_max(mx); float sum = 0.f;
            for (int s = lane; s < nk; s += 64) { const float p = exp2f(sc[s] - m); sc[s] = p; sum += p; }
            const float l = wave_sum(sum);
            LDS_WAIT(); asm volatile("" ::: "memory");
            float o = 0.f; const bf16* vp = Vp + (size_t)(b * S) * 1024 + h * 64 + lane;
            int s = 0;
            for (; s + 4 <= nk; s += 4) { const float v0 = bf2f(vp[(size_t)s * 1024]), v1 = bf2f(vp[(size_t)(s + 1) * 1024]), v2 = bf2f(vp[(size_t)(s + 2) * 1024]), v3 = bf2f(vp[(size_t)(s + 3) * 1024]);
                o += sc[s] * v0; o += sc[s + 1] * v1; o += sc[s + 2] * v2; o += sc[s + 3] * v3; }
            for (; s < nk; ++s) o += sc[s] * bf2f(vp[(size_t)s * 1024]);
            Q[(size_t)r * 1024 + h * 64 + lane] = (bf16)f2bf(o / l);
            LDS_WAIT(); asm volatile("" ::: "memory");
        }
    }
}
__device__ __forceinline__ void p_oproj(const Ctx& C, int layer) {
    const float* stp = layer ? C.stats(2 * (layer - 1) + 1) : nullptr;
    const float* gp = layer ? C.ln_g + ((layer - 1) * 2 + 1) * 1024 : nullptr; const float* bp = layer ? C.ln_b + ((layer - 1) * 2 + 1) * 1024 : nullptr;
    const bf16* O = C.Q(); bf16* Z = C.Z(); const bf16* W = (const bf16*)(C.ws + WS_WO) + (size_t)layer * 1024 * 1024;
    sgemm<false, 1024>(C.lane, C.gw, C.ngw, M / 32, D / 32,
        [](int, int) { return NoTile{}; },
        [=](NoTile, int r) { return O + (size_t)r * D; },
        [=](NoTile, int n, int k, int) { return W + (size_t)n * D + k; },
        [=](NoTile, int r, int c, float v, float) {
            const f32x2 ms = row_stats(stp, r); const float zb = bf2f(Z[(size_t)r * D + c]);
            const float xin = gp ? (zb - ms.x) * ms.y * gp[c] + bp[c] : zb;
            Z[(size_t)r * D + c] = (bf16)f2bf(ALPHA * xin + v);
        });
}
__device__ __forceinline__ void p_stats(const Ctx& C, int inst) {
    const bf16* Z = C.Z(); float* st = C.stats(inst);
    for (int r = C.gw; r < M; r += C.ngw) {
        const bf16x8 a = *(const bf16x8*)(Z + (size_t)r * D + C.lane * 16), b = *(const bf16x8*)(Z + (size_t)r * D + C.lane * 16 + 8);
        float s = 0.f, q = 0.f;
#pragma unroll
        for (int e = 0; e < 8; ++e) { const float x = bf2f((bf16)a[e]), y = bf2f((bf16)b[e]); s += x + y; q += x * x + y * y; }
        s = wave_sum(s); q = wave_sum(q);
        float zf = 0.f; asm volatile("" : "+v"(zf));
        if (C.lane == 0) { *(f32x4*)(st + (size_t)r * 8) = (f32x4){s, q, zf, zf}; *(f32x4*)(st + (size_t)r * 8 + 4) = (f32x4){zf, zf, zf, zf}; }
    }
}
__device__ __forceinline__ void p_router(const Ctx& C, int layer) {
    const float* st = C.stats(2 * layer); const bf16* Z = C.Z(); const bf16* WR = (const bf16*)(C.ws + WS_WR) + (size_t)layer * 16 * 1024;
    const float* cs = C.vec(V_RT_CS) + layer * 16; const float* cb = C.vec(V_RT_CB) + layer * 16;
    LAS float* lg = (LAS float*)(C.lds + C.wave * 1280);
    LAS int* hist = (LAS int*)(C.lds + 16384); LAS int* base = hist + 32;
    unsigned* gcnt = C.ctl() + CW_CNT + 32 * layer; int* cls_o = C.cls(); f32x2* gates = C.gates(); int* list = C.list();
    const int lane = C.lane, lr = lane & 15, lq = lane >> 4;
    for (int blk = C.wg; blk < M / 64; blk += C.nwg) {
        if (C.tid < 32) hist[C.tid] = 0;
        __syncthreads();
        int tok = -1, cl = 0, lslot = 0;
        if (C.wave < 4) {
            const int r0 = blk * 64 + C.wave * 16; const f32x4 acc = thin16(Z, r0, WR, lane);
            const float csv = cs[lr], cbv = cb[lr] + C.b_router[lr];
#pragma unroll
            for (int rg = 0; rg < 4; ++rg) { const int row = 4 * lq + rg; const f32x2 ms = row_stats(st, r0 + row); lg[row * 17 + lr] = ms.y * (acc[rg] - ms.x * csv) + cbv; }
            LDS_WAIT(); asm volatile("" ::: "memory");
            if (lane < 16) {
                float l[16], mx = -INFINITY;
#pragma unroll
                for (int e = 0; e < 16; ++e) { l[e] = lg[lane * 17 + e]; mx = fmaxf(mx, l[e]); }
#pragma unroll
                for (int e = 0; e < 16; ++e) l[e] = expf(l[e] - mx);
                float gs[4];
#pragma unroll
                for (int g = 0; g < 4; ++g) { const float a0 = l[4 * g], a1 = l[4 * g + 1], a2 = l[4 * g + 2], a3 = l[4 * g + 3];
                    gs[g] = fmaxf(fmaxf(fmaxf(a0 + a1, a0 + a2), fmaxf(a0 + a3, a1 + a2)), fmaxf(a1 + a3, a2 + a3)); }
                int best = 0; float bv = gs[0];
#pragma unroll
                for (int g = 1; g < 4; ++g) if (gs[g] > bv) { bv = gs[g]; best = g; }
                float a[4];
#pragma unroll
                for (int k = 0; k < 4; ++k) a[k] = best == 0 ? l[k] : (best == 1 ? l[4 + k] : (best == 2 ? l[8 + k] : l[12 + k]));
                int i1 = 0; float v1 = a[0];
#pragma unroll
                for (int k = 1; k < 4; ++k) if (a[k] > v1) { v1 = a[k]; i1 = k; }
                int i2 = -1; float v2 = -1.f;
#pragma unroll
                for (int k = 0; k < 4; ++k) if (k != i1 && a[k] > v2) { v2 = a[k]; i2 = k; }
                const int lo = i1 < i2 ? i1 : i2, hi = i1 < i2 ? i2 : i1;
                const int pidx = lo == 0 ? hi - 1 : (lo == 1 ? hi + 1 : 5);
                const float inv = 1.f / (v1 + v2), g1 = v1 * inv, g2 = v2 * inv;
                cl = best * 6 + pidx; tok = r0 + lane;
                cls_o[tok] = cl; gates[tok] = i1 < i2 ? (f32x2){g1, g2} : (f32x2){g2, g1};
                lslot = atomicAdd((int*)(hist + cl), 1);
            }
        }
        __syncthreads();
        if (C.tid < NCLS) base[C.tid] = (int)atomicAdd(gcnt + C.tid, (unsigned)hist[C.tid]);
        __syncthreads();
        if (tok >= 0) list[cl * M + base[cl] + lslot] = tok;
        __syncthreads();
    }
}
struct ClsTile { int c, base, cnt, e1, e2; };
__device__ __forceinline__ int cls_layout(const Ctx& C, int layer, LAS int* cbase  , LAS int* ccnt  ) {
    if (C.tid == 0) { const unsigned* gcnt = C.ctl() + CW_CNT + 32 * layer; int acc = 0;
#pragma unroll 1
        for (int c = 0; c < NCLS; ++c) { const int n = (int)__hip_atomic_load(gcnt + c, RLX_AGENT); cbase[c] = acc; ccnt[c] = n; acc += (n + 255) & ~255; }
        cbase[NCLS] = acc; }
    __syncthreads();
    return cbase[NCLS];
}
__device__ __forceinline__ ClsTile find_cls(const LAS int* cbase, const LAS int* ccnt, int R0) {
    ClsTile t; t.c = 0;
#pragma unroll 1
    for (int c = 1; c < NCLS; ++c) if (R0 >= cbase[c]) t.c = c;
    t.base = cbase[t.c]; t.cnt = ccnt[t.c]; cls_experts(t.c, t.e1, t.e2); return t;
}
__device__ __forceinline__ void p_moe_up(const Ctx& C, int layer) {
    LAS int* cbase = (LAS int*)(C.lds + 32768); LAS int* ccnt = cbase + 32;
    const int rows = cls_layout(C, layer, cbase, ccnt);
    const float* st = C.stats(2 * layer); const bf16* Z = C.Z(); bf16* ACT = C.ACT(); const int* list = C.list(); const f32x2* gates = C.gates();
    const bf16* WGU = (const bf16*)(C.ws + WS_WGU) + (size_t)layer * 16 * 512 * 1024;
    const float* gcs = C.vec(V_GU_CS) + layer * 16 * 512; const float* gcb = C.vec(V_GU_CB) + layer * 16 * 512;
    sgemm<true, 1024>(C.lane, C.gw, C.ngw, rows / 32, 512 / 32,
        [=](int tm, int) { return find_cls(cbase, ccnt, tm * 32); },
        [=](const ClsTile& t, int R) { const int li = R - t.base; const int tok = list[t.c * M + (li < t.cnt ? li : 0)]; return Z + (size_t)tok * D; },
        [=](const ClsTile& t, int n, int k, int which) { const int e = (n >> 8) ? t.e2 : t.e1, f = n & 255; return WGU + ((size_t)e * 512 + (f >> 7) * 256 + which * 128 + (f & 127)) * D + k; },
        [=](const ClsTile& t, int R, int n, float vg, float vu) {
            const int li = R - t.base; const bool valid = li < t.cnt; const int tok = list[t.c * M + (valid ? li : 0)];
            const int wh = n >> 8, e = wh ? t.e2 : t.e1, f = n & 255, row = (f >> 7) * 256 + (f & 127);
            const f32x2 ms = row_stats(st, tok);
            const float hg = ms.y * (vg - ms.x * gcs[e * 512 + row]) + gcb[e * 512 + row], hu = ms.y * (vu - ms.x * gcs[e * 512 + row + 128]) + gcb[e * 512 + row + 128];
            const f32x2 gt = gates[tok]; const float gate = wh ? gt.y : gt.x;
            const float act = valid ? hg / (1.f + expf(-hg)) * hu * gate : 0.f;
            ACT[(size_t)R * 512 + n] = (bf16)f2bf(act);
        });
}
__device__ __forceinline__ void p_moe_down(const Ctx& C, int layer) {
    LAS int* cbase = (LAS int*)(C.lds + 32768); LAS int* ccnt = cbase + 32;
    const int rows = cls_layout(C, layer, cbase, ccnt);
    const float* st = C.stats(2 * layer); const float* g1 = C.ln_g + (layer * 2) * 1024; const float* b1 = C.ln_b + (layer * 2) * 1024;
    bf16* Z = C.Z(); const bf16* ACT = C.ACT(); const int* list = C.list();
    const bf16* WD = (const bf16*)(C.ws + WS_WD) + (size_t)layer * 16 * 1024 * 256;
    sgemm<false, 512>(C.lane, C.gw, C.ngw, rows / 32, D / 32,
        [=](int tm, int) { return find_cls(cbase, ccnt, tm * 32); },
        [=](const ClsTile&, int R) { return ACT + (size_t)R * 512; },
        [=](const ClsTile& t, int n, int k, int) { return WD + ((size_t)(k < 256 ? t.e1 : t.e2) * 1024 + n) * 256 + (k & 255); },
        [=](const ClsTile& t, int R, int n, float v, float) {
            const int li = R - t.base; if (li >= t.cnt) return; const int tok = list[t.c * M + li];
            const f32x2 ms = row_stats(st, tok); const float zb = bf2f(Z[(size_t)tok * D + n]);
            const float x1 = (zb - ms.x) * ms.y * g1[n] + b1[n];
            Z[(size_t)tok * D + n] = (bf16)f2bf(ALPHA * x1 + v);
        });
}
__device__ __forceinline__ void p_proj8(const Ctx& C, int layer) {
    const int j = layer >> 1; const bool fox = layer & 1;
    const float* st = layer ? C.stats(2 * (layer - 1) + 1) : nullptr;
    const float* cs = C.vec(V_PROJ_CS) + layer * FOX_NALL; const float* cb = C.vec(V_PROJ_CB) + layer * FOX_NALL;
    const bf16* Z = C.Z();
    const bf16* W = fox ? (const bf16*)(C.ws + WS_WIN_FOX) + (size_t)j * FOX_N * 1024 : (const bf16*)(C.ws + WS_WIN_SWA) + (size_t)j * SWA_N * 1024;
    const int N = fox ? FOX_N : SWA_N;
    { pg8::ProbPlain P{Z, W, M / 256, N / 256, C.nwg, C.wg}; pg8::EpiProj E{fox, st, cs, cb, (const float*)(C.ws + WS_ROPE), C.Q()}; pg8::gemm_phase(C, P, E); }
    if (fox) {
        const bf16* WF = (const bf16*)(C.ws + WS_WF) + (size_t)j * 16 * 1024; float* LG = (float*)(C.ws + WS_LG);
        const int lr = C.lane & 15, lq = C.lane >> 4;
        for (int t = C.gw; t < M / 16; t += C.ngw) {
            const int r0 = t * 16; const f32x4 acc = thin16(Z, r0, WF, C.lane);
            const float bf_ = C.fox_b_f[j * 16 + lr], csv = cs[FOX_N + lr], cbv = cb[FOX_N + lr];
            f32x4 o;
#pragma unroll
            for (int rg = 0; rg < 4; ++rg) { const int r = r0 + 4 * lq + rg; const f32x2 ms = row_stats(st, r);
                const float xg = ms.y * (acc[rg] - ms.x * csv) + cbv + bf_;
                o[rg] = fminf(xg, 0.f) - log1pf(expf(-fabsf(xg))); }
            const int b = r0 / S, s = (r0 % S) + 4 * lq;
            *(f32x4*)(LG + (size_t)(b * 16 + lr) * S + s) = o;
        }
    }
}
__device__ __forceinline__ void p_oproj8(const Ctx& C, int layer) {
    const float* stp = layer ? C.stats(2 * (layer - 1) + 1) : nullptr;
    const float* gp = layer ? C.ln_g + ((layer - 1) * 2 + 1) * 1024 : nullptr; const float* bp = layer ? C.ln_b + ((layer - 1) * 2 + 1) * 1024 : nullptr;
    pg8::ProbPlain P{C.Q(), (const bf16*)(C.ws + WS_WO) + (size_t)layer * 1024 * 1024, M / 256, D / 256, C.nwg, C.wg};
    pg8::EpiOut E{stp, gp, bp, C.Z(), C.stats(2 * layer)};
    pg8::gemm_phase(C, P, E);
}
__device__ __forceinline__ void p_moe_up8(const Ctx& C, int layer) {
    LAS int* cbase = (LAS int*)(C.lds + pg8::LDS_CLS); LAS int* ccnt = cbase + 32;
    const int rows = cls_layout(C, layer, cbase, ccnt);
    pg8::ProbUp P{C.Z(), (const bf16*)(C.ws + WS_WGU) + (size_t)layer * 16 * 512 * 1024, C.list(), cbase, ccnt, rows / 256, C.nwg, C.wg};
    pg8::EpiUp E{C.stats(2 * layer), C.list(), C.gates(), C.vec(V_GU_CS) + layer * 16 * 512, C.vec(V_GU_CB) + layer * 16 * 512, C.ACT()};
    pg8::gemm_phase(C, P, E);
}
__device__ __forceinline__ void p_moe_down8(const Ctx& C, int layer) {
    LAS int* cbase = (LAS int*)(C.lds + pg8::LDS_CLS); LAS int* ccnt = cbase + 32;
    const int rows = cls_layout(C, layer, cbase, ccnt);
    pg8::ProbDown P{C.ACT(), (const bf16*)(C.ws + WS_WD) + (size_t)layer * 16 * 1024 * 256, cbase, ccnt, rows / 256, C.nwg, C.wg};
    pg8::EpiDown E{C.stats(2 * layer), C.ln_g + (layer * 2) * 1024, C.ln_b + (layer * 2) * 1024, C.list(), C.Z(), C.stats(2 * layer + 1)};
    pg8::gemm_phase(C, P, E);
}
__device__ __forceinline__ void p_final(const Ctx& C) {
    const float* st = C.stats(7); const float* g = C.ln_g + 7 * 1024; const float* b = C.ln_b + 7 * 1024; const bf16* Z = C.Z();
    for (int r = C.gw; r < M; r += C.ngw) {
        const f32x2 ms = row_stats(st, r);
#pragma unroll
        for (int u = 0; u < 2; ++u) { const int c0 = u * 512 + C.lane * 8; const bf16x8 a = *(const bf16x8*)(Z + (size_t)r * D + c0);
            const f32x4 g0 = *(const f32x4*)(g + c0), g1 = *(const f32x4*)(g + c0 + 4), b0 = *(const f32x4*)(b + c0), b1 = *(const f32x4*)(b + c0 + 4);
            f32x4 o0, o1;
#pragma unroll
            for (int e = 0; e < 4; ++e) { o0[e] = (bf2f((bf16)a[e]) - ms.x) * ms.y * g0[e] + b0[e]; o1[e] = (bf2f((bf16)a[4 + e]) - ms.x) * ms.y * g1[e] + b1[e]; }
            *(f32x4*)(C.out + (size_t)r * D + c0) = o0; *(f32x4*)(C.out + (size_t)r * D + c0 + 4) = o1; }
    }
}

__device__ __forceinline__ int fresh_lane() { int l; asm volatile("v_mbcnt_lo_u32_b32 %0, -1, 0\n\tv_mbcnt_hi_u32_b32 %0, -1, %0" : "=v"(l)); return l; }
constexpr int PH_PER_LAYER = 9, N_PHASES = 1 + DEPTH * PH_PER_LAYER + 1;
__global__ void __launch_bounds__(NWAVES * 64, 2) mk_fwd(Args args) {
    extern __shared__ __attribute__((aligned(16))) unsigned char lds_raw[];
    const int tid0 = threadIdx.x;
#define BUILD_CTX(C, ap) Ctx C; C.x = ap->in[0]; C.ln_g = ap->in[1]; C.ln_b = ap->in[2]; C.swa_w_in = ap->in[3]; C.swa_sinks = ap->in[4]; C.swa_w_o = ap->in[5]; C.fox_w_in = ap->in[6]; \
    C.fox_b_f = ap->in[7]; C.fox_w_o = ap->in[8]; C.w_router = ap->in[9]; C.b_router = ap->in[10]; C.w_gate = ap->in[11]; C.w_up = ap->in[12]; C.w_down = ap->in[13]; \
    C.out = ap->out; C.ws = ap->ws; C.lds = (LAS unsigned char*)lds_raw; C.ldsg = (char*)lds_raw; \
    C.tid = tidv; C.lane = C.tid & 63; C.wave = __builtin_amdgcn_readfirstlane(C.tid >> 6); C.wg = wgv; C.nwg = gridDim.x; C.gw = C.wg * NWAVES + C.wave; C.ngw = C.nwg * NWAVES;
    LAS unsigned char* const lds0 = (LAS unsigned char*)lds_raw;
    volatile LAS unsigned* MISC = (volatile LAS unsigned*)(lds0 + MISC_OFF);
    if (tid0 < 32) MISC[tid0] = 0u;
    __syncthreads();
    unsigned* const ctl0 = (unsigned*)(args.ws + WS_CTL);
    XcdBarrier bar; bar.bar = ctl0 + CW_BAR; bar.x = 0; bar.st = nullptr;
    const bool one = (args.ph_hi - args.ph_lo) > 1;
    const int waveS = __builtin_amdgcn_readfirstlane(tid0 >> 6);
#define FRESH_TID() (waveS * 64 + fresh_lane())
    if (one) bar = xcd_barrier_post(ctl0 + CW_BAR, MISC + 8, tid0);
    for (int ph = args.ph_lo; ph < args.ph_hi; ++ph) {
#define RUN(body) do { const __attribute__((address_space(4))) Args* ap = (const __attribute__((address_space(4))) Args*)__builtin_amdgcn_kernarg_segment_ptr(); int tidv = FRESH_TID(); int wgv = blockIdx.x; asm volatile("" : "+s"(ap), "+s"(wgv)); asm volatile("" : "+v"(tidv)); BUILD_CTX(C, ap) body; } while (0)
#define CASE(cond, body) do { int ph_ = ph; asm volatile("" : "+s"(ph_)); const int layer = (ph_ - 1) / PH_PER_LAYER, sub = (ph_ - 1) % PH_PER_LAYER; (void)layer; (void)sub; if (cond) { body; } } while (0)
        CASE(ph_ == 0, RUN(p_prologue(C)));
        CASE(ph_ == N_PHASES - 1, RUN(p_final(C)));
        CASE(ph_ > 0 && ph_ < N_PHASES - 1 && sub == 0, if (USE8_PROJ) RUN(p_proj8(C, layer)); else RUN(p_proj(C, layer)));
        CASE(ph_ > 0 && ph_ < N_PHASES - 1 && sub == 1, if (!USE8_PROJ || (layer & 1)) RUN(p_rope_or_scan(C, layer)));
        CASE(ph_ > 0 && ph_ < N_PHASES - 1 && sub == 2, if (USE8_FOX && (layer & 1)) RUN(p_attn_fox8(C)); else RUN(p_attn(C, layer)));
        CASE(ph_ > 0 && ph_ < N_PHASES - 1 && sub == 3, if (USE8_OPROJ) RUN(p_oproj8(C, layer)); else RUN(p_oproj(C, layer)));
        CASE(ph_ > 0 && ph_ < N_PHASES - 1 && sub == 4, if (!USE8_OPROJ) RUN(p_stats(C, 2 * layer)));
        CASE(ph_ > 0 && ph_ < N_PHASES - 1 && sub == 5, RUN(p_router(C, layer)));
        CASE(ph_ > 0 && ph_ < N_PHASES - 1 && sub == 6, if (USE8_UP) RUN(p_moe_up8(C, layer)); else RUN(p_moe_up(C, layer)));
        CASE(ph_ > 0 && ph_ < N_PHASES - 1 && sub == 7, if (USE8_DOWN) RUN(p_moe_down8(C, layer)); else RUN(p_moe_down(C, layer)));
        CASE(ph_ > 0 && ph_ < N_PHASES - 1 && sub == 8, if (!USE8_DOWN) RUN(p_stats(C, 2 * layer + 1)));
        if (ph + 1 < args.ph_hi) xcd_barrier(bar, FRESH_TID());
    }
}

extern "C" void kernel_launch(void* const* d_in, const int* in_sizes, int n_in, void* d_out, int out_size, void* d_ws, size_t ws_size, hipStream_t stream) {
    static int grid = 0;
    if (grid == 0) {
        if (n_in != 14 || in_sizes[0] != M * D || out_size != M * D || ws_size < WS_END) { fprintf(stderr, "kernel_launch: unexpected shapes / workspace (n_in %d, ws %zu)\n", n_in, ws_size); grid = -1; return; }
        int dev = 0, cus = 0, per_cu = 0;
        if (hipGetDevice(&dev) != hipSuccess || hipDeviceGetAttribute(&cus, hipDeviceAttributeMultiprocessorCount, dev) != hipSuccess) { grid = -1; return; }
        if (hipFuncSetAttribute((const void*)mk_fwd, hipFuncAttributeMaxDynamicSharedMemorySize, LDS_BYTES) != hipSuccess) { fprintf(stderr, "kernel_launch: hipFuncSetAttribute failed\n"); grid = -1; return; }
        if (hipOccupancyMaxActiveBlocksPerMultiprocessor(&per_cu, (const void*)mk_fwd, NWAVES * 64, LDS_BYTES) != hipSuccess || per_cu < 1) { fprintf(stderr, "kernel_launch: occupancy query says %d\n", per_cu); per_cu = 1; }
        (void)hipGetLastError();
        grid = cus * 1;
    }
    if (grid < 0) return;
    (void)hipMemsetAsync((char*)d_ws + WS_CTL, 0, CTL_BYTES, stream);
    Args a{};
    for (int i = 0; i < 14; ++i) a.in[i] = (const float*)d_in[i];
    a.out = (float*)d_out; a.ws = (unsigned char*)d_ws;
#if MK_ONE_LAUNCH
    a.ph_lo = 0; a.ph_hi = N_PHASES;
    hipLaunchKernelGGL(mk_fwd, dim3(grid), dim3(NWAVES * 64), LDS_BYTES, stream, a);
#else
    for (int ph = 0; ph < N_PHASES; ++ph) { a.ph_lo = ph; a.ph_hi = ph + 1; hipLaunchKernelGGL(mk_fwd, dim3(grid), dim3(NWAVES * 64), LDS_BYTES, stream, a); }
#endif
}
```

```cpp
#include <hip/hip_runtime.h>
#include <cstdio>
#include <cstdint>
#include <cmath>

#define GAS __attribute__((address_space(1)))
#define LAS __attribute__((address_space(3)))
typedef unsigned short bf16;
typedef short bf16x8 __attribute__((ext_vector_type(8)));
typedef float f32x4 __attribute__((ext_vector_type(4)));
typedef float f32x2 __attribute__((ext_vector_type(2)));
typedef unsigned u32x4 __attribute__((ext_vector_type(4)));
typedef unsigned u32x2 __attribute__((ext_vector_type(2)));
typedef GAS unsigned gu32;

#ifndef MK_ONE_LAUNCH
#define MK_ONE_LAUNCH 1
#endif

constexpr int M = 16384, D = 1024, S = 2048, NB = 8, DEPTH = 4, NE = 16, DE = 256, NCLS = 24;
constexpr int SWA_N = 1536, FOX_N = 3072, FOX_NALL = 3088;
constexpr float ALPHA = 1.6817928305074290f;
constexpr float LOG2E = 1.4426950408889634f;
constexpr float C2 = 0.125f * LOG2E;
constexpr float LN_EPS = 1e-5f;
constexpr int ACT_ROWS = 22528;

constexpr size_t MiB = 1u << 20;
constexpr size_t WS_CTL = 0, CTL_BYTES = 1 * MiB;
constexpr size_t WS_ROPE = 1 * MiB;
constexpr size_t WS_VEC = 2 * MiB;
constexpr size_t V_PROJ_CS = 0, V_PROJ_CB = 64 * 1024, V_RT_CS = 128 * 1024, V_RT_CB = 129 * 1024, V_GU_CS = 256 * 1024, V_GU_CB = 768 * 1024;
constexpr size_t WS_STATS = 4 * MiB;
constexpr size_t STATS_INST = (size_t)M * 8 * 4;
constexpr size_t WS_CLS = 8 * MiB;
constexpr size_t WS_GATES = 8 * MiB + 64 * 1024;
constexpr size_t WS_LIST = 8 * MiB + 256 * 1024;
constexpr size_t WS_LG = 10 * MiB;
constexpr size_t WS_CUM = 11 * MiB;
constexpr size_t WS_WIN_SWA = 12 * MiB;
constexpr size_t WS_WIN_FOX = 18 * MiB;
constexpr size_t WS_WF = 30 * MiB;
constexpr size_t WS_WR = 30 * MiB + 256 * 1024;
constexpr size_t WS_WO = 31 * MiB;
constexpr size_t WS_WGU = 39 * MiB;
constexpr size_t WS_WD = 103 * MiB;
constexpr size_t WS_Z = 135 * MiB;
constexpr size_t WS_Q = 167 * MiB, WS_K = 199 * MiB, WS_V = 231 * MiB;
constexpr size_t WS_ACT = 263 * MiB;
constexpr size_t WS_END = 285 * MiB;
constexpr int CW_TMO = 0, CW_CODE = 1, CW_BAR = 4096, CW_CNT = 16384;

constexpr int LDS_BYTES = 147456;
constexpr int MISC_OFF = 131072 + 320;
constexpr int NWAVES = 8;

#define RLX_AGENT __ATOMIC_RELAXED, __HIP_MEMORY_SCOPE_AGENT
#define LDS_WAIT() asm volatile("s_waitcnt lgkmcnt(0)" ::: "memory")
__device__ __forceinline__ float bf2f(bf16 v) { return __uint_as_float((unsigned)v << 16); }
__device__ __forceinline__ unsigned f2bf(float f) { unsigned u = __float_as_uint(f); return (u + 0x7fffu + ((u >> 16) & 1u)) >> 16; }
__device__ __forceinline__ unsigned pk2(float lo, float hi) { return f2bf(lo) | (f2bf(hi) << 16); }
__device__ __forceinline__ float wave_sum(float v) {
#pragma unroll
    for (int o = 1; o < 64; o <<= 1) v += __shfl_xor(v, o);
    return v;
}
__device__ __forceinline__ float wave_max(float v) {
#pragma unroll
    for (int o = 1; o < 64; o <<= 1) v = fmaxf(v, __shfl_xor(v, o));
    return v;
}
__device__ __forceinline__ f32x4 mfma16(bf16x8 a, bf16x8 b, f32x4 c) { return __builtin_amdgcn_mfma_f32_16x16x32_bf16(a, b, c, 0, 0, 0); }

#define XB_TMO      128
#define XB_XCNT(j)  (256  + 64 * (j))
#define XB_XSUB(j)  (1280 + 64 * (j))
#define XB_XGEN(j)  (2304 + 64 * (j))
#define XB_TOP      3328
#define XB_TOPGEN   3392
#define XCD_BAR_WORDS 3456
#define XB_SPIN_CAP (1u << 18)
__device__ __forceinline__ unsigned xb_ld(unsigned* p)              { return __hip_atomic_load(p, __ATOMIC_RELAXED, __HIP_MEMORY_SCOPE_AGENT); }
__device__ __forceinline__ unsigned xb_add(unsigned* p, unsigned v) { return __hip_atomic_fetch_add(p, v, __ATOMIC_RELAXED, __HIP_MEMORY_SCOPE_AGENT); }
__device__ __forceinline__ unsigned xb_xcc_id() { return (unsigned)__builtin_amdgcn_s_getreg((3 << 11) | 20) & 0xFu; }
#define XB_SPIN(cond, bar) do { unsigned _sp = 0; while (cond) { __builtin_amdgcn_s_sleep(1); \
    if ((++_sp & 255u) == 0u) { if (xb_ld(&(bar)[XB_TMO])) break; if (_sp > XB_SPIN_CAP) { atomicAdd(&(bar)[XB_TMO], 1u); break; } } } } while (0)
struct XcdBarrier { unsigned* bar; unsigned x; volatile LAS unsigned* st; };
__device__ __forceinline__ XcdBarrier xcd_barrier_post(unsigned* bar, volatile LAS unsigned* st, int tid) {
    XcdBarrier b; b.bar = bar; b.x = xb_xcc_id(); b.st = st;
    if (tid == 0) (void)xb_add(&bar[XB_XCNT(b.x)], 1u);
    return b;
}
__device__ __forceinline__ void xcd_barrier_complete(unsigned* bar, unsigned x, unsigned& nloc, unsigned& nx) {
    const unsigned G = gridDim.x * gridDim.y * gridDim.z;
    unsigned sum, cnt, mine, sp = 0u;
    for (;;) {
        sum = 0u; cnt = 0u; mine = 0u;
        asm volatile("" : "+s"(bar), "+s"(x));
#pragma unroll
        for (unsigned j = 0; j < 16; ++j) { const unsigned c = xb_ld(&bar[XB_XCNT(j)]); sum += c; cnt += (c > 0u) ? 1u : 0u; mine = (j == x) ? c : mine; }
        if (sum == G) break;
        __builtin_amdgcn_s_sleep(1);
        if ((++sp & 255u) == 0u) { if (xb_ld(&bar[XB_TMO])) break; if (sp > XB_SPIN_CAP) { atomicAdd(&bar[XB_TMO], 1u); break; } }
    }
    nloc = mine > 0u ? mine : 1u; nx = cnt > 0u ? cnt : 1u;
}
__device__ __forceinline__ void xcd_barrier(const XcdBarrier& b, int tid) {
    asm volatile("s_waitcnt vmcnt(0)" ::: "memory");
    __syncthreads();
    if (tid == 0) {
        unsigned* bar = b.bar;
        __builtin_amdgcn_s_waitcnt(0);
        unsigned nloc = b.st[0], nx = b.st[1];
        if (nloc == 0u) { xcd_barrier_complete(bar, b.x, nloc, nx); b.st[0] = nloc; b.st[1] = nx; }
        const unsigned old = xb_add(&bar[XB_XSUB(b.x)], 1u);
        const unsigned gen = old / nloc;
        if (old + 1u == (gen + 1u) * nloc) {
            __builtin_amdgcn_fence(__ATOMIC_RELEASE, "agent");
            asm volatile("s_waitcnt vmcnt(0)" ::: "memory");
            const unsigned og = xb_add(&bar[XB_TOP], 1u);
            const unsigned tg = og / nx;
            if (og + 1u == (tg + 1u) * nx) xb_add(&bar[XB_TOPGEN], 1u);
            else XB_SPIN(xb_ld(&bar[XB_TOPGEN]) == tg, bar);
            __builtin_amdgcn_fence(__ATOMIC_ACQUIRE, "agent");
            xb_add(&bar[XB_XGEN(b.x)], 1u);
            asm volatile("s_waitcnt vmcnt(0)" ::: "memory");
        } else {
            XB_SPIN(xb_ld(&bar[XB_XGEN(b.x)]) == gen, bar);
            __builtin_amdgcn_fence(__ATOMIC_ACQUIRE, "agent");
            asm volatile("s_waitcnt vmcnt(0)" ::: "memory");
        }
    }
    __syncthreads();
}

struct Args { const float* in[14]; float* out; unsigned char* ws; int ph_lo, ph_hi; };
struct Ctx {
    const float *x, *ln_g, *ln_b, *swa_w_in, *swa_sinks, *swa_w_o, *fox_w_in, *fox_b_f, *fox_w_o, *w_router, *b_router, *w_gate, *w_up, *w_down;
    float* out; unsigned char* ws;
    LAS unsigned char* lds; char* ldsg;
    int tid, lane, wave, wg, nwg, gw, ngw;
    __device__ __forceinline__ bf16* Z() const { return (bf16*)(ws + WS_Z); }
    __device__ __forceinline__ bf16* Q() const { return (bf16*)(ws + WS_Q); }
    __device__ __forceinline__ bf16* Kb() const { return (bf16*)(ws + WS_K); }
    __device__ __forceinline__ bf16* Vb() const { return (bf16*)(ws + WS_V); }
    __device__ __forceinline__ bf16* ACT() const { return (bf16*)(ws + WS_ACT); }
    __device__ __forceinline__ float* stats(int inst) const { return (float*)(ws + WS_STATS + (size_t)inst * STATS_INST); }
    __device__ __forceinline__ float* vec(size_t off) const { return (float*)(ws + WS_VEC + off); }
    __device__ __forceinline__ unsigned* ctl() const { return (unsigned*)(ws + WS_CTL); }
    __device__ __forceinline__ int* cls() const { return (int*)(ws + WS_CLS); }
    __device__ __forceinline__ f32x2* gates() const { return (f32x2*)(ws + WS_GATES); }
    __device__ __forceinline__ int* list() const { return (int*)(ws + WS_LIST); }
};
__device__ __forceinline__ f32x2 row_stats(const float* st, int r) {
    if (!st) return (f32x2){0.f, 1.f};
    const f32x4 a = *(const f32x4*)(st + (size_t)r * 8), b = *(const f32x4*)(st + (size_t)r * 8 + 4);
    const float s = (a[0] + a[2]) + (b[0] + b[2]), q = (a[1] + a[3]) + (b[1] + b[3]);
    const float mu = s * (1.f / D), var = fmaxf(q * (1.f / D) - mu * mu, 0.f);
    return (f32x2){mu, 1.0f / sqrtf(var + LN_EPS)};
}
__device__ __forceinline__ void cls_experts(int c, int& e1, int& e2) {
    const int g = c / 6, p = c % 6;
    const int lo = p < 3 ? 0 : (p < 5 ? 1 : 2), hi = p < 3 ? p + 1 : (p < 5 ? p - 1 : 3);
    e1 = 4 * g + lo; e2 = 4 * g + hi;
}

__constant__ double ROPE_W[16] = {0.5403023058681397174, 0.8414709848078965067, 0.9812558362840285743, 0.1927095839820420340, 0.9992929765482185140, 0.0375971677311151056,
    0.9999734086383661963, 0.007292600096474082358, 0.9999990000001666667, 0.001414213090968621398, 0.9999999623939693048, 0.0002742481722384122054,
    0.9999999985857864380, 0.00005318295894437919888, 0.9999999999468170410, 0.00001031338537702962674};
struct CvtItem { const float* src; int K, N, n0, ncols; bf16* dst; int dpitch; const float* g; const float* b; float* cs; float* cb; };
__device__ __forceinline__ void cvt_item(const CvtItem& it, LAS float* scr, int lane) {
    float cs[4] = {0.f, 0.f, 0.f, 0.f}, cb[4] = {0.f, 0.f, 0.f, 0.f};
    const int c = lane & 7, nb = lane >> 3, ncol = lane & 31; const bool colok = ncol < it.ncols;
    for (int k0 = 0; k0 < it.K; k0 += 64) {
#pragma unroll 8
        for (int i = 0; i < 32; ++i) { const int kk = 2 * i + (lane >> 5); scr[kk * 33 + ncol] = colok ? it.src[(size_t)(k0 + kk) * it.N + it.n0 + ncol] : 0.f; }
        LDS_WAIT(); asm volatile("" ::: "memory");
        float gq[8], bq[8];
#pragma unroll
        for (int q = 0; q < 8; ++q) { gq[q] = it.g ? it.g[k0 + 8 * c + q] : 1.f; bq[q] = it.b ? it.b[k0 + 8 * c + q] : 0.f; }
#pragma unroll
        for (int j = 0; j < 4; ++j) {
            const int n = nb + 8 * j; const LAS float* s = scr + (8 * c) * 33 + n;
            unsigned r[8]; float csp = 0.f, cbp = 0.f;
#pragma unroll
            for (int q = 0; q < 8; ++q) { const float w = s[q * 33]; r[q] = f2bf(w * gq[q]); csp += __uint_as_float(r[q] << 16); cbp += w * bq[q]; }
            cs[j] += csp; cb[j] += cbp;
            if (n < it.ncols) { u32x4 o; o.x = r[0] | (r[1] << 16); o.y = r[2] | (r[3] << 16); o.z = r[4] | (r[5] << 16); o.w = r[6] | (r[7] << 16);
                *(u32x4*)(it.dst + (size_t)n * it.dpitch + k0 + 8 * c) = o; }
        }
        LDS_WAIT(); asm volatile("" ::: "memory");
    }
    if (it.cs) {
#pragma unroll
        for (int j = 0; j < 4; ++j) {
            float a = cs[j], b = cb[j];
            a += __shfl_xor(a, 1); a += __shfl_xor(a, 2); a += __shfl_xor(a, 4);
            b += __shfl_xor(b, 1); b += __shfl_xor(b, 2); b += __shfl_xor(b, 4);
            const int n = nb + 8 * j;
            if (c == 0 && n < it.ncols) { it.cs[n] = a; it.cb[n] = b; }
        }
    }
}
__device__ __forceinline__ CvtItem big_item(const Ctx& C, int idx) {
    CvtItem it; it.K = 1024; it.dpitch = 1024; it.ncols = 32; it.g = nullptr; it.b = nullptr; it.cs = nullptr; it.cb = nullptr;
    if (idx < 1024) {
        const int i = idx >> 8, e = (idx >> 4) & 15, gu = (idx >> 3) & 1, blk = idx & 7;
        it.src = (gu ? C.w_up : C.w_gate) + (size_t)(i * 16 + e) * 1024 * 256; it.N = 256; it.n0 = blk * 32;
        const int row = (it.n0 >> 7) * 256 + gu * 128 + (it.n0 & 127);
        it.dst = (bf16*)(C.ws + WS_WGU) + ((size_t)(i * 16 + e) * 512 + row) * 1024;
        it.g = C.ln_g + (i * 2 + 0) * 1024; it.b = C.ln_b + (i * 2 + 0) * 1024;
        it.cs = C.vec(V_GU_CS) + (i * 16 + e) * 512 + row; it.cb = C.vec(V_GU_CB) + (i * 16 + e) * 512 + row;
        return it; }
    idx -= 1024;
    if (idx < 194) {
        const int j = idx / 97, blk = idx % 97, i = 2 * j + 1;
        it.src = C.fox_w_in + (size_t)j * 1024 * FOX_NALL; it.N = FOX_NALL; it.n0 = blk * 32; it.ncols = blk < 96 ? 32 : 16;
        it.dst = blk < 96 ? (bf16*)(C.ws + WS_WIN_FOX) + ((size_t)j * FOX_N + it.n0) * 1024 : (bf16*)(C.ws + WS_WF) + (size_t)j * 16 * 1024;
        it.g = C.ln_g + ((i - 1) * 2 + 1) * 1024; it.b = C.ln_b + ((i - 1) * 2 + 1) * 1024;
        it.cs = C.vec(V_PROJ_CS) + i * FOX_NALL + it.n0; it.cb = C.vec(V_PROJ_CB) + i * FOX_NALL + it.n0;
        return it; }
    idx -= 194;
    if (idx < 96) {
        const int j = idx / 48, blk = idx % 48, i = 2 * j;
        it.src = C.swa_w_in + (size_t)j * 1024 * SWA_N; it.N = SWA_N; it.n0 = blk * 32;
        it.dst = (bf16*)(C.ws + WS_WIN_SWA) + ((size_t)j * SWA_N + it.n0) * 1024;
        if (i > 0) { it.g = C.ln_g + ((i - 1) * 2 + 1) * 1024; it.b = C.ln_b + ((i - 1) * 2 + 1) * 1024; }
        it.cs = C.vec(V_PROJ_CS) + i * FOX_NALL + it.n0; it.cb = C.vec(V_PROJ_CB) + i * FOX_NALL + it.n0;
        return it; }
    idx -= 96;
    if (idx < 128) {
        const int i = idx >> 5, blk = idx & 31, j = i >> 1;
        it.src = ((i & 1) ? C.fox_w_o : C.swa_w_o) + (size_t)j * 1024 * 1024; it.N = 1024; it.n0 = blk * 32;
        it.dst = (bf16*)(C.ws + WS_WO) + ((size_t)i * 1024 + it.n0) * 1024;
        return it; }
    idx -= 128;
    { const int i = idx; it.src = C.w_router; it.N = 16; it.n0 = 0; it.ncols = 16;
      it.dst = (bf16*)(C.ws + WS_WR) + (size_t)i * 16 * 1024;
      it.g = C.ln_g + (i * 2 + 0) * 1024; it.b = C.ln_b + (i * 2 + 0) * 1024;
      it.cs = C.vec(V_RT_CS) + i * 16; it.cb = C.vec(V_RT_CB) + i * 16; }
    return it;
}
constexpr int N_BIG = 1024 + 194 + 96 + 128 + 4;
__device__ __forceinline__ CvtItem small_item(const Ctx& C, int q) {
    CvtItem it; const int i = q >> 9, e = (q >> 5) & 15, blk = q & 31;
    it.src = C.w_down + (size_t)(i * 16 + e) * 256 * 1024; it.K = 256; it.N = 1024; it.n0 = blk * 32; it.ncols = 32;
    it.dst = (bf16*)(C.ws + WS_WD) + ((size_t)(i * 16 + e) * 1024 + it.n0) * 256; it.dpitch = 256;
    it.g = nullptr; it.b = nullptr; it.cs = nullptr; it.cb = nullptr; return it;
}
__device__ __forceinline__ void p_prologue(const Ctx& C) {
    LAS float* scr = (LAS float*)(C.lds + C.wave * 8704);
    for (int sl = C.gw; sl < N_BIG + 512; sl += C.ngw) {
        if (sl < N_BIG) { const CvtItem it = big_item(C, sl); cvt_item(it, scr, C.lane); }
        else { for (int u = 0; u < 4; ++u) { const CvtItem it = small_item(C, (sl - N_BIG) * 4 + u); cvt_item(it, scr, C.lane); } }
    }
    { const int nth = C.nwg * 512, gt = C.wg * 512 + C.tid; bf16* Z = C.Z();
      for (int i = gt; i < M * D / 8; i += nth) { const f32x4 a = *(const f32x4*)(C.x + (size_t)i * 8), b = *(const f32x4*)(C.x + (size_t)i * 8 + 4);
          u32x4 o; o.x = pk2(a[0], a[1]); o.y = pk2(a[2], a[3]); o.z = pk2(b[0], b[1]); o.w = pk2(b[2], b[3]); *(u32x4*)(Z + (size_t)i * 8) = o; } }
    { const int gt = C.wg * 512 + C.tid;
      if (gt < 256) { float* T = (float*)(C.ws + WS_ROPE); const int j = gt & 7, a = gt >> 3;
          const double wr = ROPE_W[2 * j], wi = ROPE_W[2 * j + 1];
          double pr = wr, pi = wi;
          for (int q = 0; q < 6; ++q) { const double t = pr * pr - pi * pi; pi = 2.0 * pr * pi; pr = t; }
          double zr = 1.0, zi = 0.0;
          for (int bit = 0; bit < 5; ++bit) { if ((a >> bit) & 1) { const double t = zr * pr - zi * pi; zi = zr * pi + zi * pr; zr = t; } const double t2 = pr * pr - pi * pi; pi = 2.0 * pr * pi; pr = t2; }
          for (int b = 0; b < 64; ++b) { const int pos = 64 * a + b; T[pos * 8 + j] = (float)zr; T[S * 8 + pos * 8 + j] = (float)zi; const double t = zr * wr - zi * wi; zi = zr * wi + zi * wr; zr = t; } } }
}

template <bool DUAL, int K, class Setup, class AF, class BF, class EP>
__device__ __forceinline__ void sgemm(int lane, int gw, int ngw, int Mt, int Nt, Setup setup, AF af, BF bf, EP ep) {
    const int lr = lane & 15, lq = lane >> 4;
    for (int t = gw; t < Mt * Nt; t += ngw) {
        const int tm = t / Nt, tn = t % Nt, r0 = tm * 32, c0 = tn * 32;
        const auto tc = setup(tm, tn);
        f32x4 acc[2][2], acc2[2][2];
#pragma unroll
        for (int i = 0; i < 2; ++i)
#pragma unroll
            for (int j = 0; j < 2; ++j) { acc[i][j] = (f32x4){0.f, 0.f, 0.f, 0.f}; acc2[i][j] = (f32x4){0.f, 0.f, 0.f, 0.f}; }
        const bf16* ap[2]; ap[0] = af(tc, r0 + lr) + 8 * lq; ap[1] = af(tc, r0 + 16 + lr) + 8 * lq;
#pragma unroll 4
        for (int k0 = 0; k0 < K; k0 += 32) {
            bf16x8 a[2], b[2], b2[2];
#pragma unroll
            for (int i = 0; i < 2; ++i) a[i] = *(const bf16x8*)(ap[i] + k0);
#pragma unroll
            for (int j = 0; j < 2; ++j) { b[j] = *(const bf16x8*)bf(tc, c0 + 16 * j + lr, k0 + 8 * lq, 0); if (DUAL) b2[j] = *(const bf16x8*)bf(tc, c0 + 16 * j + lr, k0 + 8 * lq, 1); }
#pragma unroll
            for (int i = 0; i < 2; ++i)
#pragma unroll
                for (int j = 0; j < 2; ++j) { acc[i][j] = mfma16(a[i], b[j], acc[i][j]); if (DUAL) acc2[i][j] = mfma16(a[i], b2[j], acc2[i][j]); }
        }
#pragma unroll
        for (int i = 0; i < 2; ++i)
#pragma unroll
            for (int j = 0; j < 2; ++j)
#pragma unroll
                for (int rg = 0; rg < 4; ++rg) ep(tc, r0 + 16 * i + 4 * lq + rg, c0 + 16 * j + lr, acc[i][j][rg], acc2[i][j][rg]);
    }
}
struct NoTile {};
__device__ __forceinline__ f32x4 thin16(const bf16* Zr, int r0, const bf16* WT, int lane) {
    f32x4 acc = (f32x4){0.f, 0.f, 0.f, 0.f};
    const bf16* ap = Zr + (size_t)(r0 + (lane & 15)) * D + 8 * (lane >> 4); const bf16* bp = WT + (size_t)(lane & 15) * D + 8 * (lane >> 4);
#pragma unroll 8
    for (int k0 = 0; k0 < D; k0 += 32) acc = mfma16(*(const bf16x8*)(ap + k0), *(const bf16x8*)(bp + k0), acc);
    return acc;
}

namespace pg8 {
constexpr int BM = 256, BK = 64, HALF = 128, HTB = HALF * BK * 2, STAGE_BYTES = 8 * HTB;
__device__ __forceinline__ int lds_byte(int r, int c) { const int st = (r >> 4) * 2 + (c >> 5), rr = r & 15, cc = c & 31, ob = rr * 64 + cc * 2; return st * 1024 + (ob ^ (((ob >> 9) & 1) << 5)); }
__device__ __forceinline__ void stage_rc(int b, int& R, int& C) { const int st = b / 1024, sb = b % 1024, swz = sb ^ (((sb >> 9) & 1) << 5); R = (st >> 1) * 16 + swz / 64; C = (st & 1) * 32 + (swz % 64) / 2; }
__device__ __forceinline__ int perm32(int rho) { const int n = rho >> 4, i = rho & 15; return 8 * (i >> 2) + 4 * n + (i & 3); }
struct Unit { int pm, pn, cls, base, cnt, e1, e2; };
typedef f32x4 Acc[2][2][4][2];
constexpr int LDS_TAB = 131072 + 1024;
constexpr int LDS_CLS = 131072 + 512;

template <class Prob, class Epi>
__device__ __forceinline__ void gemm_phase(const Ctx& C, const Prob& P, const Epi& E) {
    LAS unsigned char* lds = C.lds;
    const int tid = C.tid, wid = C.wave, lane = C.lane, wr = wid >> 2, wc = wid & 3, fr = lane & 15, fq = lane >> 4;
    constexpr int nt = Prob::K / BK, LDBE = Prob::LDB;
    unsigned voffA[2], voffB[2];
#pragma unroll
    for (int i = 0; i < 2; ++i) { int R_, C_; stage_rc(tid * 16 + i * 8192, R_, C_); const int Rb = (R_ & ~31) + perm32(R_ & 31); voffA[i] = (unsigned)(R_ * Prob::LDA + C_) * 2u; voffB[i] = (unsigned)(Rb * LDBE + C_) * 2u; }
    constexpr size_t hstepB = (size_t)HALF * LDBE * 2;
    const unsigned ldsw = (unsigned)wid * 1024u;
    const int aoff = lds_byte(wr * 64 + fr, fq * 8), boff = lds_byte(wc * 32 + fr, fq * 8);
#define PG8_SA(b, h) (((b) * 2 + (h)) * HTB)
#define PG8_SB(b, h) ((4 + (b) * 2 + (h)) * HTB)
#define PG8_STAGE_B(bufoff, gbase) do { _Pragma("unroll") for (int _i = 0; _i < 2; ++_i) { unsigned _v = voffB[_i]; const char* _b = (const char*)(gbase); asm volatile("" : "+v"(_v), "+s"(_b));     \
        __builtin_amdgcn_global_load_lds((const unsigned*)(_b + _v), (LAS unsigned*)(lds + (bufoff) + ldsw + _i * 8192), 16, 0, 0); } } while (0)
#define PG8_STAGE_A(bufoff, un, vo, h, tt) do { _Pragma("unroll") for (int _i = 0; _i < 2; ++_i) { unsigned _v = Prob::GATHER ? (vo)[h][_i] : voffA[_i]; const char* _b = P.a_tile(un, h) + (size_t)(tt) * (BK * 2); asm volatile("" : "+v"(_v), "+s"(_b)); \
        __builtin_amdgcn_global_load_lds((const unsigned*)(_b + _v), (LAS unsigned*)(lds + (bufoff) + ldsw + _i * 8192), 16, 0, 0); } } while (0)
#define PG8_LDA(dst, b, h) do { _Pragma("unroll") for (int m = 0; m < 4; ++m) _Pragma("unroll") for (int k = 0; k < 2; ++k) dst[m][k] = *(const LAS bf16x8*)(lds + PG8_SA(b, h) + aoff + m * 2048 + k * 1024); } while (0)
#define PG8_LDB(dst, b, h) do { _Pragma("unroll") for (int n = 0; n < 2; ++n) _Pragma("unroll") for (int k = 0; k < 2; ++k) dst[n][k] = *(const LAS bf16x8*)(lds + PG8_SB(b, h) + boff + n * 2048 + k * 1024); } while (0)
#define PG8_MMA(ai, bj, At, Bt) do { __builtin_amdgcn_s_setprio(1); _Pragma("unroll") for (int m = 0; m < 4; ++m) _Pragma("unroll") for (int n = 0; n < 2; ++n) _Pragma("unroll") for (int k = 0; k < 2; ++k) \
        acc[ai][bj][m][n] = __builtin_amdgcn_mfma_f32_16x16x32_bf16(Bt[n][k], At[m][k], acc[ai][bj][m][n], 0, 0, 0); __builtin_amdgcn_s_setprio(0); } while (0)
#define PG8_WAIT_V(n) asm volatile("s_waitcnt vmcnt(" #n ")" ::: "memory")
#define PG8_WAIT_L(n) asm volatile("s_waitcnt lgkmcnt(" #n ")" ::: "memory")
#define PG8_BAR __builtin_amdgcn_s_barrier()
#define PG8_SCHED __builtin_amdgcn_sched_barrier(0)
#define PG8_KSTEP(t, un2, vo2, t2, b2, b3) do { \
        PG8_LDB(B0, 0, 0); PG8_LDB(B1, 0, 1); PG8_SCHED; PG8_LDA(At, 0, 0); PG8_STAGE_A(PG8_SA(1, 1), cur, voC, 1, (t) + 1); \
        PG8_WAIT_V(8); PG8_WAIT_L(0); PG8_BAR; PG8_MMA(0, 0, At, B0); PG8_MMA(0, 1, At, B1); PG8_BAR; PG8_SCHED; \
        PG8_LDA(At, 0, 1); PG8_STAGE_B(PG8_SB(0, 0), b2); PG8_STAGE_B(PG8_SB(0, 1), (b2) + hstepB); PG8_STAGE_A(PG8_SA(0, 0), un2, vo2, 0, t2); \
        PG8_WAIT_V(8); PG8_WAIT_L(0); PG8_BAR; PG8_MMA(1, 0, At, B0); PG8_MMA(1, 1, At, B1); PG8_BAR; PG8_SCHED; \
        PG8_LDB(B0, 1, 0); PG8_LDB(B1, 1, 1); PG8_SCHED; PG8_LDA(At, 1, 0); PG8_STAGE_A(PG8_SA(0, 1), un2, vo2, 1, t2); \
        PG8_WAIT_V(8); PG8_WAIT_L(0); PG8_BAR; PG8_MMA(0, 0, At, B0); PG8_MMA(0, 1, At, B1); PG8_BAR; PG8_SCHED; \
        PG8_LDA(At, 1, 1); PG8_STAGE_B(PG8_SB(1, 0), b3); PG8_STAGE_B(PG8_SB(1, 1), (b3) + hstepB); PG8_STAGE_A(PG8_SA(1, 0), un2, vo2, 0, (t2) + 1); \
        PG8_WAIT_V(8); PG8_WAIT_L(0); PG8_BAR; PG8_MMA(1, 0, At, B0); PG8_MMA(1, 1, At, B1); PG8_BAR; PG8_SCHED; } while (0)
    Unit cur = {0, 0, 0, 0, 0, 0, 0}, nxt = {0, 0, 0, 0, 0, 0, 0}; int ui = 0;
    if (!P.next(0, cur)) return;
    Acc acc;
#define PG8_ZERO() do { _Pragma("unroll") for (int a = 0; a < 2; ++a) _Pragma("unroll") for (int b = 0; b < 2; ++b) _Pragma("unroll") for (int m = 0; m < 4; ++m) _Pragma("unroll") for (int n = 0; n < 2; ++n) acc[a][b][m][n] = (f32x4){0.f, 0.f, 0.f, 0.f}; } while (0)
    PG8_ZERO();
    bf16x8 At[4][2], B0[2][2], B1[2][2];
    unsigned voC[2][2], voN[2][2];
    if (Prob::GATHER) P.a_offsets(cur, tid, voC);
    {
        const char* pb0 = P.b_tile(cur, 0); const char* pb1 = P.b_tile(cur, 1);
        PG8_STAGE_B(PG8_SB(0, 0), pb0); PG8_STAGE_B(PG8_SB(0, 1), pb0 + hstepB); PG8_STAGE_A(PG8_SA(0, 0), cur, voC, 0, 0); PG8_STAGE_A(PG8_SA(0, 1), cur, voC, 1, 0);
        if (wr == 1) PG8_BAR;
        PG8_WAIT_V(2); PG8_BAR;
        PG8_STAGE_B(PG8_SB(1, 0), pb1); PG8_STAGE_A(PG8_SA(1, 0), cur, voC, 0, 1); PG8_STAGE_B(PG8_SB(1, 1), pb1 + hstepB);
        PG8_WAIT_V(6); PG8_BAR;
    }
    for (;;) {
        const bool has_next = P.next(ui + 1, nxt);
        if (has_next) { if (Prob::GATHER) P.a_offsets(nxt, tid, voN); }
        else { nxt = cur;
#pragma unroll
            for (int h = 0; h < 2; ++h)
#pragma unroll
                for (int i = 0; i < 2; ++i) voN[h][i] = voC[h][i]; }
#pragma unroll 1
        for (int t = 0; t < nt - 2; t += 2) { const char* b2 = P.b_tile(cur, t + 2); const char* b3 = P.b_tile(cur, t + 3); PG8_KSTEP(t, cur, voC, t + 2, b2, b3); }
        { const char* b2 = P.b_tile(nxt, 0); const char* b3 = P.b_tile(nxt, 1); PG8_KSTEP(nt - 2, nxt, voN, 0, b2, b3); }
        if (wr == 0) PG8_BAR;
        E(acc, cur, C, wr, wc, fr, fq);
        if (!has_next) break;
        PG8_ZERO();
        cur = nxt;
#pragma unroll
        for (int h = 0; h < 2; ++h)
#pragma unroll
            for (int i = 0; i < 2; ++i) voC[h][i] = voN[h][i];
        ++ui;
        if (wr == 1) PG8_BAR;
    }
    PG8_WAIT_V(0);
    PG8_BAR;
#undef PG8_SA
#undef PG8_SB
#undef PG8_STAGE_A
#undef PG8_STAGE_B
#undef PG8_LDA
#undef PG8_LDB
#undef PG8_MMA
#undef PG8_WAIT_V
#undef PG8_WAIT_L
#undef PG8_BAR
#undef PG8_SCHED
#undef PG8_KSTEP
#undef PG8_ZERO
}
__device__ __forceinline__ unsigned cvt_pk_bf16(float lo, float hi) { unsigned r; asm volatile("v_cvt_pk_bf16_f32 %0, %1, %2" : "=v"(r) : "v"(lo), "v"(hi)); return r; }
__device__ __forceinline__ void epi_bar() { asm volatile("s_waitcnt lgkmcnt(0)" ::: "memory"); __builtin_amdgcn_s_barrier(); asm volatile("" ::: "memory"); }

__device__ __forceinline__ bool static_next(int i, int G, int c, int nM, int nN, Unit& u) {
    const int nwg = nM * nN; const long L = (long)i * G + c; if (L >= nwg) return false;
    int wgid = (int)L; { const int q = nwg / 8, r = nwg % 8, xcd = wgid % 8, off = wgid / 8; wgid = (xcd < r ? xcd * (q + 1) : r * (q + 1) + (xcd - r) * q) + off; }
    const int nig = 8 * nN, gid = wgid / nig, fm = gid * 8, gsz = (nM - fm) < 8 ? (nM - fm) : 8;
    u.pm = fm + ((wgid % nig) % gsz); u.pn = (wgid % nig) / gsz; u.cls = 0; u.base = 0; u.cnt = 0; u.e1 = 0; u.e2 = 0; return true;
}
struct ProbPlain {
    static constexpr int K = 1024, LDA = 1024, LDB = 1024; static constexpr bool GATHER = false;
    const bf16* A; const bf16* Bt; int nM, nN, G, c;
    __device__ __forceinline__ bool next(int i, Unit& u) const { return static_next(i, G, c, nM, nN, u); }
    __device__ __forceinline__ const char* a_tile(const Unit& u, int h) const { return (const char*)A + (size_t)(u.pm * 256 + h * 128) * (1024 * 2); }
    __device__ __forceinline__ void a_offsets(const Unit&, int, unsigned (&)[2][2]) const {}
    __device__ __forceinline__ const char* b_tile(const Unit& u, int t) const { return (const char*)Bt + (size_t)u.pn * (256 * 1024 * 2) + (size_t)t * (BK * 2); }
};
__device__ __forceinline__ bool cls_next(int i, int G, int c, int ntiles, const LAS int* cbase, const LAS int* ccnt, Unit& u) {
    const int nwg = ntiles * 4; const long L = (long)i * G + c; if (L >= nwg) return false;
    int wgid = (int)L; { const int q = nwg / 8, r = nwg % 8, xcd = wgid % 8, off = wgid / 8; wgid = (xcd < r ? xcd * (q + 1) : r * (q + 1) + (xcd - r) * q) + off; }
    u.pm = wgid >> 2; u.pn = wgid & 3;
    const int R0 = u.pm * 256; int cl = 0;
#pragma unroll 1
    for (int k = 1; k < NCLS; ++k) if (R0 >= cbase[k]) cl = k;
    cl = __builtin_amdgcn_readfirstlane(cl);
    u.cls = cl; u.base = __builtin_amdgcn_readfirstlane(cbase[cl]); u.cnt = __builtin_amdgcn_readfirstlane(ccnt[cl]); cls_experts(cl, u.e1, u.e2); return true;
}
struct ProbUp {
    static constexpr int K = 1024, LDA = 1024, LDB = 1024; static constexpr bool GATHER = true;
    const bf16* Z; const bf16* WGU; const int* list; const LAS int* cbase; const LAS int* ccnt; int ntiles, G, c;
    __device__ __forceinline__ bool next(int i, Unit& u) const { return cls_next(i, G, c, ntiles, cbase, ccnt, u); }
    __device__ __forceinline__ const char* a_tile(const Unit&, int) const { return (const char*)Z; }
    __device__ __forceinline__ void a_offsets(const Unit& u, int tid, unsigned (&vo)[2][2]) const {
#pragma unroll
        for (int i = 0; i < 2; ++i) { int R_, C_; stage_rc(tid * 16 + i * 8192, R_, C_);
#pragma unroll
            for (int h = 0; h < 2; ++h) { int li = u.pm * 256 + h * 128 + R_ - u.base; li = li < u.cnt ? li : u.cnt - 1; const int tok = list[u.cls * M + li]; vo[h][i] = (unsigned)(tok * 1024 + C_) * 2u; } } }
    __device__ __forceinline__ const char* b_tile(const Unit& u, int t) const { const int e = (u.pn >> 1) ? u.e2 : u.e1; return (const char*)WGU + (size_t)(e * 2 + (u.pn & 1)) * (256 * 1024 * 2) + (size_t)t * (BK * 2); }
};
struct ProbDown {
    static constexpr int K = 512, LDA = 512, LDB = 256; static constexpr bool GATHER = false;
    const bf16* ACT; const bf16* WD; const LAS int* cbase; const LAS int* ccnt; int ntiles, G, c;
    __device__ __forceinline__ bool next(int i, Unit& u) const { return cls_next(i, G, c, ntiles, cbase, ccnt, u); }
    __device__ __forceinline__ const char* a_tile(const Unit& u, int h) const { return (const char*)ACT + (size_t)(u.pm * 256 + h * 128) * (512 * 2); }
    __device__ __forceinline__ void a_offsets(const Unit&, int, unsigned (&)[2][2]) const {}
    __device__ __forceinline__ const char* b_tile(const Unit& u, int t) const { const int e = t < 4 ? u.e1 : u.e2; return (const char*)WD + ((size_t)e * 1024 + (size_t)u.pn * 256) * (256 * 2) + (size_t)(t & 3) * (BK * 2); }
};

__device__ __forceinline__ void unpack8(const u32x4 w, float (&f)[8]) {
    f[0] = __uint_as_float(w.x << 16); f[1] = __uint_as_float(w.x & 0xffff0000u); f[2] = __uint_as_float(w.y << 16); f[3] = __uint_as_float(w.y & 0xffff0000u);
    f[4] = __uint_as_float(w.z << 16); f[5] = __uint_as_float(w.z & 0xffff0000u); f[6] = __uint_as_float(w.w << 16); f[7] = __uint_as_float(w.w & 0xffff0000u); }
struct EpiProj {
    bool fox; const float* st; const float* cs; const float* cb; const float* rope; bf16* Q;
    __device__ __forceinline__ void operator()(Acc& acc, const Unit& u, const Ctx& C, int wr, int wc, int fr, int fq) const {
        const int row0 = u.pm * 256 + wr * 64 + fr, colt = u.pn * 256 + wc * 32 + 8 * fq;
        f32x4 csv[2][2], cbv[2][2];
#pragma unroll
        for (int bj = 0; bj < 2; ++bj)
#pragma unroll
            for (int n = 0; n < 2; ++n) { csv[bj][n] = *(const f32x4*)(cs + colt + 128 * bj + 4 * n); cbv[bj][n] = *(const f32x4*)(cb + colt + 128 * bj + 4 * n); }
        size_t doff; int ldc, dcol; float sc = 1.f;
        if (fox) { const int t = u.pn >> 2; doff = (size_t)t * ((WS_K - WS_Q) / 2); ldc = 1024; dcol = (u.pn & 3) * 256; if (t == 0) sc = C2; }
        else { if (u.pn < 4) { doff = 0; ldc = 1024; dcol = u.pn * 256; sc = C2; } else { doff = (u.pn == 4) ? (WS_K - WS_Q) / 2 : (WS_V - WS_Q) / 2; ldc = 256; dcol = 0; } }
        bf16* dst = Q + doff + dcol + wc * 32 + 8 * fq;
        const bool rope_on = !fox && u.pn < 5 && !(wc & 1);
        const float sgn = fq == 0 ? -1.f : 1.f;
#pragma unroll
        for (int ai = 0; ai < 2; ++ai)
#pragma unroll
            for (int m = 0; m < 4; ++m) {
                const int r = row0 + 128 * ai + 16 * m; const f32x2 ms = row_stats(st, r);
                f32x4 v[2][2];
#pragma unroll
                for (int bj = 0; bj < 2; ++bj)
#pragma unroll
                    for (int n = 0; n < 2; ++n) v[bj][n] = (acc[ai][bj][m][n] - ms.x * csv[bj][n]) * ms.y + cbv[bj][n];
                if (rope_on) {
                    const int pos = r & (S - 1); f32x4 co[2], si[2];
                    co[0] = *(const f32x4*)(rope + pos * 8); co[1] = *(const f32x4*)(rope + pos * 8 + 4); si[0] = *(const f32x4*)(rope + S * 8 + pos * 8); si[1] = *(const f32x4*)(rope + S * 8 + pos * 8 + 4);
#pragma unroll
                    for (int bj = 0; bj < 2; ++bj)
#pragma unroll
                        for (int n = 0; n < 2; ++n)
#pragma unroll
                            for (int e = 0; e < 4; ++e) { const float x = v[bj][n][e], o = __shfl_xor(x, 16); const float y = x * co[n][e] + sgn * o * si[n][e]; v[bj][n][e] = fq < 2 ? y : x; }
                }
#pragma unroll
                for (int bj = 0; bj < 2; ++bj) { const f32x4 a = v[bj][0] * sc, b = v[bj][1] * sc; u32x4 w; w.x = cvt_pk_bf16(a[0], a[1]); w.y = cvt_pk_bf16(a[2], a[3]); w.z = cvt_pk_bf16(b[0], b[1]); w.w = cvt_pk_bf16(b[2], b[3]);
                    *(u32x4*)(dst + (size_t)r * ldc + 128 * bj) = w; }
            }
    }
};
struct EpiOut {
    const float* stp; const float* gp; const float* bp; bf16* Z; float* sto;
    __device__ __forceinline__ void operator()(Acc& acc, const Unit& u, const Ctx& C, int wr, int wc, int fr, int fq) const {
        const int colt = u.pn * 256 + wc * 32 + 8 * fq;
        f32x4 gv[2][2], bv[2][2];
#pragma unroll
        for (int bj = 0; bj < 2; ++bj)
#pragma unroll
            for (int n = 0; n < 2; ++n) { gv[bj][n] = gp ? *(const f32x4*)(gp + colt + 128 * bj + 4 * n) : (f32x4){1.f, 1.f, 1.f, 1.f}; bv[bj][n] = gp ? *(const f32x4*)(bp + colt + 128 * bj + 4 * n) : (f32x4){0.f, 0.f, 0.f, 0.f}; }
        LAS f32x2* T = (LAS f32x2*)(C.lds + LDS_TAB);
#pragma unroll
        for (int ai = 0; ai < 2; ++ai)
#pragma unroll
            for (int m = 0; m < 4; ++m) {
                const int rl = 128 * ai + 64 * wr + 16 * m + fr, r = u.pm * 256 + rl; const f32x2 ms = row_stats(stp, r);
                float s = 0.f, q = 0.f;
#pragma unroll
                for (int bj = 0; bj < 2; ++bj) {
                    bf16* p = Z + (size_t)r * D + colt + 128 * bj; float zi[8]; unpack8(*(const u32x4*)p, zi); float zo[8];
#pragma unroll
                    for (int n = 0; n < 2; ++n)
#pragma unroll
                        for (int e = 0; e < 4; ++e) { const float xin = gp ? (zi[4 * n + e] - ms.x) * ms.y * gv[bj][n][e] + bv[bj][n][e] : zi[4 * n + e]; zo[4 * n + e] = ALPHA * xin + acc[ai][bj][m][n][e]; }
                    u32x4 w; w.x = cvt_pk_bf16(zo[0], zo[1]); w.y = cvt_pk_bf16(zo[2], zo[3]); w.z = cvt_pk_bf16(zo[4], zo[5]); w.w = cvt_pk_bf16(zo[6], zo[7]);
                    *(u32x4*)p = w; float zr[8]; unpack8(w, zr);
#pragma unroll
                    for (int e = 0; e < 8; ++e) { s += zr[e]; q += zr[e] * zr[e]; }
                }
                s += __shfl_xor(s, 16); s += __shfl_xor(s, 32); q += __shfl_xor(q, 16); q += __shfl_xor(q, 32);
                if (fq == 0) T[rl * 4 + wc] = (f32x2){s, q};
                asm volatile("" ::: "memory");
            }
        epi_bar();
        if (C.tid < 256) { const f32x2 a = T[C.tid * 4 + 0], b = T[C.tid * 4 + 1], c = T[C.tid * 4 + 2], d = T[C.tid * 4 + 3];
            *(f32x2*)(sto + (size_t)(u.pm * 256 + C.tid) * 8 + u.pn * 2) = (f32x2){(a.x + b.x) + (c.x + d.x), (a.y + b.y) + (c.y + d.y)}; }
    }
};
struct EpiUp {
    const float* st; const int* list; const f32x2* gates; const float* gcs; const float* gcb; bf16* ACT;
    __device__ __forceinline__ void operator()(Acc& acc, const Unit& u, const Ctx& C, int wr, int wc, int fr, int fq) const {
        const int which = u.pn >> 1, half = u.pn & 1, e = which ? u.e2 : u.e1;
        const float* pcs = gcs + e * 512 + half * 256 + wc * 32 + 8 * fq; const float* pcb = gcb + e * 512 + half * 256 + wc * 32 + 8 * fq;
        f32x4 csg[2], csu[2], cbg[2], cbu[2];
#pragma unroll
        for (int n = 0; n < 2; ++n) { csg[n] = *(const f32x4*)(pcs + 4 * n); csu[n] = *(const f32x4*)(pcs + 128 + 4 * n); cbg[n] = *(const f32x4*)(pcb + 4 * n); cbu[n] = *(const f32x4*)(pcb + 128 + 4 * n); }
        bf16* dst = ACT + which * 256 + half * 128 + wc * 32 + 8 * fq;
#pragma unroll
        for (int ai = 0; ai < 2; ++ai)
#pragma unroll
            for (int m = 0; m < 4; ++m) {
                const int rl = 128 * ai + 64 * wr + 16 * m + fr, R = u.pm * 256 + rl, li = R - u.base; const bool valid = li < u.cnt;
                const int tok = list[u.cls * M + (valid ? li : 0)]; const f32x2 ms = row_stats(st, tok); const f32x2 gt = gates[tok];
                const float gate = valid ? (which ? gt.y : gt.x) : 0.f;
                float a[8];
#pragma unroll
                for (int n = 0; n < 2; ++n)
#pragma unroll
                    for (int k = 0; k < 4; ++k) { const float hg = ms.y * (acc[ai][0][m][n][k] - ms.x * csg[n][k]) + cbg[n][k], hu = ms.y * (acc[ai][1][m][n][k] - ms.x * csu[n][k]) + cbu[n][k];
                        a[4 * n + k] = hg * __builtin_amdgcn_rcpf(1.f + __expf(-hg)) * hu * gate; }
                u32x4 w; w.x = cvt_pk_bf16(a[0], a[1]); w.y = cvt_pk_bf16(a[2], a[3]); w.z = cvt_pk_bf16(a[4], a[5]); w.w = cvt_pk_bf16(a[6], a[7]);
                *(u32x4*)(dst + (size_t)R * 512) = w;
            }
    }
};
struct EpiDown {
    const float* st1; const float* g1; const float* b1; const int* list; bf16* Z; float* sto;
    __device__ __forceinline__ void operator()(Acc& acc, const Unit& u, const Ctx& C, int wr, int wc, int fr, int fq) const {
        const int colt = u.pn * 256 + wc * 32 + 8 * fq;
        f32x4 gv[2][2], bv[2][2];
#pragma unroll
        for (int bj = 0; bj < 2; ++bj)
#pragma unroll
            for (int n = 0; n < 2; ++n) { gv[bj][n] = *(const f32x4*)(g1 + colt + 128 * bj + 4 * n); bv[bj][n] = *(const f32x4*)(b1 + colt + 128 * bj + 4 * n); }
        LAS f32x2* T = (LAS f32x2*)(C.lds + LDS_TAB);
#pragma unroll
        for (int ai = 0; ai < 2; ++ai)
#pragma unroll
            for (int m = 0; m < 4; ++m) {
                const int rl = 128 * ai + 64 * wr + 16 * m + fr, li = u.pm * 256 + rl - u.base; const bool valid = li < u.cnt;
                const int tok = list[u.cls * M + (valid ? li : 0)]; const f32x2 ms = row_stats(st1, tok);
                float s = 0.f, q = 0.f;
#pragma unroll
                for (int bj = 0; bj < 2; ++bj) {
                    bf16* p = Z + (size_t)tok * D + colt + 128 * bj; float zi[8]; unpack8(*(const u32x4*)p, zi); float zo[8];
#pragma unroll
                    for (int n = 0; n < 2; ++n)
#pragma unroll
                        for (int e = 0; e < 4; ++e) { const float x1 = (zi[4 * n + e] - ms.x) * ms.y * gv[bj][n][e] + bv[bj][n][e]; zo[4 * n + e] = ALPHA * x1 + acc[ai][bj][m][n][e]; }
                    u32x4 w; w.x = cvt_pk_bf16(zo[0], zo[1]); w.y = cvt_pk_bf16(zo[2], zo[3]); w.z = cvt_pk_bf16(zo[4], zo[5]); w.w = cvt_pk_bf16(zo[6], zo[7]);
                    if (valid) *(u32x4*)p = w;
                    float zr[8]; unpack8(w, zr);
#pragma unroll
                    for (int e = 0; e < 8; ++e) { s += zr[e]; q += zr[e] * zr[e]; }
                }
                s += __shfl_xor(s, 16); s += __shfl_xor(s, 32); q += __shfl_xor(q, 16); q += __shfl_xor(q, 32);
                if (fq == 0) T[rl * 4 + wc] = (f32x2){s, q};
                asm volatile("" ::: "memory");
            }
        epi_bar();
        if (C.tid < 256) { const int li = u.pm * 256 + C.tid - u.base;
            if (li < u.cnt) { const int tok = list[u.cls * M + li]; const f32x2 a = T[C.tid * 4 + 0], b = T[C.tid * 4 + 1], c = T[C.tid * 4 + 2], d = T[C.tid * 4 + 3];
                *(f32x2*)(sto + (size_t)tok * 8 + u.pn * 2) = (f32x2){(a.x + b.x) + (c.x + d.x), (a.y + b.y) + (c.y + d.y)}; } }
    }
};
}

#ifndef USE8_PROJ
#define USE8_PROJ 1
#endif
#ifndef USE8_OPROJ
#define USE8_OPROJ 1
#endif
#ifndef USE8_UP
#define USE8_UP 1
#endif
#ifndef USE8_DOWN
#define USE8_DOWN 1
#endif
namespace fox {
using bf16=unsigned short;
using s16x4=__attribute__((ext_vector_type(4)))short;
using f32x16=__attribute__((ext_vector_type(16)))float;
constexpr int BATCH=8,NHEAD=16,SEQ=2048,D=64,DM=NHEAD*D;
constexpr int NW=8,QBLK=32,QB=QBLK*NW,KVBLK=64,NQB=SEQ/QB;
constexpr int ATTN_PITCH=DM, ATTN_UNIT_ROWS=QB;
__device__ __forceinline__ int crow(int r,int hi){return (r&3)+8*(r>>2)+4*hi;}
#define SBAR() __builtin_amdgcn_sched_barrier(0)
__device__ __forceinline__ void cmask(f32x16&p0,f32x16&p1,int jb,int qrel,int hi){
  const float NEG=-INFINITY; int kb=64*jb+4*hi;
  #pragma unroll
  for(int r=0;r<16;++r){int kv=kb+(r&3)+8*(r>>2); if(kv>qrel)p0[r]=NEG; if(kv+32>qrel)p1[r]=NEG;}
}

__device__ __forceinline__ void wmask(f32x16&p0,f32x16&p1,int dq){
  const float NEG=-INFINITY;
  #pragma unroll
  for(int r=0;r<16;++r){const int d=dq-((r&3)+8*(r>>2)); if((unsigned)d>=128u)p0[r]=NEG; if((unsigned)(d-32)>=128u)p1[r]=NEG;}
}
constexpr int NSLOT=3, SLOTB=8192;
constexpr int LDS_K=0, LDS_V=NSLOT*SLOTB, LDS_WS=2*NSLOT*SLOTB, LDS_OST=LDS_WS+NW*64*4, LDS_C=LDS_OST+NW*4096, LDS_BYTES=LDS_C+SEQ*4;
__device__ __forceinline__ void glds16(const void*gsrc,unsigned lds_dst){unsigned keep;
  asm volatile("s_mov_b32 %0, m0\n\ts_mov_b32 m0, %2\n\ts_nop 0\n\tglobal_load_lds_dwordx4 %1, off\n\ts_mov_b32 m0, %0":"=&s"(keep):"v"(gsrc),"s"(lds_dst):"memory");}
__device__ __forceinline__ float max3f(float a,float b,float c){float r;asm("v_max3_f32 %0, %1, %2, %3":"=v"(r):"v"(a),"v"(b),"v"(c));return r;}
__device__ __forceinline__ float max2f(float a,float b){float r;asm("v_max_f32_e32 %0, %1, %2":"=v"(r):"v"(a),"v"(b));return r;}
__device__ __forceinline__ float fadd_s(float a,float b){float r;asm("v_add_f32_e32 %0, %1, %2":"=v"(r):"v"(a),"v"(b));return r;}
__device__ __forceinline__ float fsub_s(float a,float b){float r;asm("v_sub_f32_e32 %0, %1, %2":"=v"(r):"v"(a),"v"(b));return r;}
typedef float f32x2_t __attribute__((ext_vector_type(2))); typedef float f32x4_t __attribute__((ext_vector_type(4))); typedef __bf16 bf16x2_t __attribute__((ext_vector_type(2)));
__device__ __forceinline__ unsigned cvtpk_s(float lo,float hi){f32x2_t v={lo,hi};bf16x2_t b=__builtin_convertvector(v,bf16x2_t);return __builtin_bit_cast(unsigned,b);}
#define WAIT_BAR(N) asm volatile("s_waitcnt vmcnt(" #N ") lgkmcnt(0)\n\ts_barrier":::"memory")

__device__ __forceinline__ void qkt(f32x16&p0,f32x16&p1,const char*Kslot,const bf16x8*qr,int r32,int hi){
  const char*kb=Kslot+hi*1024+r32*16;
  #pragma unroll
  for(int d0=0;d0<4;++d0){
    const bf16x8 b0=*reinterpret_cast<const bf16x8*>(kb+d0*2048);
    const bf16x8 b1=*reinterpret_cast<const bf16x8*>(kb+d0*2048+512);
    p0=__builtin_amdgcn_mfma_f32_32x32x16_bf16(b0,qr[d0],p0,0,0,0);p1=__builtin_amdgcn_mfma_f32_32x32x16_bf16(b1,qr[d0],p1,0,0,0);}
}
typedef __attribute__((address_space(3))) const char* lds_cptr;
typedef short v4i16_t __attribute__((ext_vector_type(4)));
__device__ __forceinline__ void kload8(bf16x8*kf,lds_cptr kp){
  kf[0]=*(const __attribute__((address_space(3))) bf16x8*)(kp);      kf[1]=*(const __attribute__((address_space(3))) bf16x8*)(kp+512);
  kf[2]=*(const __attribute__((address_space(3))) bf16x8*)(kp+2048); kf[3]=*(const __attribute__((address_space(3))) bf16x8*)(kp+2560);
  kf[4]=*(const __attribute__((address_space(3))) bf16x8*)(kp+4096); kf[5]=*(const __attribute__((address_space(3))) bf16x8*)(kp+4608);
  kf[6]=*(const __attribute__((address_space(3))) bf16x8*)(kp+6144); kf[7]=*(const __attribute__((address_space(3))) bf16x8*)(kp+6656);
}
__device__ __forceinline__ void kload2(bf16x8*kf,lds_cptr kp,int j){ kf[2*j]=*(const __attribute__((address_space(3))) bf16x8*)(kp+j*2048); kf[2*j+1]=*(const __attribute__((address_space(3))) bf16x8*)(kp+j*2048+512); }
__device__ __forceinline__ s16x4 vtr(lds_cptr p){ return __builtin_bit_cast(s16x4,__builtin_amdgcn_ds_read_tr16_b64_v4i16((__attribute__((address_space(3))) v4i16_t*)p)); }
__device__ __forceinline__ float rowmax(const f32x16&p0,const f32x16&p1){
  float a=max3f(p0[0],p0[1],p1[0]),b=max3f(p0[2],p0[3],p1[1]);a=max3f(a,p1[2],p1[3]);
  #pragma unroll
  for(int r=4;r<16;r+=4){a=max3f(a,p0[r],p0[r+1]);b=max3f(b,p0[r+2],p0[r+3]);a=max3f(a,p1[r],p1[r+1]);b=max3f(b,p1[r+2],p1[r+3]);}
  const float m=max2f(a,b);
  auto rr=__builtin_amdgcn_permlane32_swap(__float_as_uint(m),__float_as_uint(m),false,false);
  return max2f(__uint_as_float(rr[0]),__uint_as_float(rr[1]));
}
__device__ __forceinline__ void pv(f32x16*o,int vb,bf16x8 pa0,bf16x8 pa1,bf16x8 pa2,bf16x8 pa3){
  #pragma unroll
  for(int d0=0;d0<2;++d0){s16x4 lo[4],hi[4];
    #pragma unroll
    for(int ks=0;ks<4;++ks){
      asm volatile("ds_read_b64_tr_b16 %0,%1 offset:%c2":"=&v"(lo[ks]):"v"(vb),"i"(d0*4096+ks*1024):"memory");
      asm volatile("ds_read_b64_tr_b16 %0,%1 offset:%c2":"=&v"(hi[ks]):"v"(vb),"i"(d0*4096+ks*1024+512):"memory");}
    asm volatile("s_waitcnt lgkmcnt(0)":::"memory");SBAR();
    #define PK(k) (bf16x8){lo[k][0],lo[k][1],lo[k][2],lo[k][3],hi[k][0],hi[k][1],hi[k][2],hi[k][3]}
    o[d0]=__builtin_amdgcn_mfma_f32_32x32x16_bf16(pa0,PK(0),o[d0],0,0,0);
    o[d0]=__builtin_amdgcn_mfma_f32_32x32x16_bf16(pa1,PK(1),o[d0],0,0,0);
    o[d0]=__builtin_amdgcn_mfma_f32_32x32x16_bf16(pa2,PK(2),o[d0],0,0,0);
    o[d0]=__builtin_amdgcn_mfma_f32_32x32x16_bf16(pa3,PK(3),o[d0],0,0,0);
    #undef PK
  }
}

#ifndef ATTN_STORE16
#define ATTN_STORE16(p,v) (*(u32x4*)(p)=(v))
#endif
template<int THRL,bool SWA> __device__ __forceinline__ void attn_unit(int tid,int b,int h,int qb,const bf16*Q,const bf16*__restrict__ K,const bf16*__restrict__ V,bf16*O,const float*__restrict__ CU,float sink2,char*shm){
  constexpr int DMK=SWA?256:DM;
  const int lane=tid&63,r32=lane&31,hi=lane>>5; const int wid=__builtin_amdgcn_readfirstlane(tid>>6);
  const long rowbase=(long)b*SEQ; const int q0=qb*QB;
  const bf16*Qw=Q+(rowbase+q0+wid*QBLK)*DM+h*D;
  const int TL=SWA?(qb?4*qb-2:0):0;
  const bf16*Kh=K+(rowbase+TL*KVBLK)*DMK+(SWA?(h>>2):h)*D,*Vh=V+(rowbase+TL*KVBLK)*DMK+(SWA?(h>>2):h)*D;
  const unsigned lds0=(unsigned)(uintptr_t)shm;
  float*wsf=(float*)(shm+LDS_WS)+wid*64;
  const bf16*ksrc=Kh+(long)lane*DMK+wid*8;
  const bf16*vsrc=Vh+(long)(16*(wid&3)+(lane>>2))*DMK+(wid>>2)*32+(lane&3)*8;
  const unsigned kdst=lds0+LDS_K+wid*1024, vdst=lds0+LDS_V+wid*1024;
  #define DMA_K(t,slot) glds16(ksrc+(long)(t)*KVBLK*DMK,(unsigned)__builtin_amdgcn_readfirstlane(kdst+(slot)))
  #define DMA_V(t,slot) glds16(vsrc+(long)(t)*KVBLK*DMK,(unsigned)__builtin_amdgcn_readfirstlane(vdst+(slot)))
  const int vb0=(int)(lds0+LDS_V)+((lane>>4)&1)*32+(lane&3)*8+(4*hi+((lane&15)>>2))*64;
  const char*Kbase=shm+LDS_K; bf16x8 kf[8];
  const lds_cptr shm3=(lds_cptr)shm; const lds_cptr kp0=shm3+LDS_K+hi*1024+r32*16; const lds_cptr vp0=shm3+LDS_V+((lane>>4)&1)*32+(lane&3)*8+(4*hi+((lane&15)>>2))*64;
  const int NT=(q0+QB)/KVBLK-TL;
  if(!SWA){ const f32x4_t cv=*(const f32x4_t*)(CU+tid*4); *(__attribute__((address_space(3))) f32x4_t*)((lds_cptr)shm+LDS_C+tid*16)=cv; }
  DMA_K(0,0);DMA_V(0,0);DMA_K(1,SLOTB);
  const lds_cptr cpl=(lds_cptr)shm+LDS_C+hi*16;
  bf16x8 qr[4];
  #pragma unroll
  for(int d0=0;d0<4;++d0)qr[d0]=*reinterpret_cast<const bf16x8*>(&Qw[(long)r32*DM+d0*16+hi*8]);
  float l_reg=(SWA&&hi==0)?1.f:0.f;f32x16 o[2];o[0]=f32x16{};o[1]=f32x16{};float bm=0.f;
  const int qrel=wid*QBLK+r32;
  #define CMASK(P0,P1,t) do{ if(SWA){ wmask(P0,P1,q0+qrel-(TL+(t))*KVBLK-4*hi); } else { int jb_=(t)-(NT-4); if(jb_>=0)cmask(P0,P1,jb_,qrel,hi); } }while(0)
  bool resc=false;
  #define START(P0,P1) do{ const float rm=rowmax(P0,P1); resc=false; \
    { const float dl=SWA?((__any(rm>(float)THRL))?__builtin_fmaxf(rm,0.f):0.f):rm; \
      _Pragma("unroll") for(int r=0;r<16;++r){P0[r]=fsub_s(P0[r],dl);P1[r]=fsub_s(P1[r],dl);} \
      bm=fsub_s(bm,dl); if(SWA)l_reg*=__builtin_amdgcn_exp2f(-dl); } \
    _Pragma("unroll") for(int r=0;r<16;++r)P0[r]=__builtin_amdgcn_exp2f(P0[r]); }while(0)
  #define RESC() do{ if(resc){ asm volatile("s_waitcnt lgkmcnt(0)":::"memory"); \
      _Pragma("unroll") for(int d_=0;d_<2;++d_) _Pragma("unroll") for(int r=0;r<16;++r)o[d_][r]*=wsf[crow(r,hi)]; } }while(0)
  typedef __attribute__((address_space(3))) const f32x4_t* lds_f4p;
  #define CPRE(X0,X1,tt) do{ if(!SWA){ const lds_cptr cp_=cpl+(tt)*256; _Pragma("unroll") for(int g_=0;g_<4;++g_){ const f32x4_t a_=*(lds_f4p)(cp_+32*g_), b_=*(lds_f4p)(cp_+128+32*g_); \
      X0[4*g_]=a_[0];X0[4*g_+1]=a_[1];X0[4*g_+2]=a_[2];X0[4*g_+3]=a_[3]; X1[4*g_]=b_[0];X1[4*g_+1]=b_[1];X1[4*g_+2]=b_[2];X1[4*g_+3]=b_[3]; } } }while(0)
  #define CFIN(X0,X1) do{ _Pragma("unroll") for(int r=0;r<16;++r){ if(SWA){X0[r]=bm;X1[r]=bm;} else {X0[r]=bm-X0[r];X1[r]=bm-X1[r];} } }while(0)
  f32x16 pA0,pA1,pB0,pB1;
  int sl_prev=0,sl_cur=0,sl_next=SLOTB;
  #define ROT() do{sl_prev=sl_cur;sl_cur=sl_next;sl_next=(sl_next==(NSLOT-1)*SLOTB)?0:sl_next+SLOTB;}while(0)
  DMA_K(2,2*SLOTB);
  WAIT_BAR(3);
  bm=SWA?-sink2:*(const __attribute__((address_space(3))) float*)((lds_cptr)shm+LDS_C+(q0+qrel)*4);
  CPRE(pA0,pA1,0); CFIN(pA0,pA1);
  qkt(pA0,pA1,Kbase,qr,r32,hi);asm volatile("s_nop 15\n\ts_nop 7":"+v"(pA0),"+v"(pA1));CMASK(pA0,pA1,0);
  START(pA0,pA1);
  CPRE(pB0,pB1,1);
  _Pragma("unroll") for(int r=0;r<16;++r)pA1[r]=__builtin_amdgcn_exp2f(pA1[r]);
  WAIT_BAR(0);
  DMA_K(3,0);DMA_V(1,SLOTB);
  ROT();
  kload8(kf,kp0+sl_cur);
  WAIT_BAR(2);
  s16x4 vlo[8],vhi[8]; u32x4 pw0,pw1,pw2,pw3;
  #define PKW(P,B) cvtpk_s(P[B],P[B+1])
  #define PAF(k) __builtin_bit_cast(bf16x8,pw##k)
  #define VFR(i) (bf16x8){vlo[i][0],vlo[i][1],vlo[i][2],vlo[i][3],vhi[i][0],vhi[i][1],vhi[i][2],vhi[i][3]}
  #define PIN(x) asm volatile("":"+v"(x))
  #define MX3(a,b,c) __builtin_fmaxf(__builtin_fmaxf((a),(b)),(c))
  #define GAPA(MF,A0,A1,A2,A3,W0,W1,PW) do{ MF; sacc+=A0; sacc+=A1; sacc+=A2; sacc+=A3; PIN(sacc); W0; W1; PIN(PW); SBAR(); }while(0)
  #define EX(v) __builtin_amdgcn_exp2f(v)
  #define GAPB(MF,X,B) do{ MF; X[B]=EX(X[B]); X[B+1]=EX(X[B+1]); X[B+2]=EX(X[B+2]); X[B+3]=EX(X[B+3]); PIN(X); SBAR(); }while(0)
  #define VRD(i) do{ vlo[i]=vtr(vp_+(((i)>>2)*4096+((i)&3)*1024)); vhi[i]=vtr(vp_+(((i)>>2)*4096+((i)&3)*1024+512)); }while(0)
  #define KRD(G,j) do{ if(G){ kload2(kf,kp0+sl_next,j); SBAR(); } }while(0)
  #define STEP(C0,C1,P0,P1,t,GK,GV,GL) do{ SBAR(); \
    CFIN(C0,C1); SBAR(); \
    const lds_cptr vp_=vp0+sl_prev; \
    VRD(0); SBAR(); float sacc=(P0[0]+P0[1]); \
    GAPA(C0=__builtin_amdgcn_mfma_f32_32x32x16_bf16(kf[0],qr[0],C0,0,0,0), P0[2],P0[3],P0[4],P0[5],     pw0[0]=PKW(P0,0), pw0[1]=PKW(P0,2), pw0); \
    VRD(4); SBAR(); GAPA(C1=__builtin_amdgcn_mfma_f32_32x32x16_bf16(kf[1],qr[0],C1,0,0,0), P0[6],P0[7],P0[8],P0[9],     pw0[2]=PKW(P0,4), pw0[3]=PKW(P0,6), pw0); \
    VRD(1); SBAR(); GAPA(C0=__builtin_amdgcn_mfma_f32_32x32x16_bf16(kf[2],qr[1],C0,0,0,0),   P0[10],P0[11],P0[12],P0[13], pw1[0]=PKW(P0,8), pw1[1]=PKW(P0,10), pw1); \
    VRD(5); SBAR(); GAPA(C1=__builtin_amdgcn_mfma_f32_32x32x16_bf16(kf[3],qr[1],C1,0,0,0),   P0[14],P0[15],P1[0],P1[1],   pw1[2]=PKW(P0,12),pw1[3]=PKW(P0,14), pw1); \
    VRD(2); SBAR(); GAPA(C0=__builtin_amdgcn_mfma_f32_32x32x16_bf16(kf[4],qr[2],C0,0,0,0),   P1[2],P1[3],P1[4],P1[5],     pw2[0]=PKW(P1,0), pw2[1]=PKW(P1,2), pw2); \
    VRD(6); SBAR(); GAPA(C1=__builtin_amdgcn_mfma_f32_32x32x16_bf16(kf[5],qr[2],C1,0,0,0),   P1[6],P1[7],P1[8],P1[9],     pw2[2]=PKW(P1,4), pw2[3]=PKW(P1,6), pw2); \
    VRD(3); SBAR(); GAPA(C0=__builtin_amdgcn_mfma_f32_32x32x16_bf16(kf[6],qr[3],C0,0,0,0),   P1[10],P1[11],P1[12],P1[13], pw3[0]=PKW(P1,8), pw3[1]=PKW(P1,10), pw3); \
    VRD(7); SBAR(); GAPA(C1=__builtin_amdgcn_mfma_f32_32x32x16_bf16(kf[7],qr[3],C1,0,0,0),   P1[14],P1[15],0.f,0.f,       pw3[2]=PKW(P1,12),pw3[3]=PKW(P1,14), pw3); \
    l_reg+=sacc; \
    if(GK){DMA_K((t)+3,sl_cur);} if(GV){DMA_V((t)+1,sl_next);} \
    CMASK(C0,C1,t); \
    { float a=MX3(C0[0],C0[1],C1[0]),b=MX3(C0[2],C0[3],C1[1]); a=MX3(a,C1[2],C1[3]); \
      _Pragma("unroll") for(int r=4;r<16;r+=4){a=MX3(a,C0[r],C0[r+1]);b=MX3(b,C0[r+2],C0[r+3]);a=MX3(a,C1[r],C1[r+1]);b=MX3(b,C1[r+2],C1[r+3]);} \
      float rm=__builtin_fmaxf(a,b); { auto rr=__builtin_amdgcn_permlane32_swap(__float_as_uint(rm),__float_as_uint(rm),false,false); rm=__builtin_fmaxf(__uint_as_float(rr[0]),__uint_as_float(rr[1])); } \
      resc=false; \
      if(__builtin_expect(__any(rm>(float)THRL),0)){ const float dl=__builtin_fmaxf(rm,0.f); \
        _Pragma("unroll") for(int r=0;r<16;++r){C0[r]-=dl;C1[r]-=dl;} \
        bm-=dl; \
        const float f=__builtin_amdgcn_exp2f(-dl); l_reg*=f; if(hi==0)wsf[r32]=f; resc=true; } } \
    SBAR(); \
    GAPB(o[0]=__builtin_amdgcn_mfma_f32_32x32x16_bf16(PAF(0),VFR(0),o[0],0,0,0), C0,0); \
    GAPB(o[1]=__builtin_amdgcn_mfma_f32_32x32x16_bf16(PAF(0),VFR(4),o[1],0,0,0), C0,4); \
    KRD(GL,0); GAPB(o[0]=__builtin_amdgcn_mfma_f32_32x32x16_bf16(PAF(1),VFR(1),o[0],0,0,0), C0,8); \
    KRD(GL,1); GAPB(o[1]=__builtin_amdgcn_mfma_f32_32x32x16_bf16(PAF(1),VFR(5),o[1],0,0,0), C0,12); \
    KRD(GL,2); GAPB(o[0]=__builtin_amdgcn_mfma_f32_32x32x16_bf16(PAF(2),VFR(2),o[0],0,0,0), C1,0); \
    KRD(GL,3); GAPB(o[1]=__builtin_amdgcn_mfma_f32_32x32x16_bf16(PAF(2),VFR(6),o[1],0,0,0), C1,4); \
    GAPB(o[0]=__builtin_amdgcn_mfma_f32_32x32x16_bf16(PAF(3),VFR(3),o[0],0,0,0), C1,8); \
    GAPB(o[1]=__builtin_amdgcn_mfma_f32_32x32x16_bf16(PAF(3),VFR(7),o[1],0,0,0), C1,12); \
    if(GL){ CPRE(P0,P1,(t)+1); SBAR(); } \
    }while(0)
  int t=1;
  #undef CMASK
  #define CMASK(P0,P1,t) do{}while(0)
  for(;t+5<NT;t+=2){
    STEP(pB0,pB1,pA0,pA1,t,true,true,true);     WAIT_BAR(2); RESC(); ROT();
    STEP(pA0,pA1,pB0,pB1,t+1,true,true,true);   WAIT_BAR(2); RESC(); ROT();
  }
  #undef CMASK
  #define CMASK(P0,P1,t) do{ if(SWA){ wmask(P0,P1,q0+qrel-(TL+(t))*KVBLK-4*hi); } else { int jb_=(t)-(NT-4); if(jb_>=0)cmask(P0,P1,jb_,qrel,hi); } }while(0)
  #define ENDW(tt) do{ if((tt)+3<NT){WAIT_BAR(2);} else if((tt)+2<NT){WAIT_BAR(1);} else {WAIT_BAR(0);} }while(0)
  for(;t+1<NT;t+=2){
    STEP(pB0,pB1,pA0,pA1,t,(t+3<NT),(t+1<NT),(t+1<NT));       ENDW(t);   RESC(); ROT();
    STEP(pA0,pA1,pB0,pB1,t+1,(t+4<NT),(t+2<NT),(t+2<NT));     ENDW(t+1); RESC(); ROT();
  }
  STEP(pB0,pB1,pA0,pA1,NT-1,false,false,false); RESC();
  { float sacc=pB0[0]+pB0[1]; _Pragma("unroll") for(int r=2;r<16;++r)sacc+=pB0[r]; _Pragma("unroll") for(int r=0;r<16;++r)sacc+=pB1[r]; l_reg+=sacc;
    pw0=(u32x4){PKW(pB0,0),PKW(pB0,2),PKW(pB0,4),PKW(pB0,6)};pw1=(u32x4){PKW(pB0,8),PKW(pB0,10),PKW(pB0,12),PKW(pB0,14)};pw2=(u32x4){PKW(pB1,0),PKW(pB1,2),PKW(pB1,4),PKW(pB1,6)};pw3=(u32x4){PKW(pB1,8),PKW(pB1,10),PKW(pB1,12),PKW(pB1,14)};
    SBAR(); pv(o,vb0+sl_cur,PAF(0),PAF(1),PAF(2),PAF(3)); }
  #undef PKW
  #undef PAF
  #undef VFR
  #undef PIN
  #undef MX3
  #undef GAPA
  #undef GAPB
  #undef EX
  #undef VRD
  #undef KRD
  #undef STEP
  #undef ENDW
  {auto rr=__builtin_amdgcn_permlane32_swap(__float_as_uint(l_reg),__float_as_uint(l_reg),false,false);l_reg=__uint_as_float(rr[0])+__uint_as_float(rr[1]);}
  if(hi==0)wsf[32+r32]=l_reg;asm volatile("s_waitcnt lgkmcnt(0)":::"memory");
  float rli[16];
  #pragma unroll
  for(int r=0;r<16;++r)rli[r]=__builtin_amdgcn_rcpf(wsf[32+crow(r,hi)]);
  bf16*Ow=O+(rowbase+q0+wid*QBLK)*DM+h*D;
  { bf16*stg=(bf16*)(shm+LDS_OST)+wid*2048;
    #pragma unroll
    for(int r=0;r<16;++r){const int orow=crow(r,hi);
      #pragma unroll
      for(int d0=0;d0<2;++d0)stg[orow*64+d0*32+r32]=(bf16)f2bf(o[d0][r]*rli[r]);}
    asm volatile("s_waitcnt lgkmcnt(0)":::"memory");
    #pragma unroll
    for(int i=0;i<4;++i){const int row=i*8+(lane>>3),ch=lane&7; const u32x4 v=*(const u32x4*)(stg+row*64+ch*8); ATTN_STORE16(Ow+(long)row*DM+ch*8,v);} }
  asm volatile("s_waitcnt lgkmcnt(0)\n\ts_barrier":::"memory");
  #undef DMA_K
  #undef DMA_V
  #undef CMASK
  #undef START
  #undef RESC
  #undef ROT
  #undef CPRE
  #undef CFIN
}
constexpr int ATTN_LDS_BYTES=LDS_BYTES;
struct AttnTensors { const bf16* Q; const bf16* K; const bf16* V; bf16* O; };
struct AttnUnit { int bh; int qb; };
struct StaticOrder {
  int vcu;
  __device__ __forceinline__ explicit StaticOrder(int grid,int block):vcu((grid%8==0)?(block%8)*(grid/8)+block/8:block){}
  __device__ __forceinline__ bool next(int i,AttnUnit&u)const{ if(i>=4)return false; const int s=vcu&1; u.bh=vcu>>1; u.qb=(i==0)?7-s:(i==1)?s:(i==2)?4+s:3-s; return u.bh<BATCH*NHEAD; }
};
template<class Sched,bool SWA,int THRL=8> __device__ __forceinline__ void attn_phase(int tid,char*lds,const AttnTensors&T,const float*CUM,const float*sinks,const Sched&S){
  AttnUnit u;
  for(int i=0;S.next(i,u);++i){ attn_unit<THRL,SWA>(tid,u.bh/NHEAD,u.bh%NHEAD,u.qb,T.Q,T.K,T.V,T.O,SWA?CUM:CUM+(size_t)u.bh*SEQ,SWA?sinks[u.bh%NHEAD]*1.4426950408889634f:0.f,lds); }
}
#undef SBAR
#undef WAIT_BAR
}

#ifndef USE8_FOX
#define USE8_FOX 1
#endif
#ifndef USE8_SWA
#define USE8_SWA 1
#endif
__device__ __forceinline__ void p_proj(const Ctx& C, int layer) {
    const int j = layer >> 1; const bool fox = layer & 1;
    const float* st = layer ? C.stats(2 * (layer - 1) + 1) : nullptr;
    const float* cs = C.vec(V_PROJ_CS) + layer * FOX_NALL; const float* cb = C.vec(V_PROJ_CB) + layer * FOX_NALL;
    const bf16* Z = C.Z(); bf16 *Q = C.Q(), *Kp = C.Kb(), *Vp = C.Vb();
    const bf16* W = fox ? (const bf16*)(C.ws + WS_WIN_FOX) + (size_t)j * FOX_N * 1024 : (const bf16*)(C.ws + WS_WIN_SWA) + (size_t)j * SWA_N * 1024;
    const int N = fox ? FOX_N : SWA_N;
    sgemm<false, 1024>(C.lane, C.gw, C.ngw, M / 32, N / 32,
        [](int, int) { return NoTile{}; },
        [=](NoTile, int r) { return Z + (size_t)r * D; },
        [=](NoTile, int n, int k, int) { return W + (size_t)n * D + k; },
        [=](NoTile, int r, int c, float v, float) {
            const f32x2 ms = row_stats(st, r); const float x = ms.y * (v - ms.x * cs[c]) + cb[c];
            if (fox) { const int t = c >> 10, cc = c & 1023; bf16* dst = Q + (size_t)t * ((WS_K - WS_Q) / 2); dst[(size_t)r * 1024 + cc] = (bf16)f2bf(t == 0 ? x * C2 : x); }
            else { if (c < 1024) Q[(size_t)r * 1024 + c] = (bf16)f2bf(x * C2); else if (c < 1280) Kp[(size_t)r * 256 + c - 1024] = (bf16)f2bf(x); else Vp[(size_t)r * 256 + c - 1280] = (bf16)f2bf(x); }
        });
    if (fox) {
        const bf16* WF = (const bf16*)(C.ws + WS_WF) + (size_t)j * 16 * 1024; float* LG = (float*)(C.ws + WS_LG);
        const int lr = C.lane & 15, lq = C.lane >> 4;
        for (int t = C.gw; t < M / 16; t += C.ngw) {
            const int r0 = t * 16; const f32x4 acc = thin16(Z, r0, WF, C.lane);
            const float bf_ = C.fox_b_f[j * 16 + lr], csv = cs[FOX_N + lr], cbv = cb[FOX_N + lr];
            f32x4 o;
#pragma unroll
            for (int rg = 0; rg < 4; ++rg) { const int r = r0 + 4 * lq + rg; const f32x2 ms = row_stats(st, r);
                const float xg = ms.y * (acc[rg] - ms.x * csv) + cbv + bf_;
                o[rg] = fminf(xg, 0.f) - log1pf(expf(-fabsf(xg))); }
            const int b = r0 / S, s = (r0 % S) + 4 * lq;
            *(f32x4*)(LG + (size_t)(b * 16 + lr) * S + s) = o;
        }
    }
}
__device__ __forceinline__ void p_rope_or_scan(const Ctx& C, int layer) {
    if (!(layer & 1)) {
        const float* T = (const float*)(C.ws + WS_ROPE); bf16 *Q = C.Q(), *Kp = C.Kb();
        const int nth = C.nwg * 512, gt = C.wg * 512 + C.tid;
        for (int i = gt; i < M * 20 * 8; i += nth) { const int jj = i & 7, hs = (i >> 3) % 20, r = i / 160, pos = r % S;
            bf16* p = hs < 16 ? Q + (size_t)r * 1024 + hs * 64 + jj : Kp + (size_t)r * 256 + (hs - 16) * 64 + jj;
            const float x1 = bf2f(p[0]), x2 = bf2f(p[8]), cs = T[pos * 8 + jj], sn = T[S * 8 + pos * 8 + jj];
            p[0] = (bf16)f2bf(x1 * cs - x2 * sn); p[8] = (bf16)f2bf(x2 * cs + x1 * sn); }
    } else {
        const float* LG = (const float*)(C.ws + WS_LG); float* CU = (float*)(C.ws + WS_CUM);
        for (int bh = C.gw; bh < NB * 16; bh += C.ngw) {
            double carry = 0.0;
            for (int ch = 0; ch < S / 64; ++ch) { double v = (double)LG[(size_t)bh * S + ch * 64 + C.lane];
#pragma unroll
                for (int o = 1; o < 64; o <<= 1) { const double u = __shfl_up(v, o); if (C.lane >= o) v += u; }
                v += carry; CU[(size_t)bh * S + ch * 64 + C.lane] = (float)(v * (double)LOG2E); carry = __shfl(v, 63); }
        }
    }
}
__device__ __forceinline__ void p_attn_fox8(const Ctx& C) {
    const fox::AttnTensors AT{(const fox::bf16*)C.Q(), (const fox::bf16*)C.Kb(), (const fox::bf16*)C.Vb(), (fox::bf16*)C.Q()};
    const fox::StaticOrder S(C.nwg, C.wg);
    fox::attn_phase<fox::StaticOrder, false>(C.tid, C.ldsg, AT, (const float*)(C.ws + WS_CUM), nullptr, S);
}
__device__ __forceinline__ void p_attn_swa8(const Ctx& C, int layer) {
    const fox::AttnTensors AT{(const fox::bf16*)C.Q(), (const fox::bf16*)C.Kb(), (const fox::bf16*)C.Vb(), (fox::bf16*)C.Q()};
    const fox::StaticOrder S(C.nwg, C.wg);
    fox::attn_phase<fox::StaticOrder, true>(C.tid, C.ldsg, AT, nullptr, C.swa_sinks + (layer >> 1) * 16, S);
}
__device__ __forceinline__ void p_attn(const Ctx& C, int layer) {
    const int j = layer >> 1; bf16* Q = C.Q(); const bf16 *Kp = C.Kb(), *Vp = C.Vb(); const int lane = C.lane;
    if (!(layer & 1)) {
        for (int t = C.gw; t < M * 16; t += C.ngw) {
            const int r = t >> 4, h = t & 15, kh = h >> 2, b = r / S, pos = r % S;
            float q[64];
#pragma unroll
            for (int d0 = 0; d0 < 8; ++d0) { const bf16x8 v = *(const bf16x8*)(Q + (size_t)r * 1024 + h * 64 + d0 * 8);
#pragma unroll
                for (int e = 0; e < 8; ++e) q[d0 * 8 + e] = bf2f((bf16)v[e]); }
            float sc[2]; int srow[2];
#pragma unroll
            for (int u = 0; u < 2; ++u) { const int s = pos - 127 + 64 * u + lane; srow[u] = b * S + (s < 0 ? 0 : s); float a = 0.f;
#pragma unroll
                for (int d0 = 0; d0 < 8; ++d0) { const bf16x8 v = *(const bf16x8*)(Kp + (size_t)srow[u] * 256 + kh * 64 + d0 * 8);
#pragma unroll
                    for (int e = 0; e < 8; ++e) a += q[d0 * 8 + e] * bf2f((bf16)v[e]); }
                sc[u] = s < 0 ? -INFINITY : a; }
            const float sink2 = C.swa_sinks[j * 16 + h] * LOG2E;
            const float m = fmaxf(wave_max(fmaxf(sc[0], sc[1])), sink2);
            const float p0 = exp2f(sc[0] - m), p1 = exp2f(sc[1] - m);
            const float l = wave_sum(p0 + p1) + exp2f(sink2 - m);
            float o = 0.f;
            for (int i = 0; i < 64; ++i) { const float pa = __shfl(p0, i), pb = __shfl(p1, i); const int ra = __shfl(srow[0], i), rb = __shfl(srow[1], i);
                o += pa * bf2f(Vp[(size_t)ra * 256 + kh * 64 + lane]) + pb * bf2f(Vp[(size_t)rb * 256 + kh * 64 + lane]); }
            Q[(size_t)r * 1024 + h * 64 + lane] = (bf16)f2bf(o / l);
        }
    } else {
        const float* CU = (const float*)(C.ws + WS_CUM); LAS float* sc = (LAS float*)(C.lds + C.wave * 8192);
        for (int t = C.gw; t < M * 16; t += C.ngw) {
            const int r = t >> 4, h = t & 15, b = r / S, pos = r % S, nk = pos + 1; const float* cu = CU + (size_t)(b * 16 + h) * S;
            float q[64];
#pragma unroll
            for (int d0 = 0; d0 < 8; ++d0) { const bf16x8 v = *(const bf16x8*)(Q + (size_t)r * 1024 + h * 64 + d0 * 8);
#pragma unroll
                for (int e = 0; e < 8; ++e) q[d0 * 8 + e] = bf2f((bf16)v[e]); }
            const float ct = cu[pos]; float mx = -INFINITY;
            for (int s = lane; s < nk; s += 64) { float a = 0.f;
#pragma unroll
                for (int d0 = 0; d0 < 8; ++d0) { const bf16x8 v = *(const bf16x8*)(Kp + (size_t)(b * S + s) * 1024 + h * 64 + d0 * 8);
#pragma unroll
                    for (int e = 0; e < 8; ++e) a += q[d0 * 8 + e] * bf2f((bf16)v[e]); }
                a += ct - cu[s]; sc[s] = a; mx = fmaxf(mx, a); }
            const float m = wave_max(mx); float sum = 0.f;
            for (int s = lane; s < nk; s += 64) { const float p = exp2f(sc[s] - m); sc[s] = p; sum += p; }
            const float l = wave_sum(sum);
            LDS_WAIT(); asm volatile("" ::: "memory");
            float o = 0.f; const bf16* vp = Vp + (size_t)(b * S) * 1024 + h * 64 + lane;
            int s = 0;
            for (; s + 4 <= nk; s += 4) { const float v0 = bf2f(vp[(size_t)s * 1024]), v1 = bf2f(vp[(size_t)(s + 1) * 1024]), v2 = bf2f(vp[(size_t)(s + 2) * 1024]), v3 = bf2f(vp[(size_t)(s + 3) * 1024]);
                o += sc[s] * v0; o += sc[s + 1] * v1; o += sc[s + 2] * v2; o += sc[s + 3] * v3; }
            for (; s < nk; ++s) o += sc[s] * bf2f(vp[(size_t)s * 1024]);
            Q[(size_t)r * 1024 + h * 64 + lane] = (bf16)f2bf(o / l);
            LDS_WAIT(); asm volatile("" ::: "memory");
        }
    }
}
__device__ __forceinline__ void p_oproj(const Ctx& C, int layer) {
    const float* stp = layer ? C.stats(2 * (layer - 1) + 1) : nullptr;
    const float* gp = layer ? C.ln_g + ((layer - 1) * 2 + 1) * 1024 : nullptr; const float* bp = layer ? C.ln_b + ((layer - 1) * 2 + 1) * 1024 : nullptr;
    const bf16* O = C.Q(); bf16* Z = C.Z(); const bf16* W = (const bf16*)(C.ws + WS_WO) + (size_t)layer * 1024 * 1024;
    sgemm<false, 1024>(C.lane, C.gw, C.ngw, M / 32, D / 32,
        [](int, int) { return NoTile{}; },
        [=](NoTile, int r) { return O + (size_t)r * D; },
        [=](NoTile, int n, int k, int) { return W + (size_t)n * D + k; },
        [=](NoTile, int r, int c, float v, float) {
            const f32x2 ms = row_stats(stp, r); const float zb = bf2f(Z[(size_t)r * D + c]);
            const float xin = gp ? (zb - ms.x) * ms.y * gp[c] + bp[c] : zb;
            Z[(size_t)r * D + c] = (bf16)f2bf(ALPHA * xin + v);
        });
}
__device__ __forceinline__ void p_stats(const Ctx& C, int inst) {
    const bf16* Z = C.Z(); float* st = C.stats(inst);
    for (int r = C.gw; r < M; r += C.ngw) {
        const bf16x8 a = *(const bf16x8*)(Z + (size_t)r * D + C.lane * 16), b = *(const bf16x8*)(Z + (size_t)r * D + C.lane * 16 + 8);
        float s = 0.f, q = 0.f;
#pragma unroll
        for (int e = 0; e < 8; ++e) { const float x = bf2f((bf16)a[e]), y = bf2f((bf16)b[e]); s += x + y; q += x * x + y * y; }
        s = wave_sum(s); q = wave_sum(q);
        float zf = 0.f; asm volatile("" : "+v"(zf));
        if (C.lane == 0) { *(f32x4*)(st + (size_t)r * 8) = (f32x4){s, q, zf, zf}; *(f32x4*)(st + (size_t)r * 8 + 4) = (f32x4){zf, zf, zf, zf}; }
    }
}
__device__ __forceinline__ void p_router(const Ctx& C, int layer) {
    const float* st = C.stats(2 * layer); const bf16* Z = C.Z(); const bf16* WR = (const bf16*)(C.ws + WS_WR) + (size_t)layer * 16 * 1024;
    const float* cs = C.vec(V_RT_CS) + layer * 16; const float* cb = C.vec(V_RT_CB) + layer * 16;
    LAS float* lg = (LAS float*)(C.lds + C.wave * 1280);
    LAS int* hist = (LAS int*)(C.lds + 16384); LAS int* base = hist + 32;
    unsigned* gcnt = C.ctl() + CW_CNT + 32 * layer; int* cls_o = C.cls(); f32x2* gates = C.gates(); int* list = C.list();
    const int lane = C.lane, lr = lane & 15, lq = lane >> 4;
    for (int blk = C.wg; blk < M / 64; blk += C.nwg) {
        if (C.tid < 32) hist[C.tid] = 0;
        __syncthreads();
        int tok = -1, cl = 0, lslot = 0;
        if (C.wave < 4) {
            const int r0 = blk * 64 + C.wave * 16; const f32x4 acc = thin16(Z, r0, WR, lane);
            const float csv = cs[lr], cbv = cb[lr] + C.b_router[lr];
#pragma unroll
            for (int rg = 0; rg < 4; ++rg) { const int row = 4 * lq + rg; const f32x2 ms = row_stats(st, r0 + row); lg[row * 17 + lr] = ms.y * (acc[rg] - ms.x * csv) + cbv; }
            LDS_WAIT(); asm volatile("" ::: "memory");
            if (lane < 16) {
                float l[16], mx = -INFINITY;
#pragma unroll
                for (int e = 0; e < 16; ++e) { l[e] = lg[lane * 17 + e]; mx = fmaxf(mx, l[e]); }
#pragma unroll
                for (int e = 0; e < 16; ++e) l[e] = expf(l[e] - mx);
                float gs[4];
#pragma unroll
                for (int g = 0; g < 4; ++g) { const float a0 = l[4 * g], a1 = l[4 * g + 1], a2 = l[4 * g + 2], a3 = l[4 * g + 3];
                    gs[g] = fmaxf(fmaxf(fmaxf(a0 + a1, a0 + a2), fmaxf(a0 + a3, a1 + a2)), fmaxf(a1 + a3, a2 + a3)); }
                int best = 0; float bv = gs[0];
#pragma unroll
                for (int g = 1; g < 4; ++g) if (gs[g] > bv) { bv = gs[g]; best = g; }
                float a[4];
#pragma unroll
                for (int k = 0; k < 4; ++k) a[k] = best == 0 ? l[k] : (best == 1 ? l[4 + k] : (best == 2 ? l[8 + k] : l[12 + k]));
                int i1 = 0; float v1 = a[0];
#pragma unroll
                for (int k = 1; k < 4; ++k) if (a[k] > v1) { v1 = a[k]; i1 = k; }
                int i2 = -1; float v2 = -1.f;
#pragma unroll
                for (int k = 0; k < 4; ++k) if (k != i1 && a[k] > v2) { v2 = a[k]; i2 = k; }
                const int lo = i1 < i2 ? i1 : i2, hi = i1 < i2 ? i2 : i1;
                const int pidx = lo == 0 ? hi - 1 : (lo == 1 ? hi + 1 : 5);
                const float inv = 1.f / (v1 + v2), g1 = v1 * inv, g2 = v2 * inv;
                cl = best * 6 + pidx; tok = r0 + lane;
                cls_o[tok] = cl; gates[tok] = i1 < i2 ? (f32x2){g1, g2} : (f32x2){g2, g1};
                lslot = atomicAdd((int*)(hist + cl), 1);
            }
        }
        __syncthreads();
        if (C.tid < NCLS) base[C.tid] = (int)atomicAdd(gcnt + C.tid, (unsigned)hist[C.tid]);
        __syncthreads();
        if (tok >= 0) list[cl * M + base[cl] + lslot] = tok;
        __syncthreads();
    }
}
struct ClsTile { int c, base, cnt, e1, e2; };
__device__ __forceinline__ int cls_layout(const Ctx& C, int layer, LAS int* cbase  , LAS int* ccnt  ) {
    if (C.tid == 0) { const unsigned* gcnt = C.ctl() + CW_CNT + 32 * layer; int acc = 0;
#pragma unroll 1
        for (int c = 0; c < NCLS; ++c) { const int n = (int)__hip_atomic_load(gcnt + c, RLX_AGENT); cbase[c] = acc; ccnt[c] = n; acc += (n + 255) & ~255; }
        cbase[NCLS] = acc; }
    __syncthreads();
    return cbase[NCLS];
}
__device__ __forceinline__ ClsTile find_cls(const LAS int* cbase, const LAS int* ccnt, int R0) {
    ClsTile t; t.c = 0;
#pragma unroll 1
    for (int c = 1; c < NCLS; ++c) if (R0 >= cbase[c]) t.c = c;
    t.base = cbase[t.c]; t.cnt = ccnt[t.c]; cls_experts(t.c, t.e1, t.e2); return t;
}
__device__ __forceinline__ void p_moe_up(const Ctx& C, int layer) {
    LAS int* cbase = (LAS int*)(C.lds + 32768); LAS int* ccnt = cbase + 32;
    const int rows = cls_layout(C, layer, cbase, ccnt);
    const float* st = C.stats(2 * layer); const bf16* Z = C.Z(); bf16* ACT = C.ACT(); const int* list = C.list(); const f32x2* gates = C.gates();
    const bf16* WGU = (const bf16*)(C.ws + WS_WGU) + (size_t)layer * 16 * 512 * 1024;
    const float* gcs = C.vec(V_GU_CS) + layer * 16 * 512; const float* gcb = C.vec(V_GU_CB) + layer * 16 * 512;
    sgemm<true, 1024>(C.lane, C.gw, C.ngw, rows / 32, 512 / 32,
        [=](int tm, int) { return find_cls(cbase, ccnt, tm * 32); },
        [=](const ClsTile& t, int R) { const int li = R - t.base; const int tok = list[t.c * M + (li < t.cnt ? li : 0)]; return Z + (size_t)tok * D; },
        [=](const ClsTile& t, int n, int k, int which) { const int e = (n >> 8) ? t.e2 : t.e1, f = n & 255; return WGU + ((size_t)e * 512 + (f >> 7) * 256 + which * 128 + (f & 127)) * D + k; },
        [=](const ClsTile& t, int R, int n, float vg, float vu) {
            const int li = R - t.base; const bool valid = li < t.cnt; const int tok = list[t.c * M + (valid ? li : 0)];
            const int wh = n >> 8, e = wh ? t.e2 : t.e1, f = n & 255, row = (f >> 7) * 256 + (f & 127);
            const f32x2 ms = row_stats(st, tok);
            const float hg = ms.y * (vg - ms.x * gcs[e * 512 + row]) + gcb[e * 512 + row], hu = ms.y * (vu - ms.x * gcs[e * 512 + row + 128]) + gcb[e * 512 + row + 128];
            const f32x2 gt = gates[tok]; const float gate = wh ? gt.y : gt.x;
            const float act = valid ? hg / (1.f + expf(-hg)) * hu * gate : 0.f;
            ACT[(size_t)R * 512 + n] = (bf16)f2bf(act);
        });
}
__device__ __forceinline__ void p_moe_down(const Ctx& C, int layer) {
    LAS int* cbase = (LAS int*)(C.lds + 32768); LAS int* ccnt = cbase + 32;
    const int rows = cls_layout(C, layer, cbase, ccnt);
    const float* st = C.stats(2 * layer); const float* g1 = C.ln_g + (layer * 2) * 1024; const float* b1 = C.ln_b + (layer * 2) * 1024;
    bf16* Z = C.Z(); const bf16* ACT = C.ACT(); const int* list = C.list();
    const bf16* WD = (const bf16*)(C.ws + WS_WD) + (size_t)layer * 16 * 1024 * 256;
    sgemm<false, 512>(C.lane, C.gw, C.ngw, rows / 32, D / 32,
        [=](int tm, int) { return find_cls(cbase, ccnt, tm * 32); },
        [=](const ClsTile&, int R) { return ACT + (size_t)R * 512; },
        [=](const ClsTile& t, int n, int k, int) { return WD + ((size_t)(k < 256 ? t.e1 : t.e2) * 1024 + n) * 256 + (k & 255); },
        [=](const ClsTile& t, int R, int n, float v, float) {
            const int li = R - t.base; if (li >= t.cnt) return; const int tok = list[t.c * M + li];
            const f32x2 ms = row_stats(st, tok); const float zb = bf2f(Z[(size_t)tok * D + n]);
            const float x1 = (zb - ms.x) * ms.y * g1[n] + b1[n];
            Z[(size_t)tok * D + n] = (bf16)f2bf(ALPHA * x1 + v);
        });
}
__device__ __forceinline__ void p_proj8(const Ctx& C, int layer) {
    const int j = layer >> 1; const bool fox = layer & 1;
    const float* st = layer ? C.stats(2 * (layer - 1) + 1) : nullptr;
    const float* cs = C.vec(V_PROJ_CS) + layer * FOX_NALL; const float* cb = C.vec(V_PROJ_CB) + layer * FOX_NALL;
    const bf16* Z = C.Z();
    const bf16* W = fox ? (const bf16*)(C.ws + WS_WIN_FOX) + (size_t)j * FOX_N * 1024 : (const bf16*)(C.ws + WS_WIN_SWA) + (size_t)j * SWA_N * 1024;
    const int N = fox ? FOX_N : SWA_N;
    { pg8::ProbPlain P{Z, W, M / 256, N / 256, C.nwg, C.wg}; pg8::EpiProj E{fox, st, cs, cb, (const float*)(C.ws + WS_ROPE), C.Q()}; pg8::gemm_phase(C, P, E); }
    if (fox) {
        const bf16* WF = (const bf16*)(C.ws + WS_WF) + (size_t)j * 16 * 1024; float* LG = (float*)(C.ws + WS_LG);
        const int lr = C.lane & 15, lq = C.lane >> 4;
        for (int t = C.gw; t < M / 16; t += C.ngw) {
            const int r0 = t * 16; const f32x4 acc = thin16(Z, r0, WF, C.lane);
            const float bf_ = C.fox_b_f[j * 16 + lr], csv = cs[FOX_N + lr], cbv = cb[FOX_N + lr];
            f32x4 o;
#pragma unroll
            for (int rg = 0; rg < 4; ++rg) { const int r = r0 + 4 * lq + rg; const f32x2 ms = row_stats(st, r);
                const float xg = ms.y * (acc[rg] - ms.x * csv) + cbv + bf_;
                o[rg] = fminf(xg, 0.f) - log1pf(expf(-fabsf(xg))); }
            const int b = r0 / S, s = (r0 % S) + 4 * lq;
            *(f32x4*)(LG + (size_t)(b * 16 + lr) * S + s) = o;
        }
    }
}
__device__ __forceinline__ void p_oproj8(const Ctx& C, int layer) {
    const float* stp = layer ? C.stats(2 * (layer - 1) + 1) : nullptr;
    const float* gp = layer ? C.ln_g + ((layer - 1) * 2 + 1) * 1024 : nullptr; const float* bp = layer ? C.ln_b + ((layer - 1) * 2 + 1) * 1024 : nullptr;
    pg8::ProbPlain P{C.Q(), (const bf16*)(C.ws + WS_WO) + (size_t)layer * 1024 * 1024, M / 256, D / 256, C.nwg, C.wg};
    pg8::EpiOut E{stp, gp, bp, C.Z(), C.stats(2 * layer)};
    pg8::gemm_phase(C, P, E);
}
__device__ __forceinline__ void p_moe_up8(const Ctx& C, int layer) {
    LAS int* cbase = (LAS int*)(C.lds + pg8::LDS_CLS); LAS int* ccnt = cbase + 32;
    const int rows = cls_layout(C, layer, cbase, ccnt);
    pg8::ProbUp P{C.Z(), (const bf16*)(C.ws + WS_WGU) + (size_t)layer * 16 * 512 * 1024, C.list(), cbase, ccnt, rows / 256, C.nwg, C.wg};
    pg8::EpiUp E{C.stats(2 * layer), C.list(), C.gates(), C.vec(V_GU_CS) + layer * 16 * 512, C.vec(V_GU_CB) + layer * 16 * 512, C.ACT()};
    pg8::gemm_phase(C, P, E);
}
__device__ __forceinline__ void p_moe_down8(const Ctx& C, int layer) {
    LAS int* cbase = (LAS int*)(C.lds + pg8::LDS_CLS); LAS int* ccnt = cbase + 32;
    const int rows = cls_layout(C, layer, cbase, ccnt);
    pg8::ProbDown P{C.ACT(), (const bf16*)(C.ws + WS_WD) + (size_t)layer * 16 * 1024 * 256, cbase, ccnt, rows / 256, C.nwg, C.wg};
    pg8::EpiDown E{C.stats(2 * layer), C.ln_g + (layer * 2) * 1024, C.ln_b + (layer * 2) * 1024, C.list(), C.Z(), C.stats(2 * layer + 1)};
    pg8::gemm_phase(C, P, E);
}
__device__ __forceinline__ void p_final(const Ctx& C) {
    const float* st = C.stats(7); const float* g = C.ln_g + 7 * 1024; const float* b = C.ln_b + 7 * 1024; const bf16* Z = C.Z();
    for (int r = C.gw; r < M; r += C.ngw) {
        const f32x2 ms = row_stats(st, r);
#pragma unroll
        for (int u = 0; u < 2; ++u) { const int c0 = u * 512 + C.lane * 8; const bf16x8 a = *(const bf16x8*)(Z + (size_t)r * D + c0);
            const f32x4 g0 = *(const f32x4*)(g + c0), g1 = *(const f32x4*)(g + c0 + 4), b0 = *(const f32x4*)(b + c0), b1 = *(const f32x4*)(b + c0 + 4);
            f32x4 o0, o1;
#pragma unroll
            for (int e = 0; e < 4; ++e) { o0[e] = (bf2f((bf16)a[e]) - ms.x) * ms.y * g0[e] + b0[e]; o1[e] = (bf2f((bf16)a[4 + e]) - ms.x) * ms.y * g1[e] + b1[e]; }
            *(f32x4*)(C.out + (size_t)r * D + c0) = o0; *(f32x4*)(C.out + (size_t)r * D + c0 + 4) = o1; }
    }
}

__device__ __forceinline__ int fresh_lane() { int l; asm volatile("v_mbcnt_lo_u32_b32 %0, -1, 0\n\tv_mbcnt_hi_u32_b32 %0, -1, %0" : "=v"(l)); return l; }
constexpr int PH_PER_LAYER = 9, N_PHASES = 1 + DEPTH * PH_PER_LAYER + 1;
__global__ void __launch_bounds__(NWAVES * 64, 2) mk_fwd(Args args) {
    extern __shared__ __attribute__((aligned(16))) unsigned char lds_raw[];
    const int tid0 = threadIdx.x;
#define BUILD_CTX(C, ap) Ctx C; C.x = ap->in[0]; C.ln_g = ap->in[1]; C.ln_b = ap->in[2]; C.swa_w_in = ap->in[3]; C.swa_sinks = ap->in[4]; C.swa_w_o = ap->in[5]; C.fox_w_in = ap->in[6]; \
    C.fox_b_f = ap->in[7]; C.fox_w_o = ap->in[8]; C.w_router = ap->in[9]; C.b_router = ap->in[10]; C.w_gate = ap->in[11]; C.w_up = ap->in[12]; C.w_down = ap->in[13]; \
    C.out = ap->out; C.ws = ap->ws; C.lds = (LAS unsigned char*)lds_raw; C.ldsg = (char*)lds_raw; \
    C.tid = tidv; C.lane = C.tid & 63; C.wave = __builtin_amdgcn_readfirstlane(C.tid >> 6); C.wg = wgv; C.nwg = gridDim.x; C.gw = C.wg * NWAVES + C.wave; C.ngw = C.nwg * NWAVES;
    LAS unsigned char* const lds0 = (LAS unsigned char*)lds_raw;
    volatile LAS unsigned* MISC = (volatile LAS unsigned*)(lds0 + MISC_OFF);
    if (tid0 < 32) MISC[tid0] = 0u;
    __syncthreads();
    unsigned* const ctl0 = (unsigned*)(args.ws + WS_CTL);
    XcdBarrier bar; bar.bar = ctl0 + CW_BAR; bar.x = 0; bar.st = nullptr;
    const bool one = (args.ph_hi - args.ph_lo) > 1;
    const int waveS = __builtin_amdgcn_readfirstlane(tid0 >> 6);
#define FRESH_TID() (waveS * 64 + fresh_lane())
    if (one) bar = xcd_barrier_post(ctl0 + CW_BAR, MISC + 8, tid0);
    for (int ph = args.ph_lo; ph < args.ph_hi; ++ph) {
#define RUN(body) do { const __attribute__((address_space(4))) Args* ap = (const __attribute__((address_space(4))) Args*)__builtin_amdgcn_kernarg_segment_ptr(); int tidv = FRESH_TID(); int wgv = blockIdx.x; asm volatile("" : "+s"(ap), "+s"(wgv)); asm volatile("" : "+v"(tidv)); BUILD_CTX(C, ap) body; } while (0)
#define CASE(cond, body) do { int ph_ = ph; asm volatile("" : "+s"(ph_)); const int layer = (ph_ - 1) / PH_PER_LAYER, sub = (ph_ - 1) % PH_PER_LAYER; (void)layer; (void)sub; if (cond) { body; } } while (0)
        CASE(ph_ == 0, RUN(p_prologue(C)));
        CASE(ph_ == N_PHASES - 1, RUN(p_final(C)));
        CASE(ph_ > 0 && ph_ < N_PHASES - 1 && sub == 0, if (USE8_PROJ) RUN(p_proj8(C, layer)); else RUN(p_proj(C, layer)));
        CASE(ph_ > 0 && ph_ < N_PHASES - 1 && sub == 1, if (!USE8_PROJ || (layer & 1)) RUN(p_rope_or_scan(C, layer)));
        CASE(ph_ > 0 && ph_ < N_PHASES - 1 && sub == 2, if (USE8_FOX && (layer & 1)) RUN(p_attn_fox8(C)); else if (USE8_SWA && !(layer & 1)) RUN(p_attn_swa8(C, layer)); else RUN(p_attn(C, layer)));
        CASE(ph_ > 0 && ph_ < N_PHASES - 1 && sub == 3, if (USE8_OPROJ) RUN(p_oproj8(C, layer)); else RUN(p_oproj(C, layer)));
        CASE(ph_ > 0 && ph_ < N_PHASES - 1 && sub == 4, if (!USE8_OPROJ) RUN(p_stats(C, 2 * layer)));
        CASE(ph_ > 0 && ph_ < N_PHASES - 1 && sub == 5, RUN(p_router(C, layer)));
        CASE(ph_ > 0 && ph_ < N_PHASES - 1 && sub == 6, if (USE8_UP) RUN(p_moe_up8(C, layer)); else RUN(p_moe_up(C, layer)));
        CASE(ph_ > 0 && ph_ < N_PHASES - 1 && sub == 7, if (USE8_DOWN) RUN(p_moe_down8(C, layer)); else RUN(p_moe_down(C, layer)));
        CASE(ph_ > 0 && ph_ < N_PHASES - 1 && sub == 8, if (!USE8_DOWN) RUN(p_stats(C, 2 * layer + 1)));
        if (ph + 1 < args.ph_hi) xcd_barrier(bar, FRESH_TID());
    }
}

extern "C" void kernel_launch(void* const* d_in, const int* in_sizes, int n_in, void* d_out, int out_size, void* d_ws, size_t ws_size, hipStream_t stream) {
    static int grid = 0;
    if (grid == 0) {
        if (n_in != 14 || in_sizes[0] != M * D || out_size != M * D || ws_size < WS_END) { fprintf(stderr, "kernel_launch: unexpected shapes / workspace (n_in %d, ws %zu)\n", n_in, ws_size); grid = -1; return; }
        int dev = 0, cus = 0, per_cu = 0;
        if (hipGetDevice(&dev) != hipSuccess || hipDeviceGetAttribute(&cus, hipDeviceAttributeMultiprocessorCount, dev) != hipSuccess) { grid = -1; return; }
        if (hipFuncSetAttribute((const void*)mk_fwd, hipFuncAttributeMaxDynamicSharedMemorySize, LDS_BYTES) != hipSuccess) { fprintf(stderr, "kernel_launch: hipFuncSetAttribute failed\n"); grid = -1; return; }
        if (hipOccupancyMaxActiveBlocksPerMultiprocessor(&per_cu, (const void*)mk_fwd, NWAVES * 64, LDS_BYTES) != hipSuccess || per_cu < 1) { fprintf(stderr, "kernel_launch: occupancy query says %d\n", per_cu); per_cu = 1; }
        (void)hipGetLastError();
        grid = cus * 1;
    }
    if (grid < 0) return;
    (void)hipMemsetAsync((char*)d_ws + WS_CTL, 0, CTL_BYTES, stream);
    Args a{};
    for (int i = 0; i < 14; ++i) a.in[i] = (const float*)d_in[i];
    a.out = (float*)d_out; a.ws = (unsigned char*)d_ws;
#if MK_ONE_LAUNCH
    a.ph_lo = 0; a.ph_hi = N_PHASES;
    hipLaunchKernelGGL(mk_fwd, dim3(grid), dim3(NWAVES * 64), LDS_BYTES, stream, a);
#else
    for (int ph = 0; ph < N_PHASES; ++ph) { a.ph_lo = ph; a.ph_hi = ph + 1; hipLaunchKernelGGL(mk_fwd, dim3(grid), dim3(NWAVES * 64), LDS_BYTES, stream, a); }
#endif
}
```

```cpp
#include <hip/hip_runtime.h>
#include <cstdio>
#include <cstdint>
#include <cmath>

#define GAS __attribute__((address_space(1)))
#define LAS __attribute__((address_space(3)))
typedef unsigned short bf16;
typedef short bf16x8 __attribute__((ext_vector_type(8)));
typedef float f32x4 __attribute__((ext_vector_type(4)));
typedef float f32x2 __attribute__((ext_vector_type(2)));
typedef unsigned u32x4 __attribute__((ext_vector_type(4)));
typedef unsigned u32x2 __attribute__((ext_vector_type(2)));
typedef GAS unsigned gu32;

#ifndef PROBE_MASK
#define PROBE_MASK 0
#endif
#ifndef PROBE_PAR
#define PROBE_PAR 0
#endif
#define PROBE_HIT(kind, layer) (((PROBE_MASK >> (kind)) & 1) && (PROBE_PAR == 0 || ((layer) & 1) == PROBE_PAR - 1))
#ifndef MK_ONE_LAUNCH
#define MK_ONE_LAUNCH 1
#endif

constexpr int M = 16384, D = 1024, S = 2048, NB = 8, DEPTH = 4, NE = 16, DE = 256, NCLS = 24;
constexpr int SWA_N = 1536, FOX_N = 3072, FOX_NALL = 3088;
constexpr float ALPHA = 1.6817928305074290f;
constexpr float LOG2E = 1.4426950408889634f;
constexpr float C2 = 0.125f * LOG2E;
constexpr float LN_EPS = 1e-5f;
constexpr int ACT_ROWS = 22528;

constexpr size_t MiB = 1u << 20;
constexpr size_t WS_CTL = 0, CTL_BYTES = 1 * MiB;
constexpr size_t WS_ROPE = 1 * MiB;
constexpr size_t WS_VEC = 2 * MiB;
constexpr size_t V_PROJ_CS = 0, V_PROJ_CB = 64 * 1024, V_RT_CS = 128 * 1024, V_RT_CB = 129 * 1024, V_GU_CS = 256 * 1024, V_GU_CB = 768 * 1024;
constexpr size_t WS_STATS = 4 * MiB;
constexpr size_t STATS_INST = (size_t)M * 8 * 4;
constexpr size_t WS_CLS = 8 * MiB;
constexpr size_t WS_GATES = 8 * MiB + 64 * 1024;
constexpr size_t WS_LIST = 8 * MiB + 256 * 1024;
constexpr size_t WS_LG = 10 * MiB;
constexpr size_t WS_CUM = 11 * MiB;
constexpr size_t WS_WIN_SWA = 12 * MiB;
constexpr size_t WS_WIN_FOX = 18 * MiB;
constexpr size_t WS_WF = 30 * MiB;
constexpr size_t WS_WR = 30 * MiB + 256 * 1024;
constexpr size_t WS_WO = 31 * MiB;
constexpr size_t WS_WGU = 39 * MiB;
constexpr size_t WS_WD = 103 * MiB;
constexpr size_t WS_Z = 135 * MiB;
constexpr size_t WS_Q = 167 * MiB, WS_K = 199 * MiB, WS_V = 231 * MiB;
constexpr size_t WS_ACT = 263 * MiB;
constexpr size_t WS_END = 285 * MiB;
constexpr int CW_PROBE = 8;
constexpr int CW_TMO = 0, CW_CODE = 1, CW_BAR = 4096, CW_CNT = 16384;

constexpr int LDS_BYTES = 147456;
constexpr int MISC_OFF = 131072 + 320;
constexpr int NWAVES = 8;

#define RLX_AGENT __ATOMIC_RELAXED, __HIP_MEMORY_SCOPE_AGENT
#define LDS_WAIT() asm volatile("s_waitcnt lgkmcnt(0)" ::: "memory")
__device__ __forceinline__ float bf2f(bf16 v) { return __uint_as_float((unsigned)v << 16); }
__device__ __forceinline__ unsigned f2bf(float f) { unsigned u = __float_as_uint(f); return (u + 0x7fffu + ((u >> 16) & 1u)) >> 16; }
__device__ __forceinline__ unsigned pk2(float lo, float hi) { return f2bf(lo) | (f2bf(hi) << 16); }
__device__ __forceinline__ float wave_sum(float v) {
#pragma unroll
    for (int o = 1; o < 64; o <<= 1) v += __shfl_xor(v, o);
    return v;
}
__device__ __forceinline__ float wave_max(float v) {
#pragma unroll
    for (int o = 1; o < 64; o <<= 1) v = fmaxf(v, __shfl_xor(v, o));
    return v;
}
__device__ __forceinline__ f32x4 mfma16(bf16x8 a, bf16x8 b, f32x4 c) { return __builtin_amdgcn_mfma_f32_16x16x32_bf16(a, b, c, 0, 0, 0); }

#define XB_TMO      128
#define XB_XCNT(j)  (256  + 64 * (j))
#define XB_XSUB(j)  (1280 + 64 * (j))
#define XB_XGEN(j)  (2304 + 64 * (j))
#define XB_TOP      3328
#define XB_TOPGEN   3392
#define XCD_BAR_WORDS 3456
#define XB_SPIN_CAP (1u << 18)
__device__ __forceinline__ unsigned xb_ld(unsigned* p)              { return __hip_atomic_load(p, __ATOMIC_RELAXED, __HIP_MEMORY_SCOPE_AGENT); }
__device__ __forceinline__ unsigned xb_add(unsigned* p, unsigned v) { return __hip_atomic_fetch_add(p, v, __ATOMIC_RELAXED, __HIP_MEMORY_SCOPE_AGENT); }
__device__ __forceinline__ unsigned xb_xcc_id() { return (unsigned)__builtin_amdgcn_s_getreg((3 << 11) | 20) & 0xFu; }
#define XB_SPIN(cond, bar) do { unsigned _sp = 0; while (cond) { __builtin_amdgcn_s_sleep(1); \
    if ((++_sp & 255u) == 0u) { if (xb_ld(&(bar)[XB_TMO])) break; if (_sp > XB_SPIN_CAP) { atomicAdd(&(bar)[XB_TMO], 1u); break; } } } } while (0)
struct XcdBarrier { unsigned* bar; unsigned x; volatile LAS unsigned* st; };
__device__ __forceinline__ XcdBarrier xcd_barrier_post(unsigned* bar, volatile LAS unsigned* st, int tid) {
    XcdBarrier b; b.bar = bar; b.x = xb_xcc_id(); b.st = st;
    if (tid == 0) (void)xb_add(&bar[XB_XCNT(b.x)], 1u);
    return b;
}
__device__ __forceinline__ void xcd_barrier_complete(unsigned* bar, unsigned x, unsigned& nloc, unsigned& nx) {
    const unsigned G = gridDim.x * gridDim.y * gridDim.z;
    unsigned sum, cnt, mine, sp = 0u;
    for (;;) {
        sum = 0u; cnt = 0u; mine = 0u;
        asm volatile("" : "+s"(bar), "+s"(x));
#pragma unroll
        for (unsigned j = 0; j < 16; ++j) { const unsigned c = xb_ld(&bar[XB_XCNT(j)]); sum += c; cnt += (c > 0u) ? 1u : 0u; mine = (j == x) ? c : mine; }
        if (sum == G) break;
        __builtin_amdgcn_s_sleep(1);
        if ((++sp & 255u) == 0u) { if (xb_ld(&bar[XB_TMO])) break; if (sp > XB_SPIN_CAP) { atomicAdd(&bar[XB_TMO], 1u); break; } }
    }
    nloc = mine > 0u ? mine : 1u; nx = cnt > 0u ? cnt : 1u;
}
__device__ __forceinline__ void xcd_barrier(const XcdBarrier& b, int tid) {
    asm volatile("s_waitcnt vmcnt(0)" ::: "memory");
    __syncthreads();
    if (tid == 0) {
        unsigned* bar = b.bar;
        __builtin_amdgcn_s_waitcnt(0);
        unsigned nloc = b.st[0], nx = b.st[1];
        if (nloc == 0u) { xcd_barrier_complete(bar, b.x, nloc, nx); b.st[0] = nloc; b.st[1] = nx; }
        const unsigned old = xb_add(&bar[XB_XSUB(b.x)], 1u);
        const unsigned gen = old / nloc;
        if (old + 1u == (gen + 1u) * nloc) {
            __builtin_amdgcn_fence(__ATOMIC_RELEASE, "agent");
            asm volatile("s_waitcnt vmcnt(0)" ::: "memory");
            const unsigned og = xb_add(&bar[XB_TOP], 1u);
            const unsigned tg = og / nx;
            if (og + 1u == (tg + 1u) * nx) xb_add(&bar[XB_TOPGEN], 1u);
            else XB_SPIN(xb_ld(&bar[XB_TOPGEN]) == tg, bar);
            __builtin_amdgcn_fence(__ATOMIC_ACQUIRE, "agent");
            xb_add(&bar[XB_XGEN(b.x)], 1u);
            asm volatile("s_waitcnt vmcnt(0)" ::: "memory");
        } else {
            XB_SPIN(xb_ld(&bar[XB_XGEN(b.x)]) == gen, bar);
            __builtin_amdgcn_fence(__ATOMIC_ACQUIRE, "agent");
            asm volatile("s_waitcnt vmcnt(0)" ::: "memory");
        }
    }
    __syncthreads();
}

struct Args { const float* in[14]; float* out; unsigned char* ws; int ph_lo, ph_hi; };
struct Ctx {
    const float *x, *ln_g, *ln_b, *swa_w_in, *swa_sinks, *swa_w_o, *fox_w_in, *fox_b_f, *fox_w_o, *w_router, *b_router, *w_gate, *w_up, *w_down;
    float* out; unsigned char* ws;
    LAS unsigned char* lds; char* ldsg;
    int tid, lane, wave, wg, nwg, gw, ngw;
    __device__ __forceinline__ bf16* Z() const { return (bf16*)(ws + WS_Z); }
    __device__ __forceinline__ bf16* Q() const { return (bf16*)(ws + WS_Q); }
    __device__ __forceinline__ bf16* Kb() const { return (bf16*)(ws + WS_K); }
    __device__ __forceinline__ bf16* Vb() const { return (bf16*)(ws + WS_V); }
    __device__ __forceinline__ bf16* ACT() const { return (bf16*)(ws + WS_ACT); }
    __device__ __forceinline__ float* stats(int inst) const { return (float*)(ws + WS_STATS + (size_t)inst * STATS_INST); }
    __device__ __forceinline__ float* vec(size_t off) const { return (float*)(ws + WS_VEC + off); }
    __device__ __forceinline__ unsigned* ctl() const { return (unsigned*)(ws + WS_CTL); }
    __device__ __forceinline__ int* cls() const { return (int*)(ws + WS_CLS); }
    __device__ __forceinline__ f32x2* gates() const { return (f32x2*)(ws + WS_GATES); }
    __device__ __forceinline__ int* list() const { return (int*)(ws + WS_LIST); }
};
__device__ __forceinline__ f32x2 row_stats(const float* st, int r) {
    if (!st) return (f32x2){0.f, 1.f};
    const f32x4 a = *(const f32x4*)(st + (size_t)r * 8), b = *(const f32x4*)(st + (size_t)r * 8 + 4);
    const float s = (a[0] + a[2]) + (b[0] + b[2]), q = (a[1] + a[3]) + (b[1] + b[3]);
    const float mu = s * (1.f / D), var = fmaxf(q * (1.f / D) - mu * mu, 0.f);
    return (f32x2){mu, 1.0f / sqrtf(var + LN_EPS)};
}
__device__ __forceinline__ void cls_experts(int c, int& e1, int& e2) {
    const int g = c / 6, p = c % 6;
    const int lo = p < 3 ? 0 : (p < 5 ? 1 : 2), hi = p < 3 ? p + 1 : (p < 5 ? p - 1 : 3);
    e1 = 4 * g + lo; e2 = 4 * g + hi;
}

__constant__ double ROPE_W[16] = {0.5403023058681397174, 0.8414709848078965067, 0.9812558362840285743, 0.1927095839820420340, 0.9992929765482185140, 0.0375971677311151056,
    0.9999734086383661963, 0.007292600096474082358, 0.9999990000001666667, 0.001414213090968621398, 0.9999999623939693048, 0.0002742481722384122054,
    0.9999999985857864380, 0.00005318295894437919888, 0.9999999999468170410, 0.00001031338537702962674};
struct CvtItem { const float* src; int K, N, n0, ncols; bf16* dst; int dpitch; const float* g; const float* b; float* cs; float* cb; };
__device__ __forceinline__ void cvt_item(const CvtItem& it, LAS float* scr, int lane) {
    float cs[4] = {0.f, 0.f, 0.f, 0.f}, cb[4] = {0.f, 0.f, 0.f, 0.f};
    const int c = lane & 7, nb = lane >> 3;
    const int lrow = lane >> 3, lc4 = lane & 7;
    const bool colok = lc4 * 4 < it.ncols;
    const float* sp = it.src + (size_t)lrow * it.N + it.n0 + lc4 * 4;
    f32x4 cur[8], nxt[8];
#pragma unroll
    for (int i = 0; i < 8; ++i) cur[i] = colok ? *(const f32x4*)(sp + (size_t)(8 * i) * it.N) : (f32x4){0.f, 0.f, 0.f, 0.f};
    for (int k0 = 0; k0 < it.K; k0 += 64) {
        const bool more = k0 + 64 < it.K;
        if (more) {
#pragma unroll
            for (int i = 0; i < 8; ++i) nxt[i] = colok ? *(const f32x4*)(sp + (size_t)(k0 + 64 + 8 * i) * it.N) : (f32x4){0.f, 0.f, 0.f, 0.f}; }
#pragma unroll
        for (int i = 0; i < 8; ++i) { LAS float* w = scr + (8 * i + lrow) * 33 + lc4 * 4; w[0] = cur[i][0]; w[1] = cur[i][1]; w[2] = cur[i][2]; w[3] = cur[i][3]; }
        LDS_WAIT(); asm volatile("" ::: "memory");
        float gq[8], bq[8];
#pragma unroll
        for (int q = 0; q < 8; ++q) { gq[q] = it.g ? it.g[k0 + 8 * c + q] : 1.f; bq[q] = it.b ? it.b[k0 + 8 * c + q] : 0.f; }
#pragma unroll
        for (int j = 0; j < 4; ++j) {
            const int n = nb + 8 * j; const LAS float* s = scr + (8 * c) * 33 + n;
            unsigned r[8]; float csp = 0.f, cbp = 0.f;
#pragma unroll
            for (int q = 0; q < 8; ++q) { const float w = s[q * 33]; r[q] = f2bf(w * gq[q]); csp += __uint_as_float(r[q] << 16); cbp += w * bq[q]; }
            cs[j] += csp; cb[j] += cbp;
            if (n < it.ncols) { u32x4 o; o.x = r[0] | (r[1] << 16); o.y = r[2] | (r[3] << 16); o.z = r[4] | (r[5] << 16); o.w = r[6] | (r[7] << 16);
                *(u32x4*)(it.dst + (size_t)n * it.dpitch + k0 + 8 * c) = o; }
        }
        LDS_WAIT(); asm volatile("" ::: "memory");
        if (more) {
#pragma unroll
            for (int i = 0; i < 8; ++i) cur[i] = nxt[i]; }
    }
    if (it.cs) {
#pragma unroll
        for (int j = 0; j < 4; ++j) {
            float a = cs[j], b = cb[j];
            a += __shfl_xor(a, 1); a += __shfl_xor(a, 2); a += __shfl_xor(a, 4);
            b += __shfl_xor(b, 1); b += __shfl_xor(b, 2); b += __shfl_xor(b, 4);
            const int n = nb + 8 * j;
            if (c == 0 && n < it.ncols) { it.cs[n] = a; it.cb[n] = b; }
        }
    }
}
__device__ __forceinline__ CvtItem big_item(const Ctx& C, int idx) {
    CvtItem it; it.K = 1024; it.dpitch = 1024; it.ncols = 32; it.g = nullptr; it.b = nullptr; it.cs = nullptr; it.cb = nullptr;
    if (idx < 1024) {
        const int i = idx >> 8, e = (idx >> 4) & 15, gu = (idx >> 3) & 1, blk = idx & 7;
        it.src = (gu ? C.w_up : C.w_gate) + (size_t)(i * 16 + e) * 1024 * 256; it.N = 256; it.n0 = blk * 32;
        const int row = (it.n0 >> 7) * 256 + gu * 128 + (it.n0 & 127);
        it.dst = (bf16*)(C.ws + WS_WGU) + ((size_t)(i * 16 + e) * 512 + row) * 1024;
        it.g = C.ln_g + (i * 2 + 0) * 1024; it.b = C.ln_b + (i * 2 + 0) * 1024;
        it.cs = C.vec(V_GU_CS) + (i * 16 + e) * 512 + row; it.cb = C.vec(V_GU_CB) + (i * 16 + e) * 512 + row;
        return it; }
    idx -= 1024;
    if (idx < 194) {
        const int j = idx / 97, blk = idx % 97, i = 2 * j + 1;
        it.src = C.fox_w_in + (size_t)j * 1024 * FOX_NALL; it.N = FOX_NALL; it.n0 = blk * 32; it.ncols = blk < 96 ? 32 : 16;
        it.dst = blk < 96 ? (bf16*)(C.ws + WS_WIN_FOX) + ((size_t)j * FOX_N + it.n0) * 1024 : (bf16*)(C.ws + WS_WF) + (size_t)j * 16 * 1024;
        it.g = C.ln_g + ((i - 1) * 2 + 1) * 1024; it.b = C.ln_b + ((i - 1) * 2 + 1) * 1024;
        it.cs = C.vec(V_PROJ_CS) + i * FOX_NALL + it.n0; it.cb = C.vec(V_PROJ_CB) + i * FOX_NALL + it.n0;
        return it; }
    idx -= 194;
    if (idx < 96) {
        const int j = idx / 48, blk = idx % 48, i = 2 * j;
        it.src = C.swa_w_in + (size_t)j * 1024 * SWA_N; it.N = SWA_N; it.n0 = blk * 32;
        it.dst = (bf16*)(C.ws + WS_WIN_SWA) + ((size_t)j * SWA_N + it.n0) * 1024;
        if (i > 0) { it.g = C.ln_g + ((i - 1) * 2 + 1) * 1024; it.b = C.ln_b + ((i - 1) * 2 + 1) * 1024; }
        it.cs = C.vec(V_PROJ_CS) + i * FOX_NALL + it.n0; it.cb = C.vec(V_PROJ_CB) + i * FOX_NALL + it.n0;
        return it; }
    idx -= 96;
    if (idx < 128) {
        const int i = idx >> 5, blk = idx & 31, j = i >> 1;
        it.src = ((i & 1) ? C.fox_w_o : C.swa_w_o) + (size_t)j * 1024 * 1024; it.N = 1024; it.n0 = blk * 32;
        it.dst = (bf16*)(C.ws + WS_WO) + ((size_t)i * 1024 + it.n0) * 1024;
        return it; }
    idx -= 128;
    { const int i = idx; it.src = C.w_router; it.N = 16; it.n0 = 0; it.ncols = 16;
      it.dst = (bf16*)(C.ws + WS_WR) + (size_t)i * 16 * 1024;
      it.g = C.ln_g + (i * 2 + 0) * 1024; it.b = C.ln_b + (i * 2 + 0) * 1024;
      it.cs = C.vec(V_RT_CS) + i * 16; it.cb = C.vec(V_RT_CB) + i * 16; }
    return it;
}
constexpr int N_BIG = 1024 + 194 + 96 + 128 + 4;
__device__ __forceinline__ CvtItem small_item(const Ctx& C, int q) {
    CvtItem it; const int i = q >> 9, e = (q >> 5) & 15, blk = q & 31;
    it.src = C.w_down + (size_t)(i * 16 + e) * 256 * 1024; it.K = 256; it.N = 1024; it.n0 = blk * 32; it.ncols = 32;
    it.dst = (bf16*)(C.ws + WS_WD) + ((size_t)(i * 16 + e) * 1024 + it.n0) * 256; it.dpitch = 256;
    it.g = nullptr; it.b = nullptr; it.cs = nullptr; it.cb = nullptr; return it;
}
__device__ __forceinline__ void p_prologue(const Ctx& C) {
    LAS float* scr = (LAS float*)(C.lds + C.wave * 8704);
    for (int sl = C.gw; sl < N_BIG + 512; sl += C.ngw) {
        if (sl < N_BIG) { const CvtItem it = big_item(C, sl); cvt_item(it, scr, C.lane); }
        else { for (int u = 0; u < 4; ++u) { const CvtItem it = small_item(C, (sl - N_BIG) * 4 + u); cvt_item(it, scr, C.lane); } }
    }
    { const int nth = C.nwg * 512, gt = C.wg * 512 + C.tid; bf16* Z = C.Z();
#pragma unroll 2
      for (int i = gt; i < M * D / 16; i += nth) { const f32x4 a = *(const f32x4*)(C.x + (size_t)i * 16), b = *(const f32x4*)(C.x + (size_t)i * 16 + 4), c2 = *(const f32x4*)(C.x + (size_t)i * 16 + 8), d = *(const f32x4*)(C.x + (size_t)i * 16 + 12);
          u32x4 o, p; o.x = pk2(a[0], a[1]); o.y = pk2(a[2], a[3]); o.z = pk2(b[0], b[1]); o.w = pk2(b[2], b[3]); p.x = pk2(c2[0], c2[1]); p.y = pk2(c2[2], c2[3]); p.z = pk2(d[0], d[1]); p.w = pk2(d[2], d[3]);
          *(u32x4*)(Z + (size_t)i * 16) = o; *(u32x4*)(Z + (size_t)i * 16 + 8) = p; } }
    { const int gt = C.wg * 512 + C.tid;
      if (gt < 256) { float* T = (float*)(C.ws + WS_ROPE); const int j = gt & 7, a = gt >> 3;
          const double wr = ROPE_W[2 * j], wi = ROPE_W[2 * j + 1];
          double pr = wr, pi = wi;
          for (int q = 0; q < 6; ++q) { const double t = pr * pr - pi * pi; pi = 2.0 * pr * pi; pr = t; }
          double zr = 1.0, zi = 0.0;
          for (int bit = 0; bit < 5; ++bit) { if ((a >> bit) & 1) { const double t = zr * pr - zi * pi; zi = zr * pi + zi * pr; zr = t; } const double t2 = pr * pr - pi * pi; pi = 2.0 * pr * pi; pr = t2; }
          for (int b = 0; b < 64; ++b) { const int pos = 64 * a + b; T[pos * 8 + j] = (float)zr; T[S * 8 + pos * 8 + j] = (float)zi; const double t = zr * wr - zi * wi; zi = zr * wi + zi * wr; zr = t; } } }
}

__device__ __forceinline__ f32x4 thin64(const Ctx& C, const bf16* Zr, int r0blk, const bf16* WT) {
    const int lane = C.lane, w = C.wave, kh = w >> 2;
    const bf16* ap = Zr + (size_t)(r0blk + 16 * (w & 3) + (lane & 15)) * D + 512 * kh + 8 * (lane >> 4); const bf16* bp = WT + (size_t)(lane & 15) * D + 512 * kh + 8 * (lane >> 4);
    bf16x8 a[16], b[16];
#pragma unroll
    for (int k = 0; k < 16; ++k) { a[k] = *(const bf16x8*)(ap + 32 * k); b[k] = *(const bf16x8*)(bp + 32 * k); }
    f32x4 acc = (f32x4){0.f, 0.f, 0.f, 0.f};
#pragma unroll
    for (int k = 0; k < 16; ++k) acc = mfma16(a[k], b[k], acc);
    LAS f32x4* X = (LAS f32x4*)(C.lds + 12288);
    __syncthreads();
    if (kh) X[(w & 3) * 64 + lane] = acc;
    __syncthreads();
    if (!kh) acc += X[w * 64 + lane];
    return acc;
}
namespace pg8 {
constexpr int BM = 256, BK = 64, HALF = 128, HTB = HALF * BK * 2, STAGE_BYTES = 8 * HTB;
__device__ __forceinline__ int lds_byte(int r, int c) { const int st = (r >> 4) * 2 + (c >> 5), rr = r & 15, cc = c & 31, ob = rr * 64 + cc * 2; return st * 1024 + (ob ^ (((ob >> 9) & 1) << 5)); }
__device__ __forceinline__ void stage_rc(int b, int& R, int& C) { const int st = b / 1024, sb = b % 1024, swz = sb ^ (((sb >> 9) & 1) << 5); R = (st >> 1) * 16 + swz / 64; C = (st & 1) * 32 + (swz % 64) / 2; }
__device__ __forceinline__ int perm32(int rho) { const int n = rho >> 4, i = rho & 15; return 8 * (i >> 2) + 4 * n + (i & 3); }
struct Unit { int pm, pn, cls, base, cnt, e1, e2; };
typedef f32x4 Acc[2][2][4][2];
constexpr int LDS_TAB = 131072 + 1024;
constexpr int LDS_CLS = 131072 + 512;

template <class Prob, class Epi>
__device__ __forceinline__ void gemm_phase(const Ctx& C, const Prob& P, const Epi& E) {
    LAS unsigned char* lds = C.lds;
    const int tid = C.tid, wid = C.wave, lane = C.lane, wr = wid >> 2, wc = wid & 3, fr = lane & 15, fq = lane >> 4;
    constexpr int nt = Prob::K / BK, LDBE = Prob::LDB;
    unsigned voffA[2], voffB[2];
#pragma unroll
    for (int i = 0; i < 2; ++i) { int R_, C_; stage_rc(tid * 16 + i * 8192, R_, C_); const int Rb = (R_ & ~31) + perm32(R_ & 31); voffA[i] = (unsigned)(R_ * Prob::LDA + C_) * 2u; voffB[i] = (unsigned)(Rb * LDBE + C_) * 2u; }
    constexpr size_t hstepB = (size_t)HALF * LDBE * 2;
    const unsigned ldsw = (unsigned)wid * 1024u;
    const int aoff = lds_byte(wr * 64 + fr, fq * 8), boff = lds_byte(wc * 32 + fr, fq * 8);
#define PG8_SA(b, h) (((b) * 2 + (h)) * HTB)
#define PG8_SB(b, h) ((4 + (b) * 2 + (h)) * HTB)
#define PG8_STAGE_B(bufoff, gbase) do { _Pragma("unroll") for (int _i = 0; _i < 2; ++_i) { unsigned _v = voffB[_i]; const char* _b = (const char*)(gbase); asm volatile("" : "+v"(_v), "+s"(_b));     \
        __builtin_amdgcn_global_load_lds((const unsigned*)(_b + _v), (LAS unsigned*)(lds + (bufoff) + ldsw + _i * 8192), 16, 0, 0); } } while (0)
#define PG8_STAGE_A(bufoff, un, vo, h, tt) do { _Pragma("unroll") for (int _i = 0; _i < 2; ++_i) { unsigned _v = Prob::GATHER ? (vo)[h][_i] : voffA[_i]; const char* _b = P.a_tile(un, h) + (size_t)(tt) * (BK * 2); asm volatile("" : "+v"(_v), "+s"(_b)); \
        __builtin_amdgcn_global_load_lds((const unsigned*)(_b + _v), (LAS unsigned*)(lds + (bufoff) + ldsw + _i * 8192), 16, 0, 0); } } while (0)
#define PG8_LDA(dst, b, h) do { _Pragma("unroll") for (int m = 0; m < 4; ++m) _Pragma("unroll") for (int k = 0; k < 2; ++k) dst[m][k] = *(const LAS bf16x8*)(lds + PG8_SA(b, h) + aoff + m * 2048 + k * 1024); } while (0)
#define PG8_LDB(dst, b, h) do { _Pragma("unroll") for (int n = 0; n < 2; ++n) _Pragma("unroll") for (int k = 0; k < 2; ++k) dst[n][k] = *(const LAS bf16x8*)(lds + PG8_SB(b, h) + boff + n * 2048 + k * 1024); } while (0)
#define PG8_MMA(ai, bj, At, Bt) do { __builtin_amdgcn_s_setprio(1); _Pragma("unroll") for (int m = 0; m < 4; ++m) _Pragma("unroll") for (int n = 0; n < 2; ++n) _Pragma("unroll") for (int k = 0; k < 2; ++k) \
        acc[ai][bj][m][n] = __builtin_amdgcn_mfma_f32_16x16x32_bf16(Bt[n][k], At[m][k], acc[ai][bj][m][n], 0, 0, 0); __builtin_amdgcn_s_setprio(0); } while (0)
#define PG8_WAIT_V(n) asm volatile("s_waitcnt vmcnt(" #n ")" ::: "memory")
#define PG8_WAIT_L(n) asm volatile("s_waitcnt lgkmcnt(" #n ")" ::: "memory")
#define PG8_BAR __builtin_amdgcn_s_barrier()
#define PG8_SCHED __builtin_amdgcn_sched_barrier(0)
#define PG8_KSTEP(t, un2, vo2, t2, b2, b3) do { \
        PG8_LDB(B0, 0, 0); PG8_LDB(B1, 0, 1); PG8_SCHED; PG8_LDA(At, 0, 0); PG8_STAGE_A(PG8_SA(1, 1), cur, voC, 1, (t) + 1); \
        PG8_WAIT_V(8); PG8_WAIT_L(0); PG8_BAR; PG8_MMA(0, 0, At, B0); PG8_MMA(0, 1, At, B1); PG8_BAR; PG8_SCHED; \
        PG8_LDA(At, 0, 1); PG8_STAGE_B(PG8_SB(0, 0), b2); PG8_STAGE_B(PG8_SB(0, 1), (b2) + hstepB); PG8_STAGE_A(PG8_SA(0, 0), un2, vo2, 0, t2); \
        PG8_WAIT_V(8); PG8_WAIT_L(0); PG8_BAR; PG8_MMA(1, 0, At, B0); PG8_MMA(1, 1, At, B1); PG8_BAR; PG8_SCHED; \
        PG8_LDB(B0, 1, 0); PG8_LDB(B1, 1, 1); PG8_SCHED; PG8_LDA(At, 1, 0); PG8_STAGE_A(PG8_SA(0, 1), un2, vo2, 1, t2); \
        PG8_WAIT_V(8); PG8_WAIT_L(0); PG8_BAR; PG8_MMA(0, 0, At, B0); PG8_MMA(0, 1, At, B1); PG8_BAR; PG8_SCHED; \
        PG8_LDA(At, 1, 1); PG8_STAGE_B(PG8_SB(1, 0), b3); PG8_STAGE_B(PG8_SB(1, 1), (b3) + hstepB); PG8_STAGE_A(PG8_SA(1, 0), un2, vo2, 0, (t2) + 1); \
        PG8_WAIT_V(8); PG8_WAIT_L(0); PG8_BAR; PG8_MMA(1, 0, At, B0); PG8_MMA(1, 1, At, B1); PG8_BAR; PG8_SCHED; } while (0)
    Unit cur = {0, 0, 0, 0, 0, 0, 0}, nxt = {0, 0, 0, 0, 0, 0, 0}; int ui = 0;
    if (!P.next(0, cur)) return;
    Acc acc;
#define PG8_ZERO() do { _Pragma("unroll") for (int a = 0; a < 2; ++a) _Pragma("unroll") for (int b = 0; b < 2; ++b) _Pragma("unroll") for (int m = 0; m < 4; ++m) _Pragma("unroll") for (int n = 0; n < 2; ++n) acc[a][b][m][n] = (f32x4){0.f, 0.f, 0.f, 0.f}; } while (0)
    PG8_ZERO();
    bf16x8 At[4][2], B0[2][2], B1[2][2];
    unsigned voC[2][2], voN[2][2];
    if (Prob::GATHER) P.a_offsets(cur, tid, voC);
    {
        const char* pb0 = P.b_tile(cur, 0); const char* pb1 = P.b_tile(cur, 1);
        PG8_STAGE_B(PG8_SB(0, 0), pb0); PG8_STAGE_B(PG8_SB(0, 1), pb0 + hstepB); PG8_STAGE_A(PG8_SA(0, 0), cur, voC, 0, 0); PG8_STAGE_A(PG8_SA(0, 1), cur, voC, 1, 0);
        if (wr == 1) PG8_BAR;
        PG8_WAIT_V(2); PG8_BAR;
        PG8_STAGE_B(PG8_SB(1, 0), pb1); PG8_STAGE_A(PG8_SA(1, 0), cur, voC, 0, 1); PG8_STAGE_B(PG8_SB(1, 1), pb1 + hstepB);
        PG8_WAIT_V(6); PG8_BAR;
    }
    for (;;) {
        const bool has_next = P.next(ui + 1, nxt);
        if (has_next) { if (Prob::GATHER) P.a_offsets(nxt, tid, voN); }
        else { nxt = cur;
#pragma unroll
            for (int h = 0; h < 2; ++h)
#pragma unroll
                for (int i = 0; i < 2; ++i) voN[h][i] = voC[h][i]; }
#pragma unroll 1
        for (int t = 0; t < nt - 2; t += 2) { const char* b2 = P.b_tile(cur, t + 2); const char* b3 = P.b_tile(cur, t + 3); PG8_KSTEP(t, cur, voC, t + 2, b2, b3); }
        { const char* b2 = P.b_tile(nxt, 0); const char* b3 = P.b_tile(nxt, 1); PG8_KSTEP(nt - 2, nxt, voN, 0, b2, b3); }
        if (wr == 0) PG8_BAR;
        E(acc, cur, C, wr, wc, fr, fq);
        if (!has_next) break;
        PG8_ZERO();
        cur = nxt;
#pragma unroll
        for (int h = 0; h < 2; ++h)
#pragma unroll
            for (int i = 0; i < 2; ++i) voC[h][i] = voN[h][i];
        ++ui;
        if (wr == 1) PG8_BAR;
    }
    PG8_WAIT_V(0);
    PG8_BAR;
#undef PG8_SA
#undef PG8_SB
#undef PG8_STAGE_A
#undef PG8_STAGE_B
#undef PG8_LDA
#undef PG8_LDB
#undef PG8_MMA
#undef PG8_WAIT_V
#undef PG8_WAIT_L
#undef PG8_BAR
#undef PG8_SCHED
#undef PG8_KSTEP
#undef PG8_ZERO
}
__device__ __forceinline__ unsigned cvt_pk_bf16(float lo, float hi) { unsigned r; asm volatile("v_cvt_pk_bf16_f32 %0, %1, %2" : "=v"(r) : "v"(lo), "v"(hi)); return r; }
__device__ __forceinline__ void epi_bar() { asm volatile("s_waitcnt lgkmcnt(0)" ::: "memory"); __builtin_amdgcn_s_barrier(); asm volatile("" ::: "memory"); }

__device__ __forceinline__ bool static_next(int i, int G, int c, int nM, int nN, Unit& u) {
    const int nwg = nM * nN; const long L = (long)i * G + c; if (L >= nwg) return false;
    int wgid = (int)L; { const int q = nwg / 8, r = nwg % 8, xcd = wgid % 8, off = wgid / 8; wgid = (xcd < r ? xcd * (q + 1) : r * (q + 1) + (xcd - r) * q) + off; }
    const int nig = 8 * nN, gid = wgid / nig, fm = gid * 8, gsz = (nM - fm) < 8 ? (nM - fm) : 8;
    u.pm = fm + ((wgid % nig) % gsz); u.pn = (wgid % nig) / gsz; u.cls = 0; u.base = 0; u.cnt = 0; u.e1 = 0; u.e2 = 0; return true;
}
struct ProbPlain {
    static constexpr int K = 1024, LDA = 1024, LDB = 1024; static constexpr bool GATHER = false;
    const bf16* A; const bf16* Bt; int nM, nN, G, c;
    __device__ __forceinline__ bool next(int i, Unit& u) const { return static_next(i, G, c, nM, nN, u); }
    __device__ __forceinline__ const char* a_tile(const Unit& u, int h) const { return (const char*)A + (size_t)(u.pm * 256 + h * 128) * (1024 * 2); }
    __device__ __forceinline__ void a_offsets(const Unit&, int, unsigned (&)[2][2]) const {}
    __device__ __forceinline__ const char* b_tile(const Unit& u, int t) const { return (const char*)Bt + (size_t)u.pn * (256 * 1024 * 2) + (size_t)t * (BK * 2); }
};
__device__ __forceinline__ bool cls_next(int i, int G, int c, int ntiles, const LAS int* cbase, const LAS int* ccnt, Unit& u) {
    const int nwg = ntiles * 4; const long L = (long)i * G + c; if (L >= nwg) return false;
    int wgid = (int)L; { const int q = nwg / 8, r = nwg % 8, xcd = wgid % 8, off = wgid / 8; wgid = (xcd < r ? xcd * (q + 1) : r * (q + 1) + (xcd - r) * q) + off; }
    u.pm = wgid >> 2; u.pn = wgid & 3;
    const int R0 = u.pm * 256; int cl = 0;
#pragma unroll 1
    for (int k = 1; k < NCLS; ++k) if (R0 >= cbase[k]) cl = k;
    cl = __builtin_amdgcn_readfirstlane(cl);
    u.cls = cl; u.base = __builtin_amdgcn_readfirstlane(cbase[cl]); u.cnt = __builtin_amdgcn_readfirstlane(ccnt[cl]); cls_experts(cl, u.e1, u.e2); return true;
}
struct ProbUp {
    static constexpr int K = 1024, LDA = 1024, LDB = 1024; static constexpr bool GATHER = true;
    const bf16* Z; const bf16* WGU; const int* list; const LAS int* cbase; const LAS int* ccnt; int ntiles, G, c;
    __device__ __forceinline__ bool next(int i, Unit& u) const { return cls_next(i, G, c, ntiles, cbase, ccnt, u); }
    __device__ __forceinline__ const char* a_tile(const Unit&, int) const { return (const char*)Z; }
    __device__ __forceinline__ void a_offsets(const Unit& u, int tid, unsigned (&vo)[2][2]) const {
#pragma unroll
        for (int i = 0; i < 2; ++i) { int R_, C_; stage_rc(tid * 16 + i * 8192, R_, C_);
#pragma unroll
            for (int h = 0; h < 2; ++h) { int li = u.pm * 256 + h * 128 + R_ - u.base; li = li < u.cnt ? li : u.cnt - 1; const int tok = list[u.cls * M + li]; vo[h][i] = (unsigned)(tok * 1024 + C_) * 2u; } } }
    __device__ __forceinline__ const char* b_tile(const Unit& u, int t) const { const int e = (u.pn >> 1) ? u.e2 : u.e1; return (const char*)WGU + (size_t)(e * 2 + (u.pn & 1)) * (256 * 1024 * 2) + (size_t)t * (BK * 2); }
};
struct ProbDown {
    static constexpr int K = 512, LDA = 512, LDB = 256; static constexpr bool GATHER = false;
    const bf16* ACT; const bf16* WD; const LAS int* cbase; const LAS int* ccnt; int ntiles, G, c;
    __device__ __forceinline__ bool next(int i, Unit& u) const { return cls_next(i, G, c, ntiles, cbase, ccnt, u); }
    __device__ __forceinline__ const char* a_tile(const Unit& u, int h) const { return (const char*)ACT + (size_t)(u.pm * 256 + h * 128) * (512 * 2); }
    __device__ __forceinline__ void a_offsets(const Unit&, int, unsigned (&)[2][2]) const {}
    __device__ __forceinline__ const char* b_tile(const Unit& u, int t) const { const int e = t < 4 ? u.e1 : u.e2; return (const char*)WD + ((size_t)e * 1024 + (size_t)u.pn * 256) * (256 * 2) + (size_t)(t & 3) * (BK * 2); }
};

__device__ __forceinline__ void unpack8(const u32x4 w, float (&f)[8]) {
    f[0] = __uint_as_float(w.x << 16); f[1] = __uint_as_float(w.x & 0xffff0000u); f[2] = __uint_as_float(w.y << 16); f[3] = __uint_as_float(w.y & 0xffff0000u);
    f[4] = __uint_as_float(w.z << 16); f[5] = __uint_as_float(w.z & 0xffff0000u); f[6] = __uint_as_float(w.w << 16); f[7] = __uint_as_float(w.w & 0xffff0000u); }
struct EpiProj {
    bool fox; const float* st; const float* cs; const float* cb; const float* rope; bf16* Q;
    __device__ __forceinline__ void operator()(Acc& acc, const Unit& u, const Ctx& C, int wr, int wc, int fr, int fq) const {
        const int row0 = u.pm * 256 + wr * 64 + fr, colt = u.pn * 256 + wc * 32 + 8 * fq;
        f32x4 csv[2][2], cbv[2][2];
#pragma unroll
        for (int bj = 0; bj < 2; ++bj)
#pragma unroll
            for (int n = 0; n < 2; ++n) { csv[bj][n] = *(const f32x4*)(cs + colt + 128 * bj + 4 * n); cbv[bj][n] = *(const f32x4*)(cb + colt + 128 * bj + 4 * n); }
        size_t doff; int ldc, dcol; float sc = 1.f;
        if (fox) { const int t = u.pn >> 2; doff = (size_t)t * ((WS_K - WS_Q) / 2); ldc = 1024; dcol = (u.pn & 3) * 256; if (t == 0) sc = C2; }
        else { if (u.pn < 4) { doff = 0; ldc = 1024; dcol = u.pn * 256; sc = C2; } else { doff = (u.pn == 4) ? (WS_K - WS_Q) / 2 : (WS_V - WS_Q) / 2; ldc = 256; dcol = 0; } }
        bf16* dst = Q + doff + dcol + wc * 32 + 8 * fq;
        const bool rope_on = !fox && u.pn < 5 && !(wc & 1);
        const float sgn = fq == 0 ? -1.f : 1.f;
#pragma unroll
        for (int ai = 0; ai < 2; ++ai)
#pragma unroll
            for (int m = 0; m < 4; ++m) {
                const int r = row0 + 128 * ai + 16 * m; const f32x2 ms = row_stats(st, r);
                f32x4 v[2][2];
#pragma unroll
                for (int bj = 0; bj < 2; ++bj)
#pragma unroll
                    for (int n = 0; n < 2; ++n) v[bj][n] = (acc[ai][bj][m][n] - ms.x * csv[bj][n]) * ms.y + cbv[bj][n];
                if (rope_on) {
                    const int pos = r & (S - 1); f32x4 co[2], si[2];
                    co[0] = *(const f32x4*)(rope + pos * 8); co[1] = *(const f32x4*)(rope + pos * 8 + 4); si[0] = *(const f32x4*)(rope + S * 8 + pos * 8); si[1] = *(const f32x4*)(rope + S * 8 + pos * 8 + 4);
#pragma unroll
                    for (int bj = 0; bj < 2; ++bj)
#pragma unroll
                        for (int n = 0; n < 2; ++n)
#pragma unroll
                            for (int e = 0; e < 4; ++e) { const float x = v[bj][n][e], o = __shfl_xor(x, 16); const float y = x * co[n][e] + sgn * o * si[n][e]; v[bj][n][e] = fq < 2 ? y : x; }
                }
#pragma unroll
                for (int bj = 0; bj < 2; ++bj) { const f32x4 a = v[bj][0] * sc, b = v[bj][1] * sc; u32x4 w; w.x = cvt_pk_bf16(a[0], a[1]); w.y = cvt_pk_bf16(a[2], a[3]); w.z = cvt_pk_bf16(b[0], b[1]); w.w = cvt_pk_bf16(b[2], b[3]);
                    *(u32x4*)(dst + (size_t)r * ldc + 128 * bj) = w; }
            }
    }
};
struct EpiOut {
    const float* stp; const float* gp; const float* bp; bf16* Z; float* sto;
    __device__ __forceinline__ void operator()(Acc& acc, const Unit& u, const Ctx& C, int wr, int wc, int fr, int fq) const {
        const int colt = u.pn * 256 + wc * 32 + 8 * fq;
        f32x4 gv[2][2], bv[2][2];
#pragma unroll
        for (int bj = 0; bj < 2; ++bj)
#pragma unroll
            for (int n = 0; n < 2; ++n) { gv[bj][n] = gp ? *(const f32x4*)(gp + colt + 128 * bj + 4 * n) : (f32x4){1.f, 1.f, 1.f, 1.f}; bv[bj][n] = gp ? *(const f32x4*)(bp + colt + 128 * bj + 4 * n) : (f32x4){0.f, 0.f, 0.f, 0.f}; }
        LAS f32x2* T = (LAS f32x2*)(C.lds + LDS_TAB);
#pragma unroll
        for (int ai = 0; ai < 2; ++ai)
#pragma unroll
            for (int m = 0; m < 4; ++m) {
                const int rl = 128 * ai + 64 * wr + 16 * m + fr, r = u.pm * 256 + rl; const f32x2 ms = row_stats(stp, r);
                float s = 0.f, q = 0.f;
#pragma unroll
                for (int bj = 0; bj < 2; ++bj) {
                    bf16* p = Z + (size_t)r * D + colt + 128 * bj; float zi[8]; unpack8(*(const u32x4*)p, zi); float zo[8];
#pragma unroll
                    for (int n = 0; n < 2; ++n)
#pragma unroll
                        for (int e = 0; e < 4; ++e) { const float xin = gp ? (zi[4 * n + e] - ms.x) * ms.y * gv[bj][n][e] + bv[bj][n][e] : zi[4 * n + e]; zo[4 * n + e] = ALPHA * xin + acc[ai][bj][m][n][e]; }
                    u32x4 w; w.x = cvt_pk_bf16(zo[0], zo[1]); w.y = cvt_pk_bf16(zo[2], zo[3]); w.z = cvt_pk_bf16(zo[4], zo[5]); w.w = cvt_pk_bf16(zo[6], zo[7]);
                    *(u32x4*)p = w; float zr[8]; unpack8(w, zr);
#pragma unroll
                    for (int e = 0; e < 8; ++e) { s += zr[e]; q += zr[e] * zr[e]; }
                }
                s += __shfl_xor(s, 16); s += __shfl_xor(s, 32); q += __shfl_xor(q, 16); q += __shfl_xor(q, 32);
                if (fq == 0) T[rl * 4 + wc] = (f32x2){s, q};
                asm volatile("" ::: "memory");
            }
        epi_bar();
        if (C.tid < 256) { const f32x2 a = T[C.tid * 4 + 0], b = T[C.tid * 4 + 1], c = T[C.tid * 4 + 2], d = T[C.tid * 4 + 3];
            *(f32x2*)(sto + (size_t)(u.pm * 256 + C.tid) * 8 + u.pn * 2) = (f32x2){(a.x + b.x) + (c.x + d.x), (a.y + b.y) + (c.y + d.y)}; }
    }
};
struct EpiUp {
    const float* st; const int* list; const f32x2* gates; const float* gcs; const float* gcb; bf16* ACT;
    __device__ __forceinline__ void operator()(Acc& acc, const Unit& u, const Ctx& C, int wr, int wc, int fr, int fq) const {
        const int which = u.pn >> 1, half = u.pn & 1, e = which ? u.e2 : u.e1;
        const float* pcs = gcs + e * 512 + half * 256 + wc * 32 + 8 * fq; const float* pcb = gcb + e * 512 + half * 256 + wc * 32 + 8 * fq;
        f32x4 csg[2], csu[2], cbg[2], cbu[2];
#pragma unroll
        for (int n = 0; n < 2; ++n) { csg[n] = *(const f32x4*)(pcs + 4 * n); csu[n] = *(const f32x4*)(pcs + 128 + 4 * n); cbg[n] = *(const f32x4*)(pcb + 4 * n); cbu[n] = *(const f32x4*)(pcb + 128 + 4 * n); }
        bf16* dst = ACT + which * 256 + half * 128 + wc * 32 + 8 * fq;
#pragma unroll
        for (int ai = 0; ai < 2; ++ai)
#pragma unroll
            for (int m = 0; m < 4; ++m) {
                const int rl = 128 * ai + 64 * wr + 16 * m + fr, R = u.pm * 256 + rl, li = R - u.base; const bool valid = li < u.cnt;
                const int tok = list[u.cls * M + (valid ? li : 0)]; const f32x2 ms = row_stats(st, tok); const f32x2 gt = gates[tok];
                const float gate = valid ? (which ? gt.y : gt.x) : 0.f;
                float a[8];
#pragma unroll
                for (int n = 0; n < 2; ++n)
#pragma unroll
                    for (int k = 0; k < 4; ++k) { const float hg = ms.y * (acc[ai][0][m][n][k] - ms.x * csg[n][k]) + cbg[n][k], hu = ms.y * (acc[ai][1][m][n][k] - ms.x * csu[n][k]) + cbu[n][k];
                        a[4 * n + k] = hg * __builtin_amdgcn_rcpf(1.f + __expf(-hg)) * hu * gate; }
                u32x4 w; w.x = cvt_pk_bf16(a[0], a[1]); w.y = cvt_pk_bf16(a[2], a[3]); w.z = cvt_pk_bf16(a[4], a[5]); w.w = cvt_pk_bf16(a[6], a[7]);
                *(u32x4*)(dst + (size_t)R * 512) = w;
            }
    }
};
struct EpiDown {
    const float* st1; const float* g1; const float* b1; const int* list; bf16* Z; float* sto;
    __device__ __forceinline__ void operator()(Acc& acc, const Unit& u, const Ctx& C, int wr, int wc, int fr, int fq) const {
        const int colt = u.pn * 256 + wc * 32 + 8 * fq;
        f32x4 gv[2][2], bv[2][2];
#pragma unroll
        for (int bj = 0; bj < 2; ++bj)
#pragma unroll
            for (int n = 0; n < 2; ++n) { gv[bj][n] = *(const f32x4*)(g1 + colt + 128 * bj + 4 * n); bv[bj][n] = *(const f32x4*)(b1 + colt + 128 * bj + 4 * n); }
        LAS f32x2* T = (LAS f32x2*)(C.lds + LDS_TAB);
#pragma unroll
        for (int ai = 0; ai < 2; ++ai)
#pragma unroll
            for (int m = 0; m < 4; ++m) {
                const int rl = 128 * ai + 64 * wr + 16 * m + fr, li = u.pm * 256 + rl - u.base; const bool valid = li < u.cnt;
                const int tok = list[u.cls * M + (valid ? li : 0)]; const f32x2 ms = row_stats(st1, tok);
                float s = 0.f, q = 0.f;
#pragma unroll
                for (int bj = 0; bj < 2; ++bj) {
                    bf16* p = Z + (size_t)tok * D + colt + 128 * bj; float zi[8]; unpack8(*(const u32x4*)p, zi); float zo[8];
#pragma unroll
                    for (int n = 0; n < 2; ++n)
#pragma unroll
                        for (int e = 0; e < 4; ++e) { const float x1 = (zi[4 * n + e] - ms.x) * ms.y * gv[bj][n][e] + bv[bj][n][e]; zo[4 * n + e] = ALPHA * x1 + acc[ai][bj][m][n][e]; }
                    u32x4 w; w.x = cvt_pk_bf16(zo[0], zo[1]); w.y = cvt_pk_bf16(zo[2], zo[3]); w.z = cvt_pk_bf16(zo[4], zo[5]); w.w = cvt_pk_bf16(zo[6], zo[7]);
                    if (valid) *(u32x4*)p = w;
                    float zr[8]; unpack8(w, zr);
#pragma unroll
                    for (int e = 0; e < 8; ++e) { s += zr[e]; q += zr[e] * zr[e]; }
                }
                s += __shfl_xor(s, 16); s += __shfl_xor(s, 32); q += __shfl_xor(q, 16); q += __shfl_xor(q, 32);
                if (fq == 0) T[rl * 4 + wc] = (f32x2){s, q};
                asm volatile("" ::: "memory");
            }
        epi_bar();
        if (C.tid < 256) { const int li = u.pm * 256 + C.tid - u.base;
            if (li < u.cnt) { const int tok = list[u.cls * M + li]; const f32x2 a = T[C.tid * 4 + 0], b = T[C.tid * 4 + 1], c = T[C.tid * 4 + 2], d = T[C.tid * 4 + 3];
                *(f32x2*)(sto + (size_t)tok * 8 + u.pn * 2) = (f32x2){(a.x + b.x) + (c.x + d.x), (a.y + b.y) + (c.y + d.y)}; } }
    }
};
}

#ifndef USE8_PROJ
#define USE8_PROJ 1
#endif
#ifndef USE8_OPROJ
#define USE8_OPROJ 1
#endif
#ifndef USE8_UP
#define USE8_UP 1
#endif
#ifndef USE8_DOWN
#define USE8_DOWN 1
#endif
namespace fox {
using bf16=unsigned short;
using s16x4=__attribute__((ext_vector_type(4)))short;
using f32x16=__attribute__((ext_vector_type(16)))float;
constexpr int BATCH=8,NHEAD=16,SEQ=2048,D=64,DM=NHEAD*D;
constexpr int NW=8,QBLK=32,QB=QBLK*NW,KVBLK=64,NQB=SEQ/QB;
constexpr int ATTN_PITCH=DM, ATTN_UNIT_ROWS=QB;
__device__ __forceinline__ int crow(int r,int hi){return (r&3)+8*(r>>2)+4*hi;}
#define SBAR() __builtin_amdgcn_sched_barrier(0)
__device__ __forceinline__ void cmask(f32x16&p0,f32x16&p1,int jb,int qrel,int hi){
  const float NEG=-INFINITY; int kb=64*jb+4*hi;
  #pragma unroll
  for(int r=0;r<16;++r){int kv=kb+(r&3)+8*(r>>2); if(kv>qrel)p0[r]=NEG; if(kv+32>qrel)p1[r]=NEG;}
}

__device__ __forceinline__ void wmask(f32x16&p0,f32x16&p1,int dq){
  const float NEG=-INFINITY;
  #pragma unroll
  for(int r=0;r<16;++r){const int d=dq-((r&3)+8*(r>>2)); if((unsigned)d>=128u)p0[r]=NEG; if((unsigned)(d-32)>=128u)p1[r]=NEG;}
}
constexpr int NSLOT=3, SLOTB=8192;
constexpr int LDS_K=0, LDS_V=NSLOT*SLOTB, LDS_WS=2*NSLOT*SLOTB, LDS_OST=LDS_WS+NW*64*4, LDS_C=LDS_OST+NW*4096, LDS_BYTES=LDS_C+SEQ*4;
__device__ __forceinline__ void glds16(const void*gsrc,unsigned lds_dst){unsigned keep;
  asm volatile("s_mov_b32 %0, m0\n\ts_mov_b32 m0, %2\n\ts_nop 0\n\tglobal_load_lds_dwordx4 %1, off\n\ts_mov_b32 m0, %0":"=&s"(keep):"v"(gsrc),"s"(lds_dst):"memory");}
__device__ __forceinline__ float max3f(float a,float b,float c){float r;asm("v_max3_f32 %0, %1, %2, %3":"=v"(r):"v"(a),"v"(b),"v"(c));return r;}
__device__ __forceinline__ float max2f(float a,float b){float r;asm("v_max_f32_e32 %0, %1, %2":"=v"(r):"v"(a),"v"(b));return r;}
__device__ __forceinline__ float fadd_s(float a,float b){float r;asm("v_add_f32_e32 %0, %1, %2":"=v"(r):"v"(a),"v"(b));return r;}
__device__ __forceinline__ float fsub_s(float a,float b){float r;asm("v_sub_f32_e32 %0, %1, %2":"=v"(r):"v"(a),"v"(b));return r;}
typedef float f32x2_t __attribute__((ext_vector_type(2))); typedef float f32x4_t __attribute__((ext_vector_type(4))); typedef __bf16 bf16x2_t __attribute__((ext_vector_type(2)));
__device__ __forceinline__ unsigned cvtpk_s(float lo,float hi){f32x2_t v={lo,hi};bf16x2_t b=__builtin_convertvector(v,bf16x2_t);return __builtin_bit_cast(unsigned,b);}
#define WAIT_BAR(N) asm volatile("s_waitcnt vmcnt(" #N ") lgkmcnt(0)\n\ts_barrier":::"memory")

__device__ __forceinline__ void qkt(f32x16&p0,f32x16&p1,const char*Kslot,const bf16x8*qr,int r32,int hi){
  const char*kb=Kslot+hi*1024+r32*16;
  #pragma unroll
  for(int d0=0;d0<4;++d0){
    const bf16x8 b0=*reinterpret_cast<const bf16x8*>(kb+d0*2048);
    const bf16x8 b1=*reinterpret_cast<const bf16x8*>(kb+d0*2048+512);
    p0=__builtin_amdgcn_mfma_f32_32x32x16_bf16(b0,qr[d0],p0,0,0,0);p1=__builtin_amdgcn_mfma_f32_32x32x16_bf16(b1,qr[d0],p1,0,0,0);}
}
typedef __attribute__((address_space(3))) const char* lds_cptr;
typedef short v4i16_t __attribute__((ext_vector_type(4)));
__device__ __forceinline__ void kload8(bf16x8*kf,lds_cptr kp){
  kf[0]=*(const __attribute__((address_space(3))) bf16x8*)(kp);      kf[1]=*(const __attribute__((address_space(3))) bf16x8*)(kp+512);
  kf[2]=*(const __attribute__((address_space(3))) bf16x8*)(kp+2048); kf[3]=*(const __attribute__((address_space(3))) bf16x8*)(kp+2560);
  kf[4]=*(const __attribute__((address_space(3))) bf16x8*)(kp+4096); kf[5]=*(const __attribute__((address_space(3))) bf16x8*)(kp+4608);
  kf[6]=*(const __attribute__((address_space(3))) bf16x8*)(kp+6144); kf[7]=*(const __attribute__((address_space(3))) bf16x8*)(kp+6656);
}
__device__ __forceinline__ void kload2(bf16x8*kf,lds_cptr kp,int j){ kf[2*j]=*(const __attribute__((address_space(3))) bf16x8*)(kp+j*2048); kf[2*j+1]=*(const __attribute__((address_space(3))) bf16x8*)(kp+j*2048+512); }
__device__ __forceinline__ s16x4 vtr(lds_cptr p){ return __builtin_bit_cast(s16x4,__builtin_amdgcn_ds_read_tr16_b64_v4i16((__attribute__((address_space(3))) v4i16_t*)p)); }
__device__ __forceinline__ float rowmax(const f32x16&p0,const f32x16&p1){
  float a=max3f(p0[0],p0[1],p1[0]),b=max3f(p0[2],p0[3],p1[1]);a=max3f(a,p1[2],p1[3]);
  #pragma unroll
  for(int r=4;r<16;r+=4){a=max3f(a,p0[r],p0[r+1]);b=max3f(b,p0[r+2],p0[r+3]);a=max3f(a,p1[r],p1[r+1]);b=max3f(b,p1[r+2],p1[r+3]);}
  const float m=max2f(a,b);
  auto rr=__builtin_amdgcn_permlane32_swap(__float_as_uint(m),__float_as_uint(m),false,false);
  return max2f(__uint_as_float(rr[0]),__uint_as_float(rr[1]));
}
__device__ __forceinline__ void pv(f32x16*o,int vb,bf16x8 pa0,bf16x8 pa1,bf16x8 pa2,bf16x8 pa3){
  #pragma unroll
  for(int d0=0;d0<2;++d0){s16x4 lo[4],hi[4];
    #pragma unroll
    for(int ks=0;ks<4;++ks){
      asm volatile("ds_read_b64_tr_b16 %0,%1 offset:%c2":"=&v"(lo[ks]):"v"(vb),"i"(d0*4096+ks*1024):"memory");
      asm volatile("ds_read_b64_tr_b16 %0,%1 offset:%c2":"=&v"(hi[ks]):"v"(vb),"i"(d0*4096+ks*1024+512):"memory");}
    asm volatile("s_waitcnt lgkmcnt(0)":::"memory");SBAR();
    #define PK(k) (bf16x8){lo[k][0],lo[k][1],lo[k][2],lo[k][3],hi[k][0],hi[k][1],hi[k][2],hi[k][3]}
    o[d0]=__builtin_amdgcn_mfma_f32_32x32x16_bf16(pa0,PK(0),o[d0],0,0,0);
    o[d0]=__builtin_amdgcn_mfma_f32_32x32x16_bf16(pa1,PK(1),o[d0],0,0,0);
    o[d0]=__builtin_amdgcn_mfma_f32_32x32x16_bf16(pa2,PK(2),o[d0],0,0,0);
    o[d0]=__builtin_amdgcn_mfma_f32_32x32x16_bf16(pa3,PK(3),o[d0],0,0,0);
    #undef PK
  }
}

#ifndef ATTN_STORE16
#define ATTN_STORE16(p,v) (*(u32x4*)(p)=(v))
#endif
template<int THRL,bool SWA> __device__ __forceinline__ void attn_unit(int tid,int b,int h,int qb,const bf16*Q,const bf16*__restrict__ K,const bf16*__restrict__ V,bf16*O,float sink2,char*shm){
  constexpr int DMK=SWA?256:DM;
  const int lane=tid&63,r32=lane&31,hi=lane>>5; const int wid=__builtin_amdgcn_readfirstlane(tid>>6);
  const long rowbase=(long)b*SEQ; const int q0=qb*QB;
  const bf16*Qw=Q+(rowbase+q0+wid*QBLK)*DM+h*D;
  const int TL=SWA?(qb?4*qb-2:0):0;
  const bf16*Kh=K+(rowbase+TL*KVBLK)*DMK+(SWA?(h>>2):h)*D,*Vh=V+(rowbase+TL*KVBLK)*DMK+(SWA?(h>>2):h)*D;
  const unsigned lds0=(unsigned)(uintptr_t)shm;
  float*wsf=(float*)(shm+LDS_WS)+wid*64;
  const bf16*ksrc=Kh+(long)lane*DMK+wid*8;
  const bf16*vsrc=Vh+(long)(16*(wid&3)+(lane>>2))*DMK+(wid>>2)*32+(lane&3)*8;
  const unsigned kdst=lds0+LDS_K+wid*1024, vdst=lds0+LDS_V+wid*1024;
  #define DMA_K(t,slot) glds16(ksrc+(long)(t)*KVBLK*DMK,(unsigned)__builtin_amdgcn_readfirstlane(kdst+(slot)))
  #define DMA_V(t,slot) glds16(vsrc+(long)(t)*KVBLK*DMK,(unsigned)__builtin_amdgcn_readfirstlane(vdst+(slot)))
  const int vb0=(int)(lds0+LDS_V)+((lane>>4)&1)*32+(lane&3)*8+(4*hi+((lane&15)>>2))*64;
  const char*Kbase=shm+LDS_K; bf16x8 kf[8];
  const lds_cptr shm3=(lds_cptr)shm; const lds_cptr kp0=shm3+LDS_K+hi*1024+r32*16; const lds_cptr vp0=shm3+LDS_V+((lane>>4)&1)*32+(lane&3)*8+(4*hi+((lane&15)>>2))*64;
  const int NT=(q0+QB)/KVBLK-TL;
  DMA_K(0,0);DMA_V(0,0);DMA_K(1,SLOTB);
  const lds_cptr cpl=(lds_cptr)shm+LDS_C+hi*16;
  bf16x8 qr[4];
  #pragma unroll
  for(int d0=0;d0<4;++d0)qr[d0]=*reinterpret_cast<const bf16x8*>(&Qw[(long)r32*DM+d0*16+hi*8]);
  float l_reg=(SWA&&hi==0)?1.f:0.f;f32x16 o[2];o[0]=f32x16{};o[1]=f32x16{};float bm=0.f;
  const int qrel=wid*QBLK+r32;
  #define CMASK(P0,P1,t) do{ if(SWA){ wmask(P0,P1,q0+qrel-(TL+(t))*KVBLK-4*hi); } else { int jb_=(t)-(NT-4); if(jb_>=0)cmask(P0,P1,jb_,qrel,hi); } }while(0)
  bool resc=false;
  #define START(P0,P1) do{ const float rm=rowmax(P0,P1); resc=false; \
    { const float dl=SWA?((__any(rm>(float)THRL))?__builtin_fmaxf(rm,0.f):0.f):rm; \
      _Pragma("unroll") for(int r=0;r<16;++r){P0[r]=fsub_s(P0[r],dl);P1[r]=fsub_s(P1[r],dl);} \
      bm=fsub_s(bm,dl); if(SWA)l_reg*=__builtin_amdgcn_exp2f(-dl); } \
    _Pragma("unroll") for(int r=0;r<16;++r)P0[r]=__builtin_amdgcn_exp2f(P0[r]); }while(0)
  #define RESC() do{ if(resc){ asm volatile("s_waitcnt lgkmcnt(0)":::"memory"); \
      _Pragma("unroll") for(int d_=0;d_<2;++d_) _Pragma("unroll") for(int r=0;r<16;++r)o[d_][r]*=wsf[crow(r,hi)]; } }while(0)
  typedef __attribute__((address_space(3))) const f32x4_t* lds_f4p;
  #define CPRE(X0,X1,tt) do{ if(!SWA){ const lds_cptr cp_=cpl+(tt)*256; _Pragma("unroll") for(int g_=0;g_<4;++g_){ const f32x4_t a_=*(lds_f4p)(cp_+32*g_), b_=*(lds_f4p)(cp_+128+32*g_); \
      X0[4*g_]=a_[0];X0[4*g_+1]=a_[1];X0[4*g_+2]=a_[2];X0[4*g_+3]=a_[3]; X1[4*g_]=b_[0];X1[4*g_+1]=b_[1];X1[4*g_+2]=b_[2];X1[4*g_+3]=b_[3]; } } }while(0)
  #define CFIN(X0,X1) do{ _Pragma("unroll") for(int r=0;r<16;++r){ if(SWA){X0[r]=bm;X1[r]=bm;} else {X0[r]=bm-X0[r];X1[r]=bm-X1[r];} } }while(0)
  f32x16 pA0,pA1,pB0,pB1;
  int sl_prev=0,sl_cur=0,sl_next=SLOTB;
  #define ROT() do{sl_prev=sl_cur;sl_cur=sl_next;sl_next=(sl_next==(NSLOT-1)*SLOTB)?0:sl_next+SLOTB;}while(0)
  DMA_K(2,2*SLOTB);
  WAIT_BAR(3);
  bm=SWA?-sink2:*(const __attribute__((address_space(3))) float*)((lds_cptr)shm+LDS_C+(q0+qrel)*4);
  CPRE(pA0,pA1,0); CFIN(pA0,pA1);
  qkt(pA0,pA1,Kbase,qr,r32,hi);asm volatile("s_nop 15\n\ts_nop 7":"+v"(pA0),"+v"(pA1));CMASK(pA0,pA1,0);
  START(pA0,pA1);
  CPRE(pB0,pB1,1);
  _Pragma("unroll") for(int r=0;r<16;++r)pA1[r]=__builtin_amdgcn_exp2f(pA1[r]);
  WAIT_BAR(0);
  DMA_K(3,0);DMA_V(1,SLOTB);
  ROT();
  kload8(kf,kp0+sl_cur);
  WAIT_BAR(2);
  s16x4 vlo[8],vhi[8]; u32x4 pw0,pw1,pw2,pw3;
  #define PKW(P,B) cvtpk_s(P[B],P[B+1])
  #define PAF(k) __builtin_bit_cast(bf16x8,pw##k)
  #define VFR(i) (bf16x8){vlo[i][0],vlo[i][1],vlo[i][2],vlo[i][3],vhi[i][0],vhi[i][1],vhi[i][2],vhi[i][3]}
  #define PIN(x) asm volatile("":"+v"(x))
  #define MX3(a,b,c) __builtin_fmaxf(__builtin_fmaxf((a),(b)),(c))
  #define GAPA(MF,A0,A1,A2,A3,W0,W1,PW) do{ MF; sacc+=A0; sacc+=A1; sacc+=A2; sacc+=A3; PIN(sacc); W0; W1; PIN(PW); SBAR(); }while(0)
  #define EX(v) __builtin_amdgcn_exp2f(v)
  #define GAPB(MF,X,B) do{ MF; X[B]=EX(X[B]); X[B+1]=EX(X[B+1]); X[B+2]=EX(X[B+2]); X[B+3]=EX(X[B+3]); PIN(X); SBAR(); }while(0)
  #define VRD(i) do{ vlo[i]=vtr(vp_+(((i)>>2)*4096+((i)&3)*1024)); vhi[i]=vtr(vp_+(((i)>>2)*4096+((i)&3)*1024+512)); }while(0)
  #define KRD(G,j) do{ if(G){ kload2(kf,kp0+sl_next,j); SBAR(); } }while(0)
  #define STEP(C0,C1,P0,P1,t,GK,GV,GL) do{ SBAR(); \
    CFIN(C0,C1); SBAR(); \
    const lds_cptr vp_=vp0+sl_prev; \
    VRD(0); SBAR(); float sacc=(P0[0]+P0[1]); \
    GAPA(C0=__builtin_amdgcn_mfma_f32_32x32x16_bf16(kf[0],qr[0],C0,0,0,0), P0[2],P0[3],P0[4],P0[5],     pw0[0]=PKW(P0,0), pw0[1]=PKW(P0,2), pw0); \
    VRD(4); SBAR(); GAPA(C1=__builtin_amdgcn_mfma_f32_32x32x16_bf16(kf[1],qr[0],C1,0,0,0), P0[6],P0[7],P0[8],P0[9],     pw0[2]=PKW(P0,4), pw0[3]=PKW(P0,6), pw0); \
    VRD(1); SBAR(); GAPA(C0=__builtin_amdgcn_mfma_f32_32x32x16_bf16(kf[2],qr[1],C0,0,0,0),   P0[10],P0[11],P0[12],P0[13], pw1[0]=PKW(P0,8), pw1[1]=PKW(P0,10), pw1); \
    VRD(5); SBAR(); GAPA(C1=__builtin_amdgcn_mfma_f32_32x32x16_bf16(kf[3],qr[1],C1,0,0,0),   P0[14],P0[15],P1[0],P1[1],   pw1[2]=PKW(P0,12),pw1[3]=PKW(P0,14), pw1); \
    VRD(2); SBAR(); GAPA(C0=__builtin_amdgcn_mfma_f32_32x32x16_bf16(kf[4],qr[2],C0,0,0,0),   P1[2],P1[3],P1[4],P1[5],     pw2[0]=PKW(P1,0), pw2[1]=PKW(P1,2), pw2); \
    VRD(6); SBAR(); GAPA(C1=__builtin_amdgcn_mfma_f32_32x32x16_bf16(kf[5],qr[2],C1,0,0,0),   P1[6],P1[7],P1[8],P1[9],     pw2[2]=PKW(P1,4), pw2[3]=PKW(P1,6), pw2); \
    VRD(3); SBAR(); GAPA(C0=__builtin_amdgcn_mfma_f32_32x32x16_bf16(kf[6],qr[3],C0,0,0,0),   P1[10],P1[11],P1[12],P1[13], pw3[0]=PKW(P1,8), pw3[1]=PKW(P1,10), pw3); \
    VRD(7); SBAR(); GAPA(C1=__builtin_amdgcn_mfma_f32_32x32x16_bf16(kf[7],qr[3],C1,0,0,0),   P1[14],P1[15],0.f,0.f,       pw3[2]=PKW(P1,12),pw3[3]=PKW(P1,14), pw3); \
    l_reg+=sacc; \
    if(GK){DMA_K((t)+3,sl_cur);} if(GV){DMA_V((t)+1,sl_next);} \
    CMASK(C0,C1,t); \
    { float a=MX3(C0[0],C0[1],C1[0]),b=MX3(C0[2],C0[3],C1[1]); a=MX3(a,C1[2],C1[3]); \
      _Pragma("unroll") for(int r=4;r<16;r+=4){a=MX3(a,C0[r],C0[r+1]);b=MX3(b,C0[r+2],C0[r+3]);a=MX3(a,C1[r],C1[r+1]);b=MX3(b,C1[r+2],C1[r+3]);} \
      float rm=__builtin_fmaxf(a,b); { auto rr=__builtin_amdgcn_permlane32_swap(__float_as_uint(rm),__float_as_uint(rm),false,false); rm=__builtin_fmaxf(__uint_as_float(rr[0]),__uint_as_float(rr[1])); } \
      resc=false; \
      if(__builtin_expect(__any(rm>(float)THRL),0)){ const float dl=__builtin_fmaxf(rm,0.f); \
        _Pragma("unroll") for(int r=0;r<16;++r){C0[r]-=dl;C1[r]-=dl;} \
        bm-=dl; \
        const float f=__builtin_amdgcn_exp2f(-dl); l_reg*=f; if(hi==0)wsf[r32]=f; resc=true; } } \
    SBAR(); \
    GAPB(o[0]=__builtin_amdgcn_mfma_f32_32x32x16_bf16(PAF(0),VFR(0),o[0],0,0,0), C0,0); \
    GAPB(o[1]=__builtin_amdgcn_mfma_f32_32x32x16_bf16(PAF(0),VFR(4),o[1],0,0,0), C0,4); \
    KRD(GL,0); GAPB(o[0]=__builtin_amdgcn_mfma_f32_32x32x16_bf16(PAF(1),VFR(1),o[0],0,0,0), C0,8); \
    KRD(GL,1); GAPB(o[1]=__builtin_amdgcn_mfma_f32_32x32x16_bf16(PAF(1),VFR(5),o[1],0,0,0), C0,12); \
    KRD(GL,2); GAPB(o[0]=__builtin_amdgcn_mfma_f32_32x32x16_bf16(PAF(2),VFR(2),o[0],0,0,0), C1,0); \
    KRD(GL,3); GAPB(o[1]=__builtin_amdgcn_mfma_f32_32x32x16_bf16(PAF(2),VFR(6),o[1],0,0,0), C1,4); \
    GAPB(o[0]=__builtin_amdgcn_mfma_f32_32x32x16_bf16(PAF(3),VFR(3),o[0],0,0,0), C1,8); \
    GAPB(o[1]=__builtin_amdgcn_mfma_f32_32x32x16_bf16(PAF(3),VFR(7),o[1],0,0,0), C1,12); \
    if(GL){ CPRE(P0,P1,(t)+1); SBAR(); } \
    }while(0)
  int t=1;
  #undef CMASK
  #define CMASK(P0,P1,t) do{}while(0)
  for(;t+5<NT;t+=2){
    STEP(pB0,pB1,pA0,pA1,t,true,true,true);     WAIT_BAR(2); RESC(); ROT();
    STEP(pA0,pA1,pB0,pB1,t+1,true,true,true);   WAIT_BAR(2); RESC(); ROT();
  }
  #undef CMASK
  #define CMASK(P0,P1,t) do{ if(SWA){ wmask(P0,P1,q0+qrel-(TL+(t))*KVBLK-4*hi); } else { int jb_=(t)-(NT-4); if(jb_>=0)cmask(P0,P1,jb_,qrel,hi); } }while(0)
  #define ENDW(tt) do{ if((tt)+3<NT){WAIT_BAR(2);} else if((tt)+2<NT){WAIT_BAR(1);} else {WAIT_BAR(0);} }while(0)
  for(;t+1<NT;t+=2){
    STEP(pB0,pB1,pA0,pA1,t,(t+3<NT),(t+1<NT),(t+1<NT));       ENDW(t);   RESC(); ROT();
    STEP(pA0,pA1,pB0,pB1,t+1,(t+4<NT),(t+2<NT),(t+2<NT));     ENDW(t+1); RESC(); ROT();
  }
  STEP(pB0,pB1,pA0,pA1,NT-1,false,false,false); RESC();
  { float sacc=pB0[0]+pB0[1]; _Pragma("unroll") for(int r=2;r<16;++r)sacc+=pB0[r]; _Pragma("unroll") for(int r=0;r<16;++r)sacc+=pB1[r]; l_reg+=sacc;
    pw0=(u32x4){PKW(pB0,0),PKW(pB0,2),PKW(pB0,4),PKW(pB0,6)};pw1=(u32x4){PKW(pB0,8),PKW(pB0,10),PKW(pB0,12),PKW(pB0,14)};pw2=(u32x4){PKW(pB1,0),PKW(pB1,2),PKW(pB1,4),PKW(pB1,6)};pw3=(u32x4){PKW(pB1,8),PKW(pB1,10),PKW(pB1,12),PKW(pB1,14)};
    SBAR(); pv(o,vb0+sl_cur,PAF(0),PAF(1),PAF(2),PAF(3)); }
  #undef PKW
  #undef PAF
  #undef VFR
  #undef PIN
  #undef MX3
  #undef GAPA
  #undef GAPB
  #undef EX
  #undef VRD
  #undef KRD
  #undef STEP
  #undef ENDW
  {auto rr=__builtin_amdgcn_permlane32_swap(__float_as_uint(l_reg),__float_as_uint(l_reg),false,false);l_reg=__uint_as_float(rr[0])+__uint_as_float(rr[1]);}
  if(hi==0)wsf[32+r32]=l_reg;asm volatile("s_waitcnt lgkmcnt(0)":::"memory");
  float rli[16];
  #pragma unroll
  for(int r=0;r<16;++r)rli[r]=__builtin_amdgcn_rcpf(wsf[32+crow(r,hi)]);
  bf16*Ow=O+(rowbase+q0+wid*QBLK)*DM+h*D;
  { bf16*stg=(bf16*)(shm+LDS_OST)+wid*2048;
    #pragma unroll
    for(int r=0;r<16;++r){const int orow=crow(r,hi);
      #pragma unroll
      for(int d0=0;d0<2;++d0)stg[orow*64+d0*32+r32]=(bf16)f2bf(o[d0][r]*rli[r]);}
    asm volatile("s_waitcnt lgkmcnt(0)":::"memory");
    #pragma unroll
    for(int i=0;i<4;++i){const int row=i*8+(lane>>3),ch=lane&7; const u32x4 v=*(const u32x4*)(stg+row*64+ch*8); ATTN_STORE16(Ow+(long)row*DM+ch*8,v);} }
  asm volatile("s_waitcnt lgkmcnt(0)\n\ts_barrier":::"memory");
  #undef DMA_K
  #undef DMA_V
  #undef CMASK
  #undef START
  #undef RESC
  #undef ROT
  #undef CPRE
  #undef CFIN
}
constexpr int ATTN_LDS_BYTES=LDS_BYTES;
struct AttnTensors { const bf16* Q; const bf16* K; const bf16* V; bf16* O; };
struct AttnUnit { int bh; int qb; };
struct StaticOrder {
  int vcu;
  __device__ __forceinline__ explicit StaticOrder(int grid,int block):vcu((grid%8==0)?(block%8)*(grid/8)+block/8:block){}
  __device__ __forceinline__ bool next(int i,AttnUnit&u)const{ if(i>=4)return false; const int s=vcu&1; u.bh=vcu>>1; u.qb=(i==0)?7-s:(i==1)?s:(i==2)?4+s:3-s; return u.bh<BATCH*NHEAD; }
};
__device__ __forceinline__ void scan_to_lds(int tid,const float*__restrict__ LGrow,char*shm){
  const int lane=tid&63; const int wid=__builtin_amdgcn_readfirstlane(tid>>6);
  const f32x4_t v=*(const f32x4_t*)(LGrow+tid*4);
  const float p0=v[0],p1=p0+v[1],p2=p1+v[2],p3=p2+v[3]; float inc=p3;
  #pragma unroll
  for(int o=1;o<64;o<<=1){const float u=__shfl_up(inc,o); if(lane>=o)inc+=u;}
  __attribute__((address_space(3))) float*ws=(__attribute__((address_space(3))) float*)((lds_cptr)shm+LDS_WS);
  if(lane==63)ws[wid]=inc;
  asm volatile("s_waitcnt lgkmcnt(0)\n\ts_barrier":::"memory");
  float base=inc-p3;
  #pragma unroll
  for(int w=0;w<NW-1;++w){const float t=ws[w]; if(w<wid)base+=t;}
  const float L2E=1.4426950408889634f;
  *(__attribute__((address_space(3))) f32x4_t*)((lds_cptr)shm+LDS_C+tid*16)=(f32x4_t){(base+p0)*L2E,(base+p1)*L2E,(base+p2)*L2E,(base+p3)*L2E};
  asm volatile("s_waitcnt lgkmcnt(0)\n\ts_barrier":::"memory");
}
template<class Sched,bool SWA,int THRL=8> __device__ __forceinline__ void attn_phase(int tid,char*lds,const AttnTensors&T,const float*LG,const float*sinks,const Sched&S){
  AttnUnit u;
  if(!SWA){ if(S.next(0,u)) scan_to_lds(tid,LG+(size_t)u.bh*SEQ,lds); }
  for(int i=0;S.next(i,u);++i){ attn_unit<THRL,SWA>(tid,u.bh/NHEAD,u.bh%NHEAD,u.qb,T.Q,T.K,T.V,T.O,SWA?sinks[u.bh%NHEAD]*1.4426950408889634f:0.f,lds); }
}
#undef SBAR
#undef WAIT_BAR
}

__device__ __forceinline__ void p_attn_fox8(const Ctx& C) {
    const fox::AttnTensors AT{(const fox::bf16*)C.Q(), (const fox::bf16*)C.Kb(), (const fox::bf16*)C.Vb(), (fox::bf16*)C.Q()};
    const fox::StaticOrder S(C.nwg, C.wg);
    fox::attn_phase<fox::StaticOrder, false>(C.tid, C.ldsg, AT, (const float*)(C.ws + WS_LG), nullptr, S);
}
__device__ __forceinline__ void p_attn_swa8(const Ctx& C, int layer) {
    const fox::AttnTensors AT{(const fox::bf16*)C.Q(), (const fox::bf16*)C.Kb(), (const fox::bf16*)C.Vb(), (fox::bf16*)C.Q()};
    const fox::StaticOrder S(C.nwg, C.wg);
    fox::attn_phase<fox::StaticOrder, true>(C.tid, C.ldsg, AT, nullptr, C.swa_sinks + (layer >> 1) * 16, S);
}
__device__ __forceinline__ void p_router(const Ctx& C, int layer) {
    const float* st = C.stats(2 * layer); const bf16* Z = C.Z(); const bf16* WR = (const bf16*)(C.ws + WS_WR) + (size_t)layer * 16 * 1024;
    const float* cs = C.vec(V_RT_CS) + layer * 16; const float* cb = C.vec(V_RT_CB) + layer * 16;
    LAS float* lg = (LAS float*)(C.lds + C.wave * 1280);
    LAS int* hist = (LAS int*)(C.lds + 16384); LAS int* base = hist + 32;
    unsigned* gcnt = C.ctl() + CW_CNT + 32 * layer; int* cls_o = C.cls(); f32x2* gates = C.gates(); int* list = C.list();
    const int lane = C.lane, lr = lane & 15, lq = lane >> 4;
    for (int blk = C.wg; blk < M / 64; blk += C.nwg) {
        if (C.tid < 32) hist[C.tid] = 0;
        __syncthreads();
        int tok = -1, cl = 0, lslot = 0;
        const f32x4 acc = thin64(C, Z, blk * 64, WR);
        if (C.wave < 4) {
            const int r0 = blk * 64 + C.wave * 16;
            const float csv = cs[lr], cbv = cb[lr] + C.b_router[lr];
#pragma unroll
            for (int rg = 0; rg < 4; ++rg) { const int row = 4 * lq + rg; const f32x2 ms = row_stats(st, r0 + row); lg[row * 17 + lr] = ms.y * (acc[rg] - ms.x * csv) + cbv; }
            LDS_WAIT(); asm volatile("" ::: "memory");
            if (lane < 16) {
                float l[16], mx = -INFINITY;
#pragma unroll
                for (int e = 0; e < 16; ++e) { l[e] = lg[lane * 17 + e]; mx = fmaxf(mx, l[e]); }
#pragma unroll
                for (int e = 0; e < 16; ++e) l[e] = __builtin_amdgcn_exp2f((l[e] - mx) * LOG2E);
                float gs[4];
#pragma unroll
                for (int g = 0; g < 4; ++g) { const float a0 = l[4 * g], a1 = l[4 * g + 1], a2 = l[4 * g + 2], a3 = l[4 * g + 3];
                    gs[g] = fmaxf(fmaxf(fmaxf(a0 + a1, a0 + a2), fmaxf(a0 + a3, a1 + a2)), fmaxf(a1 + a3, a2 + a3)); }
                int best = 0; float bv = gs[0];
#pragma unroll
                for (int g = 1; g < 4; ++g) if (gs[g] > bv) { bv = gs[g]; best = g; }
                float a[4];
#pragma unroll
                for (int k = 0; k < 4; ++k) a[k] = best == 0 ? l[k] : (best == 1 ? l[4 + k] : (best == 2 ? l[8 + k] : l[12 + k]));
                int i1 = 0; float v1 = a[0];
#pragma unroll
                for (int k = 1; k < 4; ++k) if (a[k] > v1) { v1 = a[k]; i1 = k; }
                int i2 = -1; float v2 = -1.f;
#pragma unroll
                for (int k = 0; k < 4; ++k) if (k != i1 && a[k] > v2) { v2 = a[k]; i2 = k; }
                const int lo = i1 < i2 ? i1 : i2, hi = i1 < i2 ? i2 : i1;
                const int pidx = lo == 0 ? hi - 1 : (lo == 1 ? hi + 1 : 5);
                const float inv = 1.f / (v1 + v2), g1 = v1 * inv, g2 = v2 * inv;
                cl = best * 6 + pidx; tok = r0 + lane;
                cls_o[tok] = cl; gates[tok] = i1 < i2 ? (f32x2){g1, g2} : (f32x2){g2, g1};
                lslot = atomicAdd((int*)(hist + cl), 1);
            }
        }
        __syncthreads();
        if (C.tid < NCLS) base[C.tid] = (int)atomicAdd(gcnt + C.tid, (unsigned)hist[C.tid]);
        __syncthreads();
        if (tok >= 0) list[cl * M + base[cl] + lslot] = tok;
        __syncthreads();
    }
}
__device__ __forceinline__ int cls_layout(const Ctx& C, int layer, LAS int* cbase  , LAS int* ccnt  ) {
    if (C.tid == 0) { const unsigned* gcnt = C.ctl() + CW_CNT + 32 * layer; int acc = 0;
#pragma unroll 1
        for (int c = 0; c < NCLS; ++c) { const int n = (int)__hip_atomic_load(gcnt + c, RLX_AGENT); cbase[c] = acc; ccnt[c] = n; acc += (n + 255) & ~255; }
        cbase[NCLS] = acc; }
    __syncthreads();
    return cbase[NCLS];
}
__device__ __forceinline__ void p_proj8(const Ctx& C, int layer) {
    const int j = layer >> 1; const bool fox = layer & 1;
    const float* st = layer ? C.stats(2 * (layer - 1) + 1) : nullptr;
    const float* cs = C.vec(V_PROJ_CS) + layer * FOX_NALL; const float* cb = C.vec(V_PROJ_CB) + layer * FOX_NALL;
    const bf16* Z = C.Z();
    const bf16* W = fox ? (const bf16*)(C.ws + WS_WIN_FOX) + (size_t)j * FOX_N * 1024 : (const bf16*)(C.ws + WS_WIN_SWA) + (size_t)j * SWA_N * 1024;
    const int N = fox ? FOX_N : SWA_N;
    { pg8::ProbPlain P{Z, W, M / 256, N / 256, C.nwg, C.wg}; pg8::EpiProj E{fox, st, cs, cb, (const float*)(C.ws + WS_ROPE), C.Q()}; pg8::gemm_phase(C, P, E); }
    if (fox) {
        const bf16* WF = (const bf16*)(C.ws + WS_WF) + (size_t)j * 16 * 1024; float* LG = (float*)(C.ws + WS_LG);
        const int lr = C.lane & 15, lq = C.lane >> 4;
        for (int blk = C.wg; blk < M / 64; blk += C.nwg) {
            const f32x4 acc = thin64(C, Z, blk * 64, WF);
            if (C.wave < 4) {
                const int r0 = blk * 64 + C.wave * 16;
                const float bf_ = C.fox_b_f[j * 16 + lr], csv = cs[FOX_N + lr], cbv = cb[FOX_N + lr];
                f32x4 o;
#pragma unroll
                for (int rg = 0; rg < 4; ++rg) { const int r = r0 + 4 * lq + rg; const f32x2 ms = row_stats(st, r);
                    const float xg = ms.y * (acc[rg] - ms.x * csv) + cbv + bf_;
                    o[rg] = fminf(xg, 0.f) - 0.6931471805599453f * __builtin_amdgcn_logf(1.f + __builtin_amdgcn_exp2f(-fabsf(xg) * LOG2E)); }
                const int b = r0 / S, s = (r0 % S) + 4 * lq;
                *(f32x4*)(LG + (size_t)(b * 16 + lr) * S + s) = o;
            }
        }
    }
}
__device__ __forceinline__ void p_oproj8(const Ctx& C, int layer) {
    const float* stp = layer ? C.stats(2 * (layer - 1) + 1) : nullptr;
    const float* gp = layer ? C.ln_g + ((layer - 1) * 2 + 1) * 1024 : nullptr; const float* bp = layer ? C.ln_b + ((layer - 1) * 2 + 1) * 1024 : nullptr;
    pg8::ProbPlain P{C.Q(), (const bf16*)(C.ws + WS_WO) + (size_t)layer * 1024 * 1024, M / 256, D / 256, C.nwg, C.wg};
    pg8::EpiOut E{stp, gp, bp, C.Z(), C.stats(2 * layer)};
    pg8::gemm_phase(C, P, E);
}
__device__ __forceinline__ void p_moe_up8(const Ctx& C, int layer) {
    LAS int* cbase = (LAS int*)(C.lds + pg8::LDS_CLS); LAS int* ccnt = cbase + 32;
    const int rows = cls_layout(C, layer, cbase, ccnt);
    pg8::ProbUp P{C.Z(), (const bf16*)(C.ws + WS_WGU) + (size_t)layer * 16 * 512 * 1024, C.list(), cbase, ccnt, rows / 256, C.nwg, C.wg};
    pg8::EpiUp E{C.stats(2 * layer), C.list(), C.gates(), C.vec(V_GU_CS) + layer * 16 * 512, C.vec(V_GU_CB) + layer * 16 * 512, C.ACT()};
    pg8::gemm_phase(C, P, E);
}
__device__ __forceinline__ void p_moe_down8(const Ctx& C, int layer) {
    LAS int* cbase = (LAS int*)(C.lds + pg8::LDS_CLS); LAS int* ccnt = cbase + 32;
    const int rows = cls_layout(C, layer, cbase, ccnt);
    pg8::ProbDown P{C.ACT(), (const bf16*)(C.ws + WS_WD) + (size_t)layer * 16 * 1024 * 256, cbase, ccnt, rows / 256, C.nwg, C.wg};
    pg8::EpiDown E{C.stats(2 * layer), C.ln_g + (layer * 2) * 1024, C.ln_b + (layer * 2) * 1024, C.list(), C.Z(), C.stats(2 * layer + 1)};
    pg8::gemm_phase(C, P, E);
}
__device__ __forceinline__ void p_final(const Ctx& C) {
    const float* st = C.stats(7); const float* g = C.ln_g + 7 * 1024; const float* b = C.ln_b + 7 * 1024; const bf16* Z = C.Z();
#if PROBE_MASK
    const float pscale = 1.f + 0.1f * sqrtf(__hip_atomic_load((const float*)(C.ctl() + CW_PROBE), RLX_AGENT));
#else
    const float pscale = 1.f;
#endif
    for (int r = C.gw; r < M; r += C.ngw) {
        f32x2 ms = row_stats(st, r); ms.y *= pscale;
#pragma unroll
        for (int u = 0; u < 2; ++u) { const int c0 = u * 512 + C.lane * 8; const bf16x8 a = *(const bf16x8*)(Z + (size_t)r * D + c0);
            const f32x4 g0 = *(const f32x4*)(g + c0), g1 = *(const f32x4*)(g + c0 + 4), b0 = *(const f32x4*)(b + c0), b1 = *(const f32x4*)(b + c0 + 4);
            f32x4 o0, o1;
#pragma unroll
            for (int e = 0; e < 4; ++e) { o0[e] = (bf2f((bf16)a[e]) - ms.x) * ms.y * g0[e] + b0[e]; o1[e] = (bf2f((bf16)a[4 + e]) - ms.x) * ms.y * g1[e] + b1[e]; }
            *(f32x4*)(C.out + (size_t)r * D + c0) = o0; *(f32x4*)(C.out + (size_t)r * D + c0 + 4) = o1; }
    }
}

__device__ __forceinline__ int fresh_lane() { int l; asm volatile("v_mbcnt_lo_u32_b32 %0, -1, 0\n\tv_mbcnt_hi_u32_b32 %0, -1, %0" : "=v"(l)); return l; }
enum { K_PROLOGUE = 0, K_PROJ, K_ATTN, K_OPROJ, K_ROUTER, K_UP, K_DOWN, K_FINAL };
constexpr int N_PHASES = 1 + DEPTH * 6 + 1;
__device__ __forceinline__ void phase_of(int ph, int& kind, int& layer) {
    if (ph == 0) { kind = K_PROLOGUE; layer = 0; return; }
    if (ph == N_PHASES - 1) { kind = K_FINAL; layer = 0; return; }
    layer = (ph - 1) / 6; kind = K_PROJ + (ph - 1) % 6;
}
__global__ void __launch_bounds__(NWAVES * 64, 2) mk_fwd(Args args) {
    extern __shared__ __attribute__((aligned(16))) unsigned char lds_raw[];
    const int tid0 = threadIdx.x;
#define BUILD_CTX(C, ap) Ctx C; C.x = ap->in[0]; C.ln_g = ap->in[1]; C.ln_b = ap->in[2]; C.swa_w_in = ap->in[3]; C.swa_sinks = ap->in[4]; C.swa_w_o = ap->in[5]; C.fox_w_in = ap->in[6]; \
    C.fox_b_f = ap->in[7]; C.fox_w_o = ap->in[8]; C.w_router = ap->in[9]; C.b_router = ap->in[10]; C.w_gate = ap->in[11]; C.w_up = ap->in[12]; C.w_down = ap->in[13]; \
    C.out = ap->out; C.ws = ap->ws; C.lds = (LAS unsigned char*)lds_raw; C.ldsg = (char*)lds_raw; \
    C.tid = tidv; C.lane = C.tid & 63; C.wave = __builtin_amdgcn_readfirstlane(C.tid >> 6); C.wg = wgv; C.nwg = gridDim.x; C.gw = C.wg * NWAVES + C.wave; C.ngw = C.nwg * NWAVES;
    LAS unsigned char* const lds0 = (LAS unsigned char*)lds_raw;
    volatile LAS unsigned* MISC = (volatile LAS unsigned*)(lds0 + MISC_OFF);
    if (tid0 < 32) MISC[tid0] = 0u;
    __syncthreads();
    unsigned* const ctl0 = (unsigned*)(args.ws + WS_CTL);
    XcdBarrier bar; bar.bar = ctl0 + CW_BAR; bar.x = 0; bar.st = nullptr;
    const bool one = (args.ph_hi - args.ph_lo) > 1;
    const int waveS = __builtin_amdgcn_readfirstlane(tid0 >> 6);
#define FRESH_TID() (waveS * 64 + fresh_lane())
    if (one) bar = xcd_barrier_post(ctl0 + CW_BAR, MISC + 8, tid0);
#if PROBE_MASK
    volatile LAS unsigned long long* PRB = (volatile LAS unsigned long long*)(lds0 + MISC_OFF + 64);
    if (blockIdx.x == 0 && tid0 == 0) { const unsigned long long t = __builtin_amdgcn_s_memrealtime(); PRB[0] = t; PRB[1] = t; PRB[2] = 0; }
#endif
    for (int ph = args.ph_lo; ph < args.ph_hi; ++ph) {
#define RUN(body) do { const __attribute__((address_space(4))) Args* ap = (const __attribute__((address_space(4))) Args*)__builtin_amdgcn_kernarg_segment_ptr(); int tidv = FRESH_TID(); int wgv = blockIdx.x; asm volatile("" : "+s"(ap), "+s"(wgv)); asm volatile("" : "+v"(tidv)); BUILD_CTX(C, ap) body; } while (0)
#define CASE(k, body) do { int ph_ = ph; asm volatile("" : "+s"(ph_)); int kind, layer; phase_of(ph_, kind, layer); (void)layer; if (kind == (k)) { body; } } while (0)
        CASE(K_PROLOGUE, RUN(p_prologue(C)));
        CASE(K_PROJ, RUN(p_proj8(C, layer)));
        CASE(K_ATTN, if (layer & 1) RUN(p_attn_fox8(C)); else RUN(p_attn_swa8(C, layer)));
        CASE(K_OPROJ, RUN(p_oproj8(C, layer)));
        CASE(K_ROUTER, RUN(p_router(C, layer)));
        CASE(K_UP, RUN(p_moe_up8(C, layer)));
        CASE(K_DOWN, RUN(p_moe_down8(C, layer)));
        CASE(K_FINAL, RUN(p_final(C)));
#if PROBE_MASK
        if (ph + 2 == args.ph_hi && blockIdx.x == 0 && FRESH_TID() == 0) {
            const unsigned long long now = __builtin_amdgcn_s_memrealtime(); int kind, layer; phase_of(ph, kind, layer);
            unsigned long long sel = PRB[2]; if (PROBE_HIT(kind, layer)) sel += now - PRB[1];
            const float frac = (float)sel / (float)(now - PRB[0]);
            __hip_atomic_store((float*)(ctl0 + CW_PROBE), frac, __ATOMIC_RELAXED, __HIP_MEMORY_SCOPE_AGENT);
        }
#endif
        if (ph + 1 < args.ph_hi) xcd_barrier(bar, FRESH_TID());
#if PROBE_MASK
        if (blockIdx.x == 0 && FRESH_TID() == 0) { const unsigned long long now = __builtin_amdgcn_s_memrealtime(); int kind, layer; phase_of(ph, kind, layer); if (PROBE_HIT(kind, layer)) PRB[2] = PRB[2] + (now - PRB[1]); PRB[1] = now; }
#endif
    }
}

extern "C" void kernel_launch(void* const* d_in, const int* in_sizes, int n_in, void* d_out, int out_size, void* d_ws, size_t ws_size, hipStream_t stream) {
    static int grid = 0;
    if (grid == 0) {
        if (n_in != 14 || in_sizes[0] != M * D || out_size != M * D || ws_size < WS_END) { fprintf(stderr, "kernel_launch: unexpected shapes / workspace (n_in %d, ws %zu)\n", n_in, ws_size); grid = -1; return; }
        int dev = 0, cus = 0, per_cu = 0;
        if (hipGetDevice(&dev) != hipSuccess || hipDeviceGetAttribute(&cus, hipDeviceAttributeMultiprocessorCount, dev) != hipSuccess) { grid = -1; return; }
        if (hipFuncSetAttribute((const void*)mk_fwd, hipFuncAttributeMaxDynamicSharedMemorySize, LDS_BYTES) != hipSuccess) { fprintf(stderr, "kernel_launch: hipFuncSetAttribute failed\n"); grid = -1; return; }
        if (hipOccupancyMaxActiveBlocksPerMultiprocessor(&per_cu, (const void*)mk_fwd, NWAVES * 64, LDS_BYTES) != hipSuccess || per_cu < 1) { fprintf(stderr, "kernel_launch: occupancy query says %d\n", per_cu); per_cu = 1; }
        (void)hipGetLastError();
        grid = cus * 1;
    }
    if (grid < 0) return;
    (void)hipMemsetAsync((char*)d_ws + WS_CTL, 0, CTL_BYTES, stream);
    Args a{};
    for (int i = 0; i < 14; ++i) a.in[i] = (const float*)d_in[i];
    a.out = (float*)d_out; a.ws = (unsigned char*)d_ws;
#if MK_ONE_LAUNCH
    a.ph_lo = 0; a.ph_hi = N_PHASES;
    hipLaunchKernelGGL(mk_fwd, dim3(grid), dim3(NWAVES * 64), LDS_BYTES, stream, a);
#else
    for (int ph = 0; ph < N_PHASES; ++ph) { a.ph_lo = ph; a.ph_hi = ph + 1; hipLaunchKernelGGL(mk_fwd, dim3(grid), dim3(NWAVES * 64), LDS_BYTES, stream, a); }
#endif
}
```

```cpp
#include <hip/hip_runtime.h>
#include <cstdio>
#include <cstdint>
#include <cmath>

#define GAS __attribute__((address_space(1)))
#define LAS __attribute__((address_space(3)))
typedef unsigned short bf16;
typedef short bf16x8 __attribute__((ext_vector_type(8)));
typedef float f32x4 __attribute__((ext_vector_type(4)));
typedef float f32x2 __attribute__((ext_vector_type(2)));
typedef unsigned u32x4 __attribute__((ext_vector_type(4)));
typedef unsigned u32x2 __attribute__((ext_vector_type(2)));
typedef GAS unsigned gu32;

#ifndef PROBE_MASK
#define PROBE_MASK 0
#endif
#ifndef PROBE_PAR
#define PROBE_PAR 0
#endif
#define PROBE_HIT(kind, layer) (((PROBE_MASK >> (kind)) & 1) && (PROBE_PAR == 0 || ((layer) & 1) == PROBE_PAR - 1))
#ifndef MK_ONE_LAUNCH
#define MK_ONE_LAUNCH 1
#endif

constexpr int M = 16384, D = 1024, S = 2048, NB = 8, DEPTH = 4, NE = 16, DE = 256, NCLS = 24;
constexpr int SWA_N = 1536, FOX_N = 3072, FOX_NALL = 3088;
constexpr float ALPHA = 1.6817928305074290f;
constexpr float LOG2E = 1.4426950408889634f;
constexpr float C2 = 0.125f * LOG2E;
constexpr float LN_EPS = 1e-5f;
constexpr int ACT_ROWS = 22528;

constexpr size_t MiB = 1u << 20;
constexpr size_t WS_CTL = 0, CTL_BYTES = 1 * MiB;
constexpr size_t WS_ROPE = 1 * MiB;
constexpr size_t WS_VEC = 2 * MiB;
constexpr size_t V_PROJ_CS = 0, V_PROJ_CB = 64 * 1024, V_RT_CS = 128 * 1024, V_RT_CB = 129 * 1024, V_GU_CS = 256 * 1024, V_GU_CB = 768 * 1024;
constexpr size_t WS_STATS = 4 * MiB;
constexpr size_t STATS_INST = (size_t)M * 8 * 4;
constexpr size_t WS_CLS = 8 * MiB;
constexpr size_t WS_GATES = 8 * MiB + 64 * 1024;
constexpr size_t WS_LIST = 8 * MiB + 256 * 1024;
constexpr size_t WS_LG = 10 * MiB;
constexpr size_t WS_CUM = 11 * MiB;
constexpr size_t WS_WIN_SWA = 12 * MiB;
constexpr size_t WS_WIN_FOX = 18 * MiB;
constexpr size_t WS_WF = 30 * MiB;
constexpr size_t WS_WR = 30 * MiB + 256 * 1024;
constexpr size_t WS_WO = 31 * MiB;
constexpr size_t WS_WGU = 39 * MiB;
constexpr size_t WS_WD = 103 * MiB;
constexpr size_t WS_Z = 135 * MiB;
constexpr size_t WS_Q = 167 * MiB, WS_K = 199 * MiB, WS_V = 231 * MiB;
constexpr size_t WS_ACT = 263 * MiB;
constexpr size_t WS_END = 285 * MiB;
constexpr int CW_PROBE = 8;
constexpr int CW_TMO = 0, CW_CODE = 1, CW_BAR = 4096, CW_CNT = 16384;

constexpr int LDS_BYTES = 147456;
constexpr int MISC_OFF = 131072 + 320;
constexpr int NWAVES = 8;

#define RLX_AGENT __ATOMIC_RELAXED, __HIP_MEMORY_SCOPE_AGENT
#define LDS_WAIT() asm volatile("s_waitcnt lgkmcnt(0)" ::: "memory")
__device__ __forceinline__ float bf2f(bf16 v) { return __uint_as_float((unsigned)v << 16); }
__device__ __forceinline__ unsigned f2bf(float f) { unsigned u = __float_as_uint(f); return (u + 0x7fffu + ((u >> 16) & 1u)) >> 16; }
__device__ __forceinline__ unsigned pk2(float lo, float hi) { return f2bf(lo) | (f2bf(hi) << 16); }
__device__ __forceinline__ float wave_sum(float v) {
#pragma unroll
    for (int o = 1; o < 64; o <<= 1) v += __shfl_xor(v, o);
    return v;
}
__device__ __forceinline__ float wave_max(float v) {
#pragma unroll
    for (int o = 1; o < 64; o <<= 1) v = fmaxf(v, __shfl_xor(v, o));
    return v;
}
__device__ __forceinline__ f32x4 mfma16(bf16x8 a, bf16x8 b, f32x4 c) { return __builtin_amdgcn_mfma_f32_16x16x32_bf16(a, b, c, 0, 0, 0); }

#define XB_TMO      128
#define XB_XCNT(j)  (256  + 64 * (j))
#define XB_XSUB(j)  (1280 + 64 * (j))
#define XB_XGEN(j)  (2304 + 64 * (j))
#define XB_TOP      3328
#define XB_TOPGEN   3392
#define XCD_BAR_WORDS 3456
#define XB_SPIN_CAP (1u << 18)
__device__ __forceinline__ unsigned xb_ld(unsigned* p)              { return __hip_atomic_load(p, __ATOMIC_RELAXED, __HIP_MEMORY_SCOPE_AGENT); }
__device__ __forceinline__ unsigned xb_add(unsigned* p, unsigned v) { return __hip_atomic_fetch_add(p, v, __ATOMIC_RELAXED, __HIP_MEMORY_SCOPE_AGENT); }
__device__ __forceinline__ unsigned xb_xcc_id() { return (unsigned)__builtin_amdgcn_s_getreg((3 << 11) | 20) & 0xFu; }
#define XB_SPIN(cond, bar) do { unsigned _sp = 0; while (cond) { __builtin_amdgcn_s_sleep(1); \
    if ((++_sp & 255u) == 0u) { if (xb_ld(&(bar)[XB_TMO])) break; if (_sp > XB_SPIN_CAP) { atomicAdd(&(bar)[XB_TMO], 1u); break; } } } } while (0)
struct XcdBarrier { unsigned* bar; unsigned x; volatile LAS unsigned* st; };
__device__ __forceinline__ XcdBarrier xcd_barrier_post(unsigned* bar, volatile LAS unsigned* st, int tid) {
    XcdBarrier b; b.bar = bar; b.x = xb_xcc_id(); b.st = st;
    if (tid == 0) (void)xb_add(&bar[XB_XCNT(b.x)], 1u);
    return b;
}
__device__ __forceinline__ void xcd_barrier_complete(unsigned* bar, unsigned x, unsigned& nloc, unsigned& nx) {
    const unsigned G = gridDim.x * gridDim.y * gridDim.z;
    unsigned sum, cnt, mine, sp = 0u;
    for (;;) {
        sum = 0u; cnt = 0u; mine = 0u;
        asm volatile("" : "+s"(bar), "+s"(x));
#pragma unroll
        for (unsigned j = 0; j < 16; ++j) { const unsigned c = xb_ld(&bar[XB_XCNT(j)]); sum += c; cnt += (c > 0u) ? 1u : 0u; mine = (j == x) ? c : mine; }
        if (sum == G) break;
        __builtin_amdgcn_s_sleep(1);
        if ((++sp & 255u) == 0u) { if (xb_ld(&bar[XB_TMO])) break; if (sp > XB_SPIN_CAP) { atomicAdd(&bar[XB_TMO], 1u); break; } }
    }
    nloc = mine > 0u ? mine : 1u; nx = cnt > 0u ? cnt : 1u;
}
__device__ __forceinline__ void xcd_barrier(const XcdBarrier& b, int tid) {
    asm volatile("s_waitcnt vmcnt(0)" ::: "memory");
    __syncthreads();
    if (tid == 0) {
        unsigned* bar = b.bar;
        __builtin_amdgcn_s_waitcnt(0);
        unsigned nloc = b.st[0], nx = b.st[1];
        if (nloc == 0u) { xcd_barrier_complete(bar, b.x, nloc, nx); b.st[0] = nloc; b.st[1] = nx; }
        const unsigned old = xb_add(&bar[XB_XSUB(b.x)], 1u);
        const unsigned gen = old / nloc;
        if (old + 1u == (gen + 1u) * nloc) {
            __builtin_amdgcn_fence(__ATOMIC_RELEASE, "agent");
            asm volatile("s_waitcnt vmcnt(0)" ::: "memory");
            const unsigned og = xb_add(&bar[XB_TOP], 1u);
            const unsigned tg = og / nx;
            if (og + 1u == (tg + 1u) * nx) xb_add(&bar[XB_TOPGEN], 1u);
            else XB_SPIN(xb_ld(&bar[XB_TOPGEN]) == tg, bar);
            __builtin_amdgcn_fence(__ATOMIC_ACQUIRE, "agent");
            xb_add(&bar[XB_XGEN(b.x)], 1u);
            asm volatile("s_waitcnt vmcnt(0)" ::: "memory");
        } else {
            XB_SPIN(xb_ld(&bar[XB_XGEN(b.x)]) == gen, bar);
            __builtin_amdgcn_fence(__ATOMIC_ACQUIRE, "agent");
            asm volatile("s_waitcnt vmcnt(0)" ::: "memory");
        }
    }
    __syncthreads();
}

struct Args { const float* in[14]; float* out; unsigned char* ws; int ph_lo, ph_hi; };
struct Ctx {
    const float *x, *ln_g, *ln_b, *swa_w_in, *swa_sinks, *swa_w_o, *fox_w_in, *fox_b_f, *fox_w_o, *w_router, *b_router, *w_gate, *w_up, *w_down;
    float* out; unsigned char* ws;
    LAS unsigned char* lds; char* ldsg;
    int tid, lane, wave, wg, nwg, gw, ngw;
    __device__ __forceinline__ bf16* Z() const { return (bf16*)(ws + WS_Z); }
    __device__ __forceinline__ bf16* Q() const { return (bf16*)(ws + WS_Q); }
    __device__ __forceinline__ bf16* Kb() const { return (bf16*)(ws + WS_K); }
    __device__ __forceinline__ bf16* Vb() const { return (bf16*)(ws + WS_V); }
    __device__ __forceinline__ bf16* ACT() const { return (bf16*)(ws + WS_ACT); }
    __device__ __forceinline__ float* stats(int inst) const { return (float*)(ws + WS_STATS + (size_t)inst * STATS_INST); }
    __device__ __forceinline__ float* vec(size_t off) const { return (float*)(ws + WS_VEC + off); }
    __device__ __forceinline__ unsigned* ctl() const { return (unsigned*)(ws + WS_CTL); }
    __device__ __forceinline__ int* cls() const { return (int*)(ws + WS_CLS); }
    __device__ __forceinline__ f32x2* gates() const { return (f32x2*)(ws + WS_GATES); }
    __device__ __forceinline__ int* list() const { return (int*)(ws + WS_LIST); }
};
__device__ __forceinline__ f32x2 row_stats(const float* st, int r) {
    if (!st) return (f32x2){0.f, 1.f};
    const f32x4 a = *(const f32x4*)(st + (size_t)r * 8), b = *(const f32x4*)(st + (size_t)r * 8 + 4);
    const float s = (a[0] + a[2]) + (b[0] + b[2]), q = (a[1] + a[3]) + (b[1] + b[3]);
    const float mu = s * (1.f / D), var = fmaxf(q * (1.f / D) - mu * mu, 0.f);
    return (f32x2){mu, 1.0f / sqrtf(var + LN_EPS)};
}
__device__ __forceinline__ void cls_experts(int c, int& e1, int& e2) {
    const int g = c / 6, p = c % 6;
    const int lo = p < 3 ? 0 : (p < 5 ? 1 : 2), hi = p < 3 ? p + 1 : (p < 5 ? p - 1 : 3);
    e1 = 4 * g + lo; e2 = 4 * g + hi;
}

__constant__ double ROPE_W[16] = {0.5403023058681397174, 0.8414709848078965067, 0.9812558362840285743, 0.1927095839820420340, 0.9992929765482185140, 0.0375971677311151056,
    0.9999734086383661963, 0.007292600096474082358, 0.9999990000001666667, 0.001414213090968621398, 0.9999999623939693048, 0.0002742481722384122054,
    0.9999999985857864380, 0.00005318295894437919888, 0.9999999999468170410, 0.00001031338537702962674};
struct CvtItem { const float* src; int K, N, n0, ncols; bf16* dst; int dpitch; const float* g; const float* b; float* cs; float* cb; };
__device__ __forceinline__ void cvt_item(const CvtItem& it, LAS float* scr, int lane) {
    float cs[4] = {0.f, 0.f, 0.f, 0.f}, cb[4] = {0.f, 0.f, 0.f, 0.f};
    const int c = lane & 7, nb = lane >> 3;
    const int lrow = lane >> 3, lc4 = lane & 7;
    const bool colok = lc4 * 4 < it.ncols;
    const float* sp = it.src + (size_t)lrow * it.N + it.n0 + lc4 * 4;
    f32x4 cur[8], nxt[8];
#pragma unroll
    for (int i = 0; i < 8; ++i) cur[i] = colok ? *(const f32x4*)(sp + (size_t)(8 * i) * it.N) : (f32x4){0.f, 0.f, 0.f, 0.f};
    for (int k0 = 0; k0 < it.K; k0 += 64) {
        const bool more = k0 + 64 < it.K;
        if (more) {
#pragma unroll
            for (int i = 0; i < 8; ++i) nxt[i] = colok ? *(const f32x4*)(sp + (size_t)(k0 + 64 + 8 * i) * it.N) : (f32x4){0.f, 0.f, 0.f, 0.f}; }
#pragma unroll
        for (int i = 0; i < 8; ++i) { LAS float* w = scr + (8 * i + lrow) * 33 + lc4 * 4; w[0] = cur[i][0]; w[1] = cur[i][1]; w[2] = cur[i][2]; w[3] = cur[i][3]; }
        LDS_WAIT(); asm volatile("" ::: "memory");
        float gq[8], bq[8];
#pragma unroll
        for (int q = 0; q < 8; ++q) { gq[q] = it.g ? it.g[k0 + 8 * c + q] : 1.f; bq[q] = it.b ? it.b[k0 + 8 * c + q] : 0.f; }
#pragma unroll
        for (int j = 0; j < 4; ++j) {
            const int n = nb + 8 * j; const LAS float* s = scr + (8 * c) * 33 + n;
            unsigned r[8]; float csp = 0.f, cbp = 0.f;
#pragma unroll
            for (int q = 0; q < 8; ++q) { const float w = s[q * 33]; r[q] = f2bf(w * gq[q]); csp += __uint_as_float(r[q] << 16); cbp += w * bq[q]; }
            cs[j] += csp; cb[j] += cbp;
            if (n < it.ncols) { u32x4 o; o.x = r[0] | (r[1] << 16); o.y = r[2] | (r[3] << 16); o.z = r[4] | (r[5] << 16); o.w = r[6] | (r[7] << 16);
                *(u32x4*)(it.dst + (size_t)n * it.dpitch + k0 + 8 * c) = o; }
        }
        LDS_WAIT(); asm volatile("" ::: "memory");
        if (more) {
#pragma unroll
            for (int i = 0; i < 8; ++i) cur[i] = nxt[i]; }
    }
    if (it.cs) {
#pragma unroll
        for (int j = 0; j < 4; ++j) {
            float a = cs[j], b = cb[j];
            a += __shfl_xor(a, 1); a += __shfl_xor(a, 2); a += __shfl_xor(a, 4);
            b += __shfl_xor(b, 1); b += __shfl_xor(b, 2); b += __shfl_xor(b, 4);
            const int n = nb + 8 * j;
            if (c == 0 && n < it.ncols) { it.cs[n] = a; it.cb[n] = b; }
        }
    }
}
__device__ __forceinline__ CvtItem big_item(const Ctx& C, int idx) {
    CvtItem it; it.K = 1024; it.dpitch = 1024; it.ncols = 32; it.g = nullptr; it.b = nullptr; it.cs = nullptr; it.cb = nullptr;
    if (idx < 1024) {
        const int i = idx >> 8, e = (idx >> 4) & 15, gu = (idx >> 3) & 1, blk = idx & 7;
        it.src = (gu ? C.w_up : C.w_gate) + (size_t)(i * 16 + e) * 1024 * 256; it.N = 256; it.n0 = blk * 32;
        const int row = (it.n0 >> 7) * 256 + gu * 128 + (it.n0 & 127);
        it.dst = (bf16*)(C.ws + WS_WGU) + ((size_t)(i * 16 + e) * 512 + row) * 1024;
        it.g = C.ln_g + (i * 2 + 0) * 1024; it.b = C.ln_b + (i * 2 + 0) * 1024;
        it.cs = C.vec(V_GU_CS) + (i * 16 + e) * 512 + row; it.cb = C.vec(V_GU_CB) + (i * 16 + e) * 512 + row;
        return it; }
    idx -= 1024;
    if (idx < 194) {
        const int j = idx / 97, blk = idx % 97, i = 2 * j + 1;
        it.src = C.fox_w_in + (size_t)j * 1024 * FOX_NALL; it.N = FOX_NALL; it.n0 = blk * 32; it.ncols = blk < 96 ? 32 : 16;
        it.dst = blk < 96 ? (bf16*)(C.ws + WS_WIN_FOX) + ((size_t)j * FOX_N + it.n0) * 1024 : (bf16*)(C.ws + WS_WF) + (size_t)j * 16 * 1024;
        it.g = C.ln_g + ((i - 1) * 2 + 1) * 1024; it.b = C.ln_b + ((i - 1) * 2 + 1) * 1024;
        it.cs = C.vec(V_PROJ_CS) + i * FOX_NALL + it.n0; it.cb = C.vec(V_PROJ_CB) + i * FOX_NALL + it.n0;
        return it; }
    idx -= 194;
    if (idx < 96) {
        const int j = idx / 48, blk = idx % 48, i = 2 * j;
        it.src = C.swa_w_in + (size_t)j * 1024 * SWA_N; it.N = SWA_N; it.n0 = blk * 32;
        it.dst = (bf16*)(C.ws + WS_WIN_SWA) + ((size_t)j * SWA_N + it.n0) * 1024;
        if (i > 0) { it.g = C.ln_g + ((i - 1) * 2 + 1) * 1024; it.b = C.ln_b + ((i - 1) * 2 + 1) * 1024; }
        it.cs = C.vec(V_PROJ_CS) + i * FOX_NALL + it.n0; it.cb = C.vec(V_PROJ_CB) + i * FOX_NALL + it.n0;
        return it; }
    idx -= 96;
    if (idx < 128) {
        const int i = idx >> 5, blk = idx & 31, j = i >> 1;
        it.src = ((i & 1) ? C.fox_w_o : C.swa_w_o) + (size_t)j * 1024 * 1024; it.N = 1024; it.n0 = blk * 32;
        it.dst = (bf16*)(C.ws + WS_WO) + ((size_t)i * 1024 + it.n0) * 1024;
        return it; }
    idx -= 128;
    { const int i = idx; it.src = C.w_router; it.N = 16; it.n0 = 0; it.ncols = 16;
      it.dst = (bf16*)(C.ws + WS_WR) + (size_t)i * 16 * 1024;
      it.g = C.ln_g + (i * 2 + 0) * 1024; it.b = C.ln_b + (i * 2 + 0) * 1024;
      it.cs = C.vec(V_RT_CS) + i * 16; it.cb = C.vec(V_RT_CB) + i * 16; }
    return it;
}
constexpr int N_BIG = 1024 + 194 + 96 + 128 + 4;
__device__ __forceinline__ CvtItem small_item(const Ctx& C, int q) {
    CvtItem it; const int i = q >> 9, e = (q >> 5) & 15, blk = q & 31;
    it.src = C.w_down + (size_t)(i * 16 + e) * 256 * 1024; it.K = 256; it.N = 1024; it.n0 = blk * 32; it.ncols = 32;
    it.dst = (bf16*)(C.ws + WS_WD) + ((size_t)(i * 16 + e) * 1024 + it.n0) * 256; it.dpitch = 256;
    it.g = nullptr; it.b = nullptr; it.cs = nullptr; it.cb = nullptr; return it;
}
__device__ __forceinline__ void p_prologue(const Ctx& C) {
    LAS float* scr = (LAS float*)(C.lds + C.wave * 8704);
    for (int sl = C.gw; sl < N_BIG + 512; sl += C.ngw) {
        if (sl < N_BIG) { const CvtItem it = big_item(C, sl); cvt_item(it, scr, C.lane); }
        else { for (int u = 0; u < 4; ++u) { const CvtItem it = small_item(C, (sl - N_BIG) * 4 + u); cvt_item(it, scr, C.lane); } }
    }
    { const int nth = C.nwg * 512, gt = C.wg * 512 + C.tid; bf16* Z = C.Z();
#pragma unroll 2
      for (int i = gt; i < M * D / 16; i += nth) { const f32x4 a = *(const f32x4*)(C.x + (size_t)i * 16), b = *(const f32x4*)(C.x + (size_t)i * 16 + 4), c2 = *(const f32x4*)(C.x + (size_t)i * 16 + 8), d = *(const f32x4*)(C.x + (size_t)i * 16 + 12);
          u32x4 o, p; o.x = pk2(a[0], a[1]); o.y = pk2(a[2], a[3]); o.z = pk2(b[0], b[1]); o.w = pk2(b[2], b[3]); p.x = pk2(c2[0], c2[1]); p.y = pk2(c2[2], c2[3]); p.z = pk2(d[0], d[1]); p.w = pk2(d[2], d[3]);
          *(u32x4*)(Z + (size_t)i * 16) = o; *(u32x4*)(Z + (size_t)i * 16 + 8) = p; } }
    { const int gt = C.wg * 512 + C.tid;
      if (gt < 256) { float* T = (float*)(C.ws + WS_ROPE); const int j = gt & 7, a = gt >> 3;
          const double wr = ROPE_W[2 * j], wi = ROPE_W[2 * j + 1];
          double pr = wr, pi = wi;
          for (int q = 0; q < 6; ++q) { const double t = pr * pr - pi * pi; pi = 2.0 * pr * pi; pr = t; }
          double zr = 1.0, zi = 0.0;
          for (int bit = 0; bit < 5; ++bit) { if ((a >> bit) & 1) { const double t = zr * pr - zi * pi; zi = zr * pi + zi * pr; zr = t; } const double t2 = pr * pr - pi * pi; pi = 2.0 * pr * pi; pr = t2; }
          for (int b = 0; b < 64; ++b) { const int pos = 64 * a + b; T[pos * 8 + j] = (float)zr; T[S * 8 + pos * 8 + j] = (float)zi; const double t = zr * wr - zi * wi; zi = zr * wi + zi * wr; zr = t; } } }
}

__device__ __forceinline__ f32x4 thin64(const Ctx& C, const bf16* Zr, int r0blk, const bf16* WT) {
    const int lane = C.lane, w = C.wave, kh = w >> 2;
    const bf16* ap = Zr + (size_t)(r0blk + 16 * (w & 3) + (lane & 15)) * D + 512 * kh + 8 * (lane >> 4); const bf16* bp = WT + (size_t)(lane & 15) * D + 512 * kh + 8 * (lane >> 4);
    bf16x8 a[16], b[16];
#pragma unroll
    for (int k = 0; k < 16; ++k) { a[k] = *(const bf16x8*)(ap + 32 * k); b[k] = *(const bf16x8*)(bp + 32 * k); }
    f32x4 acc = (f32x4){0.f, 0.f, 0.f, 0.f};
#pragma unroll
    for (int k = 0; k < 16; ++k) acc = mfma16(a[k], b[k], acc);
    LAS f32x4* X = (LAS f32x4*)(C.lds + 12288);
    __syncthreads();
    if (kh) X[(w & 3) * 64 + lane] = acc;
    __syncthreads();
    if (!kh) acc += X[w * 64 + lane];
    return acc;
}
namespace pg8 {
constexpr int BM = 256, BK = 64, HALF = 128, HTB = HALF * BK * 2, STAGE_BYTES = 8 * HTB;
__device__ __forceinline__ int lds_byte(int r, int c) { const int st = (r >> 4) * 2 + (c >> 5), rr = r & 15, cc = c & 31, ob = rr * 64 + cc * 2; return st * 1024 + (ob ^ (((ob >> 9) & 1) << 5)); }
__device__ __forceinline__ void stage_rc(int b, int& R, int& C) { const int st = b / 1024, sb = b % 1024, swz = sb ^ (((sb >> 9) & 1) << 5); R = (st >> 1) * 16 + swz / 64; C = (st & 1) * 32 + (swz % 64) / 2; }
__device__ __forceinline__ int perm32(int rho) { const int n = rho >> 4, i = rho & 15; return 8 * (i >> 2) + 4 * n + (i & 3); }
struct Unit { int pm, pn, cls, base, cnt, e1, e2; };
typedef f32x4 Acc[2][2][4][2];
constexpr int LDS_TAB = 131072 + 1024;
constexpr int LDS_CLS = 131072 + 512;

template <class Prob, class Epi>
__device__ __forceinline__ void gemm_phase(const Ctx& C, const Prob& P, const Epi& E) {
    LAS unsigned char* lds = C.lds;
    const int tid = C.tid, wid = C.wave, lane = C.lane, wr = wid >> 2, wc = wid & 3, fr = lane & 15, fq = lane >> 4;
    constexpr int nt = Prob::K / BK, LDBE = Prob::LDB;
    unsigned voffA[2], voffB[2];
#pragma unroll
    for (int i = 0; i < 2; ++i) { int R_, C_; stage_rc(tid * 16 + i * 8192, R_, C_); const int Rb = (R_ & ~31) + perm32(R_ & 31); voffA[i] = (unsigned)(R_ * Prob::LDA + C_) * 2u; voffB[i] = (unsigned)(Rb * LDBE + C_) * 2u; }
    constexpr size_t hstepB = (size_t)HALF * LDBE * 2;
    const unsigned ldsw = (unsigned)wid * 1024u;
    const int aoff = lds_byte(wr * 64 + fr, fq * 8), boff = lds_byte(wc * 32 + fr, fq * 8);
#define PG8_SA(b, h) (((b) * 2 + (h)) * HTB)
#define PG8_SB(b, h) ((4 + (b) * 2 + (h)) * HTB)
#define PG8_STAGE_B(bufoff, gbase) do { _Pragma("unroll") for (int _i = 0; _i < 2; ++_i) { unsigned _v = voffB[_i]; const char* _b = (const char*)(gbase); asm volatile("" : "+v"(_v), "+s"(_b));     \
        __builtin_amdgcn_global_load_lds((const unsigned*)(_b + _v), (LAS unsigned*)(lds + (bufoff) + ldsw + _i * 8192), 16, 0, 0); } } while (0)
#define PG8_STAGE_A(bufoff, un, vo, h, tt) do { _Pragma("unroll") for (int _i = 0; _i < 2; ++_i) { unsigned _v = Prob::GATHER ? (vo)[h][_i] : voffA[_i]; const char* _b = P.a_tile(un, h) + (size_t)(tt) * (BK * 2); asm volatile("" : "+v"(_v), "+s"(_b)); \
        __builtin_amdgcn_global_load_lds((const unsigned*)(_b + _v), (LAS unsigned*)(lds + (bufoff) + ldsw + _i * 8192), 16, 0, 0); } } while (0)
#define PG8_LDA(dst, b, h) do { _Pragma("unroll") for (int m = 0; m < 4; ++m) _Pragma("unroll") for (int k = 0; k < 2; ++k) dst[m][k] = *(const LAS bf16x8*)(lds + PG8_SA(b, h) + aoff + m * 2048 + k * 1024); } while (0)
#define PG8_LDB(dst, b, h) do { _Pragma("unroll") for (int n = 0; n < 2; ++n) _Pragma("unroll") for (int k = 0; k < 2; ++k) dst[n][k] = *(const LAS bf16x8*)(lds + PG8_SB(b, h) + boff + n * 2048 + k * 1024); } while (0)
#define PG8_MMA(ai, bj, At, Bt) do { __builtin_amdgcn_s_setprio(1); _Pragma("unroll") for (int m = 0; m < 4; ++m) _Pragma("unroll") for (int n = 0; n < 2; ++n) _Pragma("unroll") for (int k = 0; k < 2; ++k) \
        acc[ai][bj][m][n] = __builtin_amdgcn_mfma_f32_16x16x32_bf16(Bt[n][k], At[m][k], acc[ai][bj][m][n], 0, 0, 0); __builtin_amdgcn_s_setprio(0); } while (0)
#define PG8_WAIT_V(n) asm volatile("s_waitcnt vmcnt(" #n ")" ::: "memory")
#define PG8_WAIT_L(n) asm volatile("s_waitcnt lgkmcnt(" #n ")" ::: "memory")
#define PG8_BAR __builtin_amdgcn_s_barrier()
#define PG8_SCHED __builtin_amdgcn_sched_barrier(0)
#define PG8_KSTEP(t, un2, vo2, t2, b2, b3) do { \
        PG8_LDB(B0, 0, 0); PG8_LDB(B1, 0, 1); PG8_SCHED; PG8_LDA(At, 0, 0); PG8_STAGE_A(PG8_SA(1, 1), cur, voC, 1, (t) + 1); \
        PG8_WAIT_V(8); PG8_WAIT_L(0); PG8_BAR; PG8_MMA(0, 0, At, B0); PG8_MMA(0, 1, At, B1); PG8_BAR; PG8_SCHED; \
        PG8_LDA(At, 0, 1); PG8_STAGE_B(PG8_SB(0, 0), b2); PG8_STAGE_B(PG8_SB(0, 1), (b2) + hstepB); PG8_STAGE_A(PG8_SA(0, 0), un2, vo2, 0, t2); \
        PG8_WAIT_V(8); PG8_WAIT_L(0); PG8_BAR; PG8_MMA(1, 0, At, B0); PG8_MMA(1, 1, At, B1); PG8_BAR; PG8_SCHED; \
        PG8_LDB(B0, 1, 0); PG8_LDB(B1, 1, 1); PG8_SCHED; PG8_LDA(At, 1, 0); PG8_STAGE_A(PG8_SA(0, 1), un2, vo2, 1, t2); \
        PG8_WAIT_V(8); PG8_WAIT_L(0); PG8_BAR; PG8_MMA(0, 0, At, B0); PG8_MMA(0, 1, At, B1); PG8_BAR; PG8_SCHED; \
        PG8_LDA(At, 1, 1); PG8_STAGE_B(PG8_SB(1, 0), b3); PG8_STAGE_B(PG8_SB(1, 1), (b3) + hstepB); PG8_STAGE_A(PG8_SA(1, 0), un2, vo2, 0, (t2) + 1); \
        PG8_WAIT_V(8); PG8_WAIT_L(0); PG8_BAR; PG8_MMA(1, 0, At, B0); PG8_MMA(1, 1, At, B1); PG8_BAR; PG8_SCHED; } while (0)
    Unit cur = {0, 0, 0, 0, 0, 0, 0}, nxt = {0, 0, 0, 0, 0, 0, 0}; int ui = 0;
    if (!P.next(0, cur)) return;
    Acc acc;
#define PG8_ZERO() do { _Pragma("unroll") for (int a = 0; a < 2; ++a) _Pragma("unroll") for (int b = 0; b < 2; ++b) _Pragma("unroll") for (int m = 0; m < 4; ++m) _Pragma("unroll") for (int n = 0; n < 2; ++n) acc[a][b][m][n] = (f32x4){0.f, 0.f, 0.f, 0.f}; } while (0)
    PG8_ZERO();
    bf16x8 At[4][2], B0[2][2], B1[2][2];
    unsigned voC[2][2], voN[2][2];
    if (Prob::GATHER) P.a_offsets(cur, tid, voC);
    {
        const char* pb0 = P.b_tile(cur, 0); const char* pb1 = P.b_tile(cur, 1);
        PG8_STAGE_B(PG8_SB(0, 0), pb0); PG8_STAGE_B(PG8_SB(0, 1), pb0 + hstepB); PG8_STAGE_A(PG8_SA(0, 0), cur, voC, 0, 0); PG8_STAGE_A(PG8_SA(0, 1), cur, voC, 1, 0);
        if (wr == 1) PG8_BAR;
        PG8_WAIT_V(2); PG8_BAR;
        PG8_STAGE_B(PG8_SB(1, 0), pb1); PG8_STAGE_A(PG8_SA(1, 0), cur, voC, 0, 1); PG8_STAGE_B(PG8_SB(1, 1), pb1 + hstepB);
        PG8_WAIT_V(6); PG8_BAR;
    }
    for (;;) {
        const bool has_next = P.next(ui + 1, nxt);
        if (has_next) { if (Prob::GATHER) P.a_offsets(nxt, tid, voN); }
        else { nxt = cur;
#pragma unroll
            for (int h = 0; h < 2; ++h)
#pragma unroll
                for (int i = 0; i < 2; ++i) voN[h][i] = voC[h][i]; }
#pragma unroll 1
        for (int t = 0; t < nt - 2; t += 2) { const char* b2 = P.b_tile(cur, t + 2); const char* b3 = P.b_tile(cur, t + 3); PG8_KSTEP(t, cur, voC, t + 2, b2, b3); }
        { const char* b2 = P.b_tile(nxt, 0); const char* b3 = P.b_tile(nxt, 1); PG8_KSTEP(nt - 2, nxt, voN, 0, b2, b3); }
        if (wr == 0) PG8_BAR;
        E(acc, cur, C, wr, wc, fr, fq);
        if (!has_next) break;
        PG8_ZERO();
        cur = nxt;
#pragma unroll
        for (int h = 0; h < 2; ++h)
#pragma unroll
            for (int i = 0; i < 2; ++i) voC[h][i] = voN[h][i];
        ++ui;
        if (wr == 1) PG8_BAR;
    }
    PG8_WAIT_V(0);
    PG8_BAR;
#undef PG8_SA
#undef PG8_SB
#undef PG8_STAGE_A
#undef PG8_STAGE_B
#undef PG8_LDA
#undef PG8_LDB
#undef PG8_MMA
#undef PG8_WAIT_V
#undef PG8_WAIT_L
#undef PG8_BAR
#undef PG8_SCHED
#undef PG8_KSTEP
#undef PG8_ZERO
}
__device__ __forceinline__ unsigned cvt_pk_bf16(float lo, float hi) { unsigned r; asm volatile("v_cvt_pk_bf16_f32 %0, %1, %2" : "=v"(r) : "v"(lo), "v"(hi)); return r; }
__device__ __forceinline__ void epi_bar() { asm volatile("s_waitcnt lgkmcnt(0)" ::: "memory"); __builtin_amdgcn_s_barrier(); asm volatile("" ::: "memory"); }

__device__ __forceinline__ bool static_next(int i, int G, int c, int nM, int nN, Unit& u) {
    const int nwg = nM * nN; const long L = (long)i * G + c; if (L >= nwg) return false;
    int wgid = (int)L; { const int q = nwg / 8, r = nwg % 8, xcd = wgid % 8, off = wgid / 8; wgid = (xcd < r ? xcd * (q + 1) : r * (q + 1) + (xcd - r) * q) + off; }
    const int nig = 8 * nN, gid = wgid / nig, fm = gid * 8, gsz = (nM - fm) < 8 ? (nM - fm) : 8;
    u.pm = fm + ((wgid % nig) % gsz); u.pn = (wgid % nig) / gsz; u.cls = 0; u.base = 0; u.cnt = 0; u.e1 = 0; u.e2 = 0; return true;
}
struct ProbPlain {
    static constexpr int K = 1024, LDA = 1024, LDB = 1024; static constexpr bool GATHER = false;
    const bf16* A; const bf16* Bt; int nM, nN, G, c;
    __device__ __forceinline__ bool next(int i, Unit& u) const { return static_next(i, G, c, nM, nN, u); }
    __device__ __forceinline__ const char* a_tile(const Unit& u, int h) const { return (const char*)A + (size_t)(u.pm * 256 + h * 128) * (1024 * 2); }
    __device__ __forceinline__ void a_offsets(const Unit&, int, unsigned (&)[2][2]) const {}
    __device__ __forceinline__ const char* b_tile(const Unit& u, int t) const { return (const char*)Bt + (size_t)u.pn * (256 * 1024 * 2) + (size_t)t * (BK * 2); }
};
__device__ __forceinline__ bool cls_next(int i, int G, int c, int ntiles, const LAS int* cbase, const LAS int* ccnt, Unit& u) {
    const int nwg = ntiles * 4; const long L = (long)i * G + c; if (L >= nwg) return false;
    int wgid = (int)L; { const int q = nwg / 8, r = nwg % 8, xcd = wgid % 8, off = wgid / 8; wgid = (xcd < r ? xcd * (q + 1) : r * (q + 1) + (xcd - r) * q) + off; }
    u.pm = wgid >> 2; u.pn = wgid & 3;
    const int R0 = u.pm * 256; int cl = 0;
#pragma unroll 1
    for (int k = 1; k < NCLS; ++k) if (R0 >= cbase[k]) cl = k;
    cl = __builtin_amdgcn_readfirstlane(cl);
    u.cls = cl; u.base = __builtin_amdgcn_readfirstlane(cbase[cl]); u.cnt = __builtin_amdgcn_readfirstlane(ccnt[cl]); cls_experts(cl, u.e1, u.e2); return true;
}
struct ProbUp {
    static constexpr int K = 1024, LDA = 1024, LDB = 1024; static constexpr bool GATHER = true;
    const bf16* Z; const bf16* WGU; const int* list; const LAS int* cbase; const LAS int* ccnt; int ntiles, G, c;
    __device__ __forceinline__ bool next(int i, Unit& u) const { return cls_next(i, G, c, ntiles, cbase, ccnt, u); }
    __device__ __forceinline__ const char* a_tile(const Unit&, int) const { return (const char*)Z; }
    __device__ __forceinline__ void a_offsets(const Unit& u, int tid, unsigned (&vo)[2][2]) const {
#pragma unroll
        for (int i = 0; i < 2; ++i) { int R_, C_; stage_rc(tid * 16 + i * 8192, R_, C_);
#pragma unroll
            for (int h = 0; h < 2; ++h) { int li = u.pm * 256 + h * 128 + R_ - u.base; li = li < u.cnt ? li : u.cnt - 1; const int tok = list[u.cls * M + li]; vo[h][i] = (unsigned)(tok * 1024 + C_) * 2u; } } }
    __device__ __forceinline__ const char* b_tile(const Unit& u, int t) const { const int e = (u.pn >> 1) ? u.e2 : u.e1; return (const char*)WGU + (size_t)(e * 2 + (u.pn & 1)) * (256 * 1024 * 2) + (size_t)t * (BK * 2); }
};
struct ProbDown {
    static constexpr int K = 512, LDA = 512, LDB = 256; static constexpr bool GATHER = false;
    const bf16* ACT; const bf16* WD; const LAS int* cbase; const LAS int* ccnt; int ntiles, G, c;
    __device__ __forceinline__ bool next(int i, Unit& u) const { return cls_next(i, G, c, ntiles, cbase, ccnt, u); }
    __device__ __forceinline__ const char* a_tile(const Unit& u, int h) const { return (const char*)ACT + (size_t)(u.pm * 256 + h * 128) * (512 * 2); }
    __device__ __forceinline__ void a_offsets(const Unit&, int, unsigned (&)[2][2]) const {}
    __device__ __forceinline__ const char* b_tile(const Unit& u, int t) const { const int e = t < 4 ? u.e1 : u.e2; return (const char*)WD + ((size_t)e * 1024 + (size_t)u.pn * 256) * (256 * 2) + (size_t)(t & 3) * (BK * 2); }
};

__device__ __forceinline__ void unpack8(const u32x4 w, float (&f)[8]) {
    f[0] = __uint_as_float(w.x << 16); f[1] = __uint_as_float(w.x & 0xffff0000u); f[2] = __uint_as_float(w.y << 16); f[3] = __uint_as_float(w.y & 0xffff0000u);
    f[4] = __uint_as_float(w.z << 16); f[5] = __uint_as_float(w.z & 0xffff0000u); f[6] = __uint_as_float(w.w << 16); f[7] = __uint_as_float(w.w & 0xffff0000u); }
struct EpiProj {
    bool fox; const float* st; const float* cs; const float* cb; const float* rope; bf16* Q;
    __device__ __forceinline__ void operator()(Acc& acc, const Unit& u, const Ctx& C, int wr, int wc, int fr, int fq) const {
        const int row0 = u.pm * 256 + wr * 64 + fr, colt = u.pn * 256 + wc * 32 + 8 * fq;
        f32x4 csv[2][2], cbv[2][2];
#pragma unroll
        for (int bj = 0; bj < 2; ++bj)
#pragma unroll
            for (int n = 0; n < 2; ++n) { csv[bj][n] = *(const f32x4*)(cs + colt + 128 * bj + 4 * n); cbv[bj][n] = *(const f32x4*)(cb + colt + 128 * bj + 4 * n); }
        size_t doff; int ldc, dcol; float sc = 1.f;
        if (fox) { const int t = u.pn >> 2; doff = (size_t)t * ((WS_K - WS_Q) / 2); ldc = 1024; dcol = (u.pn & 3) * 256; if (t == 0) sc = C2; }
        else { if (u.pn < 4) { doff = 0; ldc = 1024; dcol = u.pn * 256; sc = C2; } else { doff = (u.pn == 4) ? (WS_K - WS_Q) / 2 : (WS_V - WS_Q) / 2; ldc = 256; dcol = 0; } }
        bf16* dst = Q + doff + dcol + wc * 32 + 8 * fq;
        const bool rope_on = !fox && u.pn < 5 && !(wc & 1);
        const float sgn = fq == 0 ? -1.f : 1.f;
#pragma unroll
        for (int ai = 0; ai < 2; ++ai)
#pragma unroll
            for (int m = 0; m < 4; ++m) {
                const int r = row0 + 128 * ai + 16 * m; const f32x2 ms = row_stats(st, r);
                f32x4 v[2][2];
#pragma unroll
                for (int bj = 0; bj < 2; ++bj)
#pragma unroll
                    for (int n = 0; n < 2; ++n) v[bj][n] = (acc[ai][bj][m][n] - ms.x * csv[bj][n]) * ms.y + cbv[bj][n];
                if (rope_on) {
                    const int pos = r & (S - 1); f32x4 co[2], si[2];
                    co[0] = *(const f32x4*)(rope + pos * 8); co[1] = *(const f32x4*)(rope + pos * 8 + 4); si[0] = *(const f32x4*)(rope + S * 8 + pos * 8); si[1] = *(const f32x4*)(rope + S * 8 + pos * 8 + 4);
#pragma unroll
                    for (int bj = 0; bj < 2; ++bj)
#pragma unroll
                        for (int n = 0; n < 2; ++n)
#pragma unroll
                            for (int e = 0; e < 4; ++e) { const float x = v[bj][n][e], o = __shfl_xor(x, 16); const float y = x * co[n][e] + sgn * o * si[n][e]; v[bj][n][e] = fq < 2 ? y : x; }
                }
#pragma unroll
                for (int bj = 0; bj < 2; ++bj) { const f32x4 a = v[bj][0] * sc, b = v[bj][1] * sc; u32x4 w; w.x = cvt_pk_bf16(a[0], a[1]); w.y = cvt_pk_bf16(a[2], a[3]); w.z = cvt_pk_bf16(b[0], b[1]); w.w = cvt_pk_bf16(b[2], b[3]);
                    *(u32x4*)(dst + (size_t)r * ldc + 128 * bj) = w; }
            }
    }
};
struct EpiOut {
    const float* stp; const float* gp; const float* bp; bf16* Z; float* sto;
    __device__ __forceinline__ void operator()(Acc& acc, const Unit& u, const Ctx& C, int wr, int wc, int fr, int fq) const {
        const int colt = u.pn * 256 + wc * 32 + 8 * fq;
        f32x4 gv[2][2], bv[2][2];
#pragma unroll
        for (int bj = 0; bj < 2; ++bj)
#pragma unroll
            for (int n = 0; n < 2; ++n) { gv[bj][n] = gp ? *(const f32x4*)(gp + colt + 128 * bj + 4 * n) : (f32x4){1.f, 1.f, 1.f, 1.f}; bv[bj][n] = gp ? *(const f32x4*)(bp + colt + 128 * bj + 4 * n) : (f32x4){0.f, 0.f, 0.f, 0.f}; }
        LAS f32x2* T = (LAS f32x2*)(C.lds + LDS_TAB);
#pragma unroll
        for (int ai = 0; ai < 2; ++ai)
#pragma unroll
            for (int m = 0; m < 4; ++m) {
                const int rl = 128 * ai + 64 * wr + 16 * m + fr, r = u.pm * 256 + rl; const f32x2 ms = row_stats(stp, r);
                float s = 0.f, q = 0.f;
#pragma unroll
                for (int bj = 0; bj < 2; ++bj) {
                    bf16* p = Z + (size_t)r * D + colt + 128 * bj; float zi[8]; unpack8(*(const u32x4*)p, zi); float zo[8];
#pragma unroll
                    for (int n = 0; n < 2; ++n)
#pragma unroll
                        for (int e = 0; e < 4; ++e) { const float xin = gp ? (zi[4 * n + e] - ms.x) * ms.y * gv[bj][n][e] + bv[bj][n][e] : zi[4 * n + e]; zo[4 * n + e] = ALPHA * xin + acc[ai][bj][m][n][e]; }
                    u32x4 w; w.x = cvt_pk_bf16(zo[0], zo[1]); w.y = cvt_pk_bf16(zo[2], zo[3]); w.z = cvt_pk_bf16(zo[4], zo[5]); w.w = cvt_pk_bf16(zo[6], zo[7]);
                    *(u32x4*)p = w; float zr[8]; unpack8(w, zr);
#pragma unroll
                    for (int e = 0; e < 8; ++e) { s += zr[e]; q += zr[e] * zr[e]; }
                }
                s += __shfl_xor(s, 16); s += __shfl_xor(s, 32); q += __shfl_xor(q, 16); q += __shfl_xor(q, 32);
                if (fq == 0) T[rl * 4 + wc] = (f32x2){s, q};
                asm volatile("" ::: "memory");
            }
        epi_bar();
        if (C.tid < 256) { const f32x2 a = T[C.tid * 4 + 0], b = T[C.tid * 4 + 1], c = T[C.tid * 4 + 2], d = T[C.tid * 4 + 3];
            *(f32x2*)(sto + (size_t)(u.pm * 256 + C.tid) * 8 + u.pn * 2) = (f32x2){(a.x + b.x) + (c.x + d.x), (a.y + b.y) + (c.y + d.y)}; }
    }
};
struct EpiUp {
    const float* st; const int* list; const f32x2* gates; const float* gcs; const float* gcb; bf16* ACT;
    __device__ __forceinline__ void operator()(Acc& acc, const Unit& u, const Ctx& C, int wr, int wc, int fr, int fq) const {
        const int which = u.pn >> 1, half = u.pn & 1, e = which ? u.e2 : u.e1;
        const float* pcs = gcs + e * 512 + half * 256 + wc * 32 + 8 * fq; const float* pcb = gcb + e * 512 + half * 256 + wc * 32 + 8 * fq;
        f32x4 csg[2], csu[2], cbg[2], cbu[2];
#pragma unroll
        for (int n = 0; n < 2; ++n) { csg[n] = *(const f32x4*)(pcs + 4 * n); csu[n] = *(const f32x4*)(pcs + 128 + 4 * n); cbg[n] = *(const f32x4*)(pcb + 4 * n); cbu[n] = *(const f32x4*)(pcb + 128 + 4 * n); }
        bf16* dst = ACT + which * 256 + half * 128 + wc * 32 + 8 * fq;
#pragma unroll
        for (int ai = 0; ai < 2; ++ai)
#pragma unroll
            for (int m = 0; m < 4; ++m) {
                const int rl = 128 * ai + 64 * wr + 16 * m + fr, R = u.pm * 256 + rl, li = R - u.base; const bool valid = li < u.cnt;
                const int tok = list[u.cls * M + (valid ? li : 0)]; const f32x2 ms = row_stats(st, tok); const f32x2 gt = gates[tok];
                const float gate = valid ? (which ? gt.y : gt.x) : 0.f;
                float a[8];
#pragma unroll
                for (int n = 0; n < 2; ++n)
#pragma unroll
                    for (int k = 0; k < 4; ++k) { const float hg = ms.y * (acc[ai][0][m][n][k] - ms.x * csg[n][k]) + cbg[n][k], hu = ms.y * (acc[ai][1][m][n][k] - ms.x * csu[n][k]) + cbu[n][k];
                        a[4 * n + k] = hg * __builtin_amdgcn_rcpf(1.f + __expf(-hg)) * hu * gate; }
                u32x4 w; w.x = cvt_pk_bf16(a[0], a[1]); w.y = cvt_pk_bf16(a[2], a[3]); w.z = cvt_pk_bf16(a[4], a[5]); w.w = cvt_pk_bf16(a[6], a[7]);
                *(u32x4*)(dst + (size_t)R * 512) = w;
            }
    }
};
struct EpiDown {
    const float* st1; const float* g1; const float* b1; const int* list; bf16* Z; float* sto;
    __device__ __forceinline__ void operator()(Acc& acc, const Unit& u, const Ctx& C, int wr, int wc, int fr, int fq) const {
        const int colt = u.pn * 256 + wc * 32 + 8 * fq;
        f32x4 gv[2][2], bv[2][2];
#pragma unroll
        for (int bj = 0; bj < 2; ++bj)
#pragma unroll
            for (int n = 0; n < 2; ++n) { gv[bj][n] = *(const f32x4*)(g1 + colt + 128 * bj + 4 * n); bv[bj][n] = *(const f32x4*)(b1 + colt + 128 * bj + 4 * n); }
        LAS f32x2* T = (LAS f32x2*)(C.lds + LDS_TAB);
#pragma unroll
        for (int ai = 0; ai < 2; ++ai)
#pragma unroll
            for (int m = 0; m < 4; ++m) {
                const int rl = 128 * ai + 64 * wr + 16 * m + fr, li = u.pm * 256 + rl - u.base; const bool valid = li < u.cnt;
                const int tok = list[u.cls * M + (valid ? li : 0)]; const f32x2 ms = row_stats(st1, tok);
                float s = 0.f, q = 0.f;
#pragma unroll
                for (int bj = 0; bj < 2; ++bj) {
                    bf16* p = Z + (size_t)tok * D + colt + 128 * bj; float zi[8]; unpack8(*(const u32x4*)p, zi); float zo[8];
#pragma unroll
                    for (int n = 0; n < 2; ++n)
#pragma unroll
                        for (int e = 0; e < 4; ++e) { const float x1 = (zi[4 * n + e] - ms.x) * ms.y * gv[bj][n][e] + bv[bj][n][e]; zo[4 * n + e] = ALPHA * x1 + acc[ai][bj][m][n][e]; }
                    u32x4 w; w.x = cvt_pk_bf16(zo[0], zo[1]); w.y = cvt_pk_bf16(zo[2], zo[3]); w.z = cvt_pk_bf16(zo[4], zo[5]); w.w = cvt_pk_bf16(zo[6], zo[7]);
                    if (valid) *(u32x4*)p = w;
                    float zr[8]; unpack8(w, zr);
#pragma unroll
                    for (int e = 0; e < 8; ++e) { s += zr[e]; q += zr[e] * zr[e]; }
                }
                s += __shfl_xor(s, 16); s += __shfl_xor(s, 32); q += __shfl_xor(q, 16); q += __shfl_xor(q, 32);
                if (fq == 0) T[rl * 4 + wc] = (f32x2){s, q};
                asm volatile("" ::: "memory");
            }
        epi_bar();
        if (C.tid < 256) { const int li = u.pm * 256 + C.tid - u.base;
            if (li < u.cnt) { const int tok = list[u.cls * M + li]; const f32x2 a = T[C.tid * 4 + 0], b = T[C.tid * 4 + 1], c = T[C.tid * 4 + 2], d = T[C.tid * 4 + 3];
                *(f32x2*)(sto + (size_t)tok * 8 + u.pn * 2) = (f32x2){(a.x + b.x) + (c.x + d.x), (a.y + b.y) + (c.y + d.y)}; } }
    }
};
}

#ifndef USE8_PROJ
#define USE8_PROJ 1
#endif
#ifndef USE8_OPROJ
#define USE8_OPROJ 1
#endif
#ifndef USE8_UP
#define USE8_UP 1
#endif
#ifndef USE8_DOWN
#define USE8_DOWN 1
#endif
namespace fox {
using bf16=unsigned short;
using s16x4=__attribute__((ext_vector_type(4)))short;
using f32x16=__attribute__((ext_vector_type(16)))float;
constexpr int BATCH=8,NHEAD=16,SEQ=2048,D=64,DM=NHEAD*D;
constexpr int NW=8,QBLK=32,QB=QBLK*NW,KVBLK=64,NQB=SEQ/QB;
constexpr int ATTN_PITCH=DM, ATTN_UNIT_ROWS=QB;
__device__ __forceinline__ int crow(int r,int hi){return (r&3)+8*(r>>2)+4*hi;}
#define SBAR() __builtin_amdgcn_sched_barrier(0)
__device__ __forceinline__ void cmask(f32x16&p0,f32x16&p1,int jb,int qrel,int hi){
  const float NEG=-INFINITY; int kb=64*jb+4*hi;
  #pragma unroll
  for(int r=0;r<16;++r){int kv=kb+(r&3)+8*(r>>2); if(kv>qrel)p0[r]=NEG; if(kv+32>qrel)p1[r]=NEG;}
}

__device__ __forceinline__ void wmask(f32x16&p0,f32x16&p1,int dq){
  const float NEG=-INFINITY;
  #pragma unroll
  for(int r=0;r<16;++r){const int d=dq-((r&3)+8*(r>>2)); if((unsigned)d>=128u)p0[r]=NEG; if((unsigned)(d-32)>=128u)p1[r]=NEG;}
}
constexpr int NSLOT=3, SLOTB=8192;
constexpr int LDS_K=0, LDS_V=NSLOT*SLOTB, LDS_WS=2*NSLOT*SLOTB, LDS_OST=LDS_WS+NW*64*4, LDS_C=LDS_OST+NW*4096, LDS_BYTES=LDS_C+SEQ*4;
__device__ __forceinline__ void glds16(const void*gsrc,unsigned lds_dst){unsigned keep;
  asm volatile("s_mov_b32 %0, m0\n\ts_mov_b32 m0, %2\n\ts_nop 0\n\tglobal_load_lds_dwordx4 %1, off\n\ts_mov_b32 m0, %0":"=&s"(keep):"v"(gsrc),"s"(lds_dst):"memory");}
__device__ __forceinline__ float max3f(float a,float b,float c){float r;asm("v_max3_f32 %0, %1, %2, %3":"=v"(r):"v"(a),"v"(b),"v"(c));return r;}
__device__ __forceinline__ float max2f(float a,float b){float r;asm("v_max_f32_e32 %0, %1, %2":"=v"(r):"v"(a),"v"(b));return r;}
__device__ __forceinline__ float fadd_s(float a,float b){float r;asm("v_add_f32_e32 %0, %1, %2":"=v"(r):"v"(a),"v"(b));return r;}
__device__ __forceinline__ float fsub_s(float a,float b){float r;asm("v_sub_f32_e32 %0, %1, %2":"=v"(r):"v"(a),"v"(b));return r;}
typedef float f32x2_t __attribute__((ext_vector_type(2))); typedef float f32x4_t __attribute__((ext_vector_type(4))); typedef __bf16 bf16x2_t __attribute__((ext_vector_type(2)));
__device__ __forceinline__ unsigned cvtpk_s(float lo,float hi){f32x2_t v={lo,hi};bf16x2_t b=__builtin_convertvector(v,bf16x2_t);return __builtin_bit_cast(unsigned,b);}
#define WAIT_BAR(N) asm volatile("s_waitcnt vmcnt(" #N ") lgkmcnt(0)\n\ts_barrier":::"memory")

__device__ __forceinline__ void qkt(f32x16&p0,f32x16&p1,const char*Kslot,const bf16x8*qr,int r32,int hi){
  const char*kb=Kslot+hi*1024+r32*16;
  #pragma unroll
  for(int d0=0;d0<4;++d0){
    const bf16x8 b0=*reinterpret_cast<const bf16x8*>(kb+d0*2048);
    const bf16x8 b1=*reinterpret_cast<const bf16x8*>(kb+d0*2048+512);
    p0=__builtin_amdgcn_mfma_f32_32x32x16_bf16(b0,qr[d0],p0,0,0,0);p1=__builtin_amdgcn_mfma_f32_32x32x16_bf16(b1,qr[d0],p1,0,0,0);}
}
typedef __attribute__((address_space(3))) const char* lds_cptr;
typedef short v4i16_t __attribute__((ext_vector_type(4)));
__device__ __forceinline__ void kload8(bf16x8*kf,lds_cptr kp){
  kf[0]=*(const __attribute__((address_space(3))) bf16x8*)(kp);      kf[1]=*(const __attribute__((address_space(3))) bf16x8*)(kp+512);
  kf[2]=*(const __attribute__((address_space(3))) bf16x8*)(kp+2048); kf[3]=*(const __attribute__((address_space(3))) bf16x8*)(kp+2560);
  kf[4]=*(const __attribute__((address_space(3))) bf16x8*)(kp+4096); kf[5]=*(const __attribute__((address_space(3))) bf16x8*)(kp+4608);
  kf[6]=*(const __attribute__((address_space(3))) bf16x8*)(kp+6144); kf[7]=*(const __attribute__((address_space(3))) bf16x8*)(kp+6656);
}
__device__ __forceinline__ void kload2(bf16x8*kf,lds_cptr kp,int j){ kf[2*j]=*(const __attribute__((address_space(3))) bf16x8*)(kp+j*2048); kf[2*j+1]=*(const __attribute__((address_space(3))) bf16x8*)(kp+j*2048+512); }
__device__ __forceinline__ s16x4 vtr(lds_cptr p){ return __builtin_bit_cast(s16x4,__builtin_amdgcn_ds_read_tr16_b64_v4i16((__attribute__((address_space(3))) v4i16_t*)p)); }
__device__ __forceinline__ float rowmax(const f32x16&p0,const f32x16&p1){
  float a=max3f(p0[0],p0[1],p1[0]),b=max3f(p0[2],p0[3],p1[1]);a=max3f(a,p1[2],p1[3]);
  #pragma unroll
  for(int r=4;r<16;r+=4){a=max3f(a,p0[r],p0[r+1]);b=max3f(b,p0[r+2],p0[r+3]);a=max3f(a,p1[r],p1[r+1]);b=max3f(b,p1[r+2],p1[r+3]);}
  const float m=max2f(a,b);
  auto rr=__builtin_amdgcn_permlane32_swap(__float_as_uint(m),__float_as_uint(m),false,false);
  return max2f(__uint_as_float(rr[0]),__uint_as_float(rr[1]));
}
__device__ __forceinline__ void pv(f32x16*o,int vb,bf16x8 pa0,bf16x8 pa1,bf16x8 pa2,bf16x8 pa3){
  #pragma unroll
  for(int d0=0;d0<2;++d0){s16x4 lo[4],hi[4];
    #pragma unroll
    for(int ks=0;ks<4;++ks){
      asm volatile("ds_read_b64_tr_b16 %0,%1 offset:%c2":"=&v"(lo[ks]):"v"(vb),"i"(d0*4096+ks*1024):"memory");
      asm volatile("ds_read_b64_tr_b16 %0,%1 offset:%c2":"=&v"(hi[ks]):"v"(vb),"i"(d0*4096+ks*1024+512):"memory");}
    asm volatile("s_waitcnt lgkmcnt(0)":::"memory");SBAR();
    #define PK(k) (bf16x8){lo[k][0],lo[k][1],lo[k][2],lo[k][3],hi[k][0],hi[k][1],hi[k][2],hi[k][3]}
    o[d0]=__builtin_amdgcn_mfma_f32_32x32x16_bf16(pa0,PK(0),o[d0],0,0,0);
    o[d0]=__builtin_amdgcn_mfma_f32_32x32x16_bf16(pa1,PK(1),o[d0],0,0,0);
    o[d0]=__builtin_amdgcn_mfma_f32_32x32x16_bf16(pa2,PK(2),o[d0],0,0,0);
    o[d0]=__builtin_amdgcn_mfma_f32_32x32x16_bf16(pa3,PK(3),o[d0],0,0,0);
    #undef PK
  }
}

#ifndef ATTN_STORE16
#define ATTN_STORE16(p,v) (*(u32x4*)(p)=(v))
#endif
template<int THRL,bool SWA> __device__ __forceinline__ void attn_unit(int tid,int b,int h,int qb,const bf16*Q,const bf16*__restrict__ K,const bf16*__restrict__ V,bf16*O,float sink2,char*shm){
  constexpr int DMK=SWA?256:DM;
  const int lane=tid&63,r32=lane&31,hi=lane>>5; const int wid=__builtin_amdgcn_readfirstlane(tid>>6);
  const long rowbase=(long)b*SEQ; const int q0=qb*QB;
  const bf16*Qw=Q+(rowbase+q0+wid*QBLK)*DM+h*D;
  const int TL=SWA?(qb?4*qb-2:0):0;
  const bf16*Kh=K+(rowbase+TL*KVBLK)*DMK+(SWA?(h>>2):h)*D,*Vh=V+(rowbase+TL*KVBLK)*DMK+(SWA?(h>>2):h)*D;
  const unsigned lds0=(unsigned)(uintptr_t)shm;
  float*wsf=(float*)(shm+LDS_WS)+wid*64;
  const bf16*ksrc=Kh+(long)lane*DMK+wid*8;
  const bf16*vsrc=Vh+(long)(16*(wid&3)+(lane>>2))*DMK+(wid>>2)*32+(lane&3)*8;
  const unsigned kdst=lds0+LDS_K+wid*1024, vdst=lds0+LDS_V+wid*1024;
  #define DMA_K(t,slot) glds16(ksrc+(long)(t)*KVBLK*DMK,(unsigned)__builtin_amdgcn_readfirstlane(kdst+(slot)))
  #define DMA_V(t,slot) glds16(vsrc+(long)(t)*KVBLK*DMK,(unsigned)__builtin_amdgcn_readfirstlane(vdst+(slot)))
  const int vb0=(int)(lds0+LDS_V)+((lane>>4)&1)*32+(lane&3)*8+(4*hi+((lane&15)>>2))*64;
  const char*Kbase=shm+LDS_K; bf16x8 kf[8];
  const lds_cptr shm3=(lds_cptr)shm; const lds_cptr kp0=shm3+LDS_K+hi*1024+r32*16; const lds_cptr vp0=shm3+LDS_V+((lane>>4)&1)*32+(lane&3)*8+(4*hi+((lane&15)>>2))*64;
  const int NT=(q0+QB)/KVBLK-TL;
  DMA_K(0,0);DMA_V(0,0);DMA_K(1,SLOTB);
  const lds_cptr cpl=(lds_cptr)shm+LDS_C+hi*16;
  bf16x8 qr[4];
  #pragma unroll
  for(int d0=0;d0<4;++d0)qr[d0]=*reinterpret_cast<const bf16x8*>(&Qw[(long)r32*DM+d0*16+hi*8]);
  float l_reg=(SWA&&hi==0)?1.f:0.f;f32x16 o[2];o[0]=f32x16{};o[1]=f32x16{};float bm=0.f;
  const int qrel=wid*QBLK+r32;
  #define CMASK(P0,P1,t) do{ if(SWA){ wmask(P0,P1,q0+qrel-(TL+(t))*KVBLK-4*hi); } else { int jb_=(t)-(NT-4); if(jb_>=0)cmask(P0,P1,jb_,qrel,hi); } }while(0)
  bool resc=false;
  #define START(P0,P1) do{ const float rm=rowmax(P0,P1); resc=false; \
    { const float dl=SWA?((__any(rm>(float)THRL))?__builtin_fmaxf(rm,0.f):0.f):rm; \
      _Pragma("unroll") for(int r=0;r<16;++r){P0[r]=fsub_s(P0[r],dl);P1[r]=fsub_s(P1[r],dl);} \
      bm=fsub_s(bm,dl); if(SWA)l_reg*=__builtin_amdgcn_exp2f(-dl); } \
    _Pragma("unroll") for(int r=0;r<16;++r)P0[r]=__builtin_amdgcn_exp2f(P0[r]); }while(0)
  #define RESC() do{ if(resc){ asm volatile("s_waitcnt lgkmcnt(0)":::"memory"); \
      _Pragma("unroll") for(int d_=0;d_<2;++d_) _Pragma("unroll") for(int r=0;r<16;++r)o[d_][r]*=wsf[crow(r,hi)]; } }while(0)
  typedef __attribute__((address_space(3))) const f32x4_t* lds_f4p;
  #define CPRE(X0,X1,tt) do{ if(!SWA){ const lds_cptr cp_=cpl+(tt)*256; _Pragma("unroll") for(int g_=0;g_<4;++g_){ const f32x4_t a_=*(lds_f4p)(cp_+32*g_), b_=*(lds_f4p)(cp_+128+32*g_); \
      X0[4*g_]=a_[0];X0[4*g_+1]=a_[1];X0[4*g_+2]=a_[2];X0[4*g_+3]=a_[3]; X1[4*g_]=b_[0];X1[4*g_+1]=b_[1];X1[4*g_+2]=b_[2];X1[4*g_+3]=b_[3]; } } }while(0)
  #define CFIN(X0,X1) do{ _Pragma("unroll") for(int r=0;r<16;++r){ if(SWA){X0[r]=bm;X1[r]=bm;} else {X0[r]=bm-X0[r];X1[r]=bm-X1[r];} } }while(0)
  f32x16 pA0,pA1,pB0,pB1;
  int sl_prev=0,sl_cur=0,sl_next=SLOTB;
  #define ROT() do{sl_prev=sl_cur;sl_cur=sl_next;sl_next=(sl_next==(NSLOT-1)*SLOTB)?0:sl_next+SLOTB;}while(0)
  DMA_K(2,2*SLOTB);
  WAIT_BAR(3);
  bm=SWA?-sink2:*(const __attribute__((address_space(3))) float*)((lds_cptr)shm+LDS_C+(q0+qrel)*4);
  CPRE(pA0,pA1,0); CFIN(pA0,pA1);
  qkt(pA0,pA1,Kbase,qr,r32,hi);asm volatile("s_nop 15\n\ts_nop 7":"+v"(pA0),"+v"(pA1));CMASK(pA0,pA1,0);
  START(pA0,pA1);
  CPRE(pB0,pB1,1);
  _Pragma("unroll") for(int r=0;r<16;++r)pA1[r]=__builtin_amdgcn_exp2f(pA1[r]);
  WAIT_BAR(0);
  DMA_K(3,0);DMA_V(1,SLOTB);
  ROT();
  kload8(kf,kp0+sl_cur);
  WAIT_BAR(2);
  s16x4 vlo[8],vhi[8]; u32x4 pw0,pw1,pw2,pw3;
  #define PKW(P,B) cvtpk_s(P[B],P[B+1])
  #define PAF(k) __builtin_bit_cast(bf16x8,pw##k)
  #define VFR(i) (bf16x8){vlo[i][0],vlo[i][1],vlo[i][2],vlo[i][3],vhi[i][0],vhi[i][1],vhi[i][2],vhi[i][3]}
  #define PIN(x) asm volatile("":"+v"(x))
  #define MX3(a,b,c) __builtin_fmaxf(__builtin_fmaxf((a),(b)),(c))
  #define GAPA(MF,A0,A1,A2,A3,W0,W1,PW) do{ MF; sacc+=A0; sacc+=A1; sacc+=A2; sacc+=A3; PIN(sacc); W0; W1; PIN(PW); SBAR(); }while(0)
  #define EX(v) __builtin_amdgcn_exp2f(v)
  #define GAPB(MF,X,B) do{ MF; X[B]=EX(X[B]); X[B+1]=EX(X[B+1]); X[B+2]=EX(X[B+2]); X[B+3]=EX(X[B+3]); PIN(X); SBAR(); }while(0)
  #define VRD(i) do{ vlo[i]=vtr(vp_+(((i)>>2)*4096+((i)&3)*1024)); vhi[i]=vtr(vp_+(((i)>>2)*4096+((i)&3)*1024+512)); }while(0)
  #define KRD(G,j) do{ if(G){ kload2(kf,kp0+sl_next,j); SBAR(); } }while(0)
  #define STEP(C0,C1,P0,P1,t,GK,GV,GL) do{ SBAR(); \
    CFIN(C0,C1); SBAR(); \
    const lds_cptr vp_=vp0+sl_prev; \
    VRD(0); SBAR(); float sacc=(P0[0]+P0[1]); \
    GAPA(C0=__builtin_amdgcn_mfma_f32_32x32x16_bf16(kf[0],qr[0],C0,0,0,0), P0[2],P0[3],P0[4],P0[5],     pw0[0]=PKW(P0,0), pw0[1]=PKW(P0,2), pw0); \
    VRD(4); SBAR(); GAPA(C1=__builtin_amdgcn_mfma_f32_32x32x16_bf16(kf[1],qr[0],C1,0,0,0), P0[6],P0[7],P0[8],P0[9],     pw0[2]=PKW(P0,4), pw0[3]=PKW(P0,6), pw0); \
    VRD(1); SBAR(); GAPA(C0=__builtin_amdgcn_mfma_f32_32x32x16_bf16(kf[2],qr[1],C0,0,0,0),   P0[10],P0[11],P0[12],P0[13], pw1[0]=PKW(P0,8), pw1[1]=PKW(P0,10), pw1); \
    VRD(5); SBAR(); GAPA(C1=__builtin_amdgcn_mfma_f32_32x32x16_bf16(kf[3],qr[1],C1,0,0,0),   P0[14],P0[15],P1[0],P1[1],   pw1[2]=PKW(P0,12),pw1[3]=PKW(P0,14), pw1); \
    VRD(2); SBAR(); GAPA(C0=__builtin_amdgcn_mfma_f32_32x32x16_bf16(kf[4],qr[2],C0,0,0,0),   P1[2],P1[3],P1[4],P1[5],     pw2[0]=PKW(P1,0), pw2[1]=PKW(P1,2), pw2); \
    VRD(6); SBAR(); GAPA(C1=__builtin_amdgcn_mfma_f32_32x32x16_bf16(kf[5],qr[2],C1,0,0,0),   P1[6],P1[7],P1[8],P1[9],     pw2[2]=PKW(P1,4), pw2[3]=PKW(P1,6), pw2); \
    VRD(3); SBAR(); GAPA(C0=__builtin_amdgcn_mfma_f32_32x32x16_bf16(kf[6],qr[3],C0,0,0,0),   P1[10],P1[11],P1[12],P1[13], pw3[0]=PKW(P1,8), pw3[1]=PKW(P1,10), pw3); \
    VRD(7); SBAR(); GAPA(C1=__builtin_amdgcn_mfma_f32_32x32x16_bf16(kf[7],qr[3],C1,0,0,0),   P1[14],P1[15],0.f,0.f,       pw3[2]=PKW(P1,12),pw3[3]=PKW(P1,14), pw3); \
    l_reg+=sacc; \
    if(GK){DMA_K((t)+3,sl_cur);} if(GV){DMA_V((t)+1,sl_next);} \
    CMASK(C0,C1,t); \
    { float a=MX3(C0[0],C0[1],C1[0]),b=MX3(C0[2],C0[3],C1[1]); a=MX3(a,C1[2],C1[3]); \
      _Pragma("unroll") for(int r=4;r<16;r+=4){a=MX3(a,C0[r],C0[r+1]);b=MX3(b,C0[r+2],C0[r+3]);a=MX3(a,C1[r],C1[r+1]);b=MX3(b,C1[r+2],C1[r+3]);} \
      float rm=__builtin_fmaxf(a,b); { auto rr=__builtin_amdgcn_permlane32_swap(__float_as_uint(rm),__float_as_uint(rm),false,false); rm=__builtin_fmaxf(__uint_as_float(rr[0]),__uint_as_float(rr[1])); } \
      resc=false; \
      if(__builtin_expect(__any(rm>(float)THRL),0)){ const float dl=__builtin_fmaxf(rm,0.f); \
        _Pragma("unroll") for(int r=0;r<16;++r){C0[r]-=dl;C1[r]-=dl;} \
        bm-=dl; \
        const float f=__builtin_amdgcn_exp2f(-dl); l_reg*=f; if(hi==0)wsf[r32]=f; resc=true; } } \
    SBAR(); \
    GAPB(o[0]=__builtin_amdgcn_mfma_f32_32x32x16_bf16(PAF(0),VFR(0),o[0],0,0,0), C0,0); \
    GAPB(o[1]=__builtin_amdgcn_mfma_f32_32x32x16_bf16(PAF(0),VFR(4),o[1],0,0,0), C0,4); \
    KRD(GL,0); GAPB(o[0]=__builtin_amdgcn_mfma_f32_32x32x16_bf16(PAF(1),VFR(1),o[0],0,0,0), C0,8); \
    KRD(GL,1); GAPB(o[1]=__builtin_amdgcn_mfma_f32_32x32x16_bf16(PAF(1),VFR(5),o[1],0,0,0), C0,12); \
    KRD(GL,2); GAPB(o[0]=__builtin_amdgcn_mfma_f32_32x32x16_bf16(PAF(2),VFR(2),o[0],0,0,0), C1,0); \
    KRD(GL,3); GAPB(o[1]=__builtin_amdgcn_mfma_f32_32x32x16_bf16(PAF(2),VFR(6),o[1],0,0,0), C1,4); \
    GAPB(o[0]=__builtin_amdgcn_mfma_f32_32x32x16_bf16(PAF(3),VFR(3),o[0],0,0,0), C1,8); \
    GAPB(o[1]=__builtin_amdgcn_mfma_f32_32x32x16_bf16(PAF(3),VFR(7),o[1],0,0,0), C1,12); \
    if(GL){ CPRE(P0,P1,(t)+1); SBAR(); } \
    }while(0)
  int t=1;
  #undef CMASK
  #define CMASK(P0,P1,t) do{}while(0)
  for(;t+5<NT;t+=2){
    STEP(pB0,pB1,pA0,pA1,t,true,true,true);     WAIT_BAR(2); RESC(); ROT();
    STEP(pA0,pA1,pB0,pB1,t+1,true,true,true);   WAIT_BAR(2); RESC(); ROT();
  }
  #undef CMASK
  #define CMASK(P0,P1,t) do{ if(SWA){ wmask(P0,P1,q0+qrel-(TL+(t))*KVBLK-4*hi); } else { int jb_=(t)-(NT-4); if(jb_>=0)cmask(P0,P1,jb_,qrel,hi); } }while(0)
  #define ENDW(tt) do{ if((tt)+3<NT){WAIT_BAR(2);} else if((tt)+2<NT){WAIT_BAR(1);} else {WAIT_BAR(0);} }while(0)
  for(;t+1<NT;t+=2){
    STEP(pB0,pB1,pA0,pA1,t,(t+3<NT),(t+1<NT),(t+1<NT));       ENDW(t);   RESC(); ROT();
    STEP(pA0,pA1,pB0,pB1,t+1,(t+4<NT),(t+2<NT),(t+2<NT));     ENDW(t+1); RESC(); ROT();
  }
  STEP(pB0,pB1,pA0,pA1,NT-1,false,false,false); RESC();
  { float sacc=pB0[0]+pB0[1]; _Pragma("unroll") for(int r=2;r<16;++r)sacc+=pB0[r]; _Pragma("unroll") for(int r=0;r<16;++r)sacc+=pB1[r]; l_reg+=sacc;
    pw0=(u32x4){PKW(pB0,0),PKW(pB0,2),PKW(pB0,4),PKW(pB0,6)};pw1=(u32x4){PKW(pB0,8),PKW(pB0,10),PKW(pB0,12),PKW(pB0,14)};pw2=(u32x4){PKW(pB1,0),PKW(pB1,2),PKW(pB1,4),PKW(pB1,6)};pw3=(u32x4){PKW(pB1,8),PKW(pB1,10),PKW(pB1,12),PKW(pB1,14)};
    SBAR(); pv(o,vb0+sl_cur,PAF(0),PAF(1),PAF(2),PAF(3)); }
  #undef PKW
  #undef PAF
  #undef VFR
  #undef PIN
  #undef MX3
  #undef GAPA
  #undef GAPB
  #undef EX
  #undef VRD
  #undef KRD
  #undef STEP
  #undef ENDW
  {auto rr=__builtin_amdgcn_permlane32_swap(__float_as_uint(l_reg),__float_as_uint(l_reg),false,false);l_reg=__uint_as_float(rr[0])+__uint_as_float(rr[1]);}
  if(hi==0)wsf[32+r32]=l_reg;asm volatile("s_waitcnt lgkmcnt(0)":::"memory");
  float rli[16];
  #pragma unroll
  for(int r=0;r<16;++r)rli[r]=__builtin_amdgcn_rcpf(wsf[32+crow(r,hi)]);
  bf16*Ow=O+(rowbase+q0+wid*QBLK)*DM+h*D;
  { bf16*stg=(bf16*)(shm+LDS_OST)+wid*2048;
    #pragma unroll
    for(int r=0;r<16;++r){const int orow=crow(r,hi);
      #pragma unroll
      for(int d0=0;d0<2;++d0)stg[orow*64+d0*32+r32]=(bf16)f2bf(o[d0][r]*rli[r]);}
    asm volatile("s_waitcnt lgkmcnt(0)":::"memory");
    #pragma unroll
    for(int i=0;i<4;++i){const int row=i*8+(lane>>3),ch=lane&7; const u32x4 v=*(const u32x4*)(stg+row*64+ch*8); ATTN_STORE16(Ow+(long)row*DM+ch*8,v);} }
  asm volatile("s_waitcnt lgkmcnt(0)\n\ts_barrier":::"memory");
  #undef DMA_K
  #undef DMA_V
  #undef CMASK
  #undef START
  #undef RESC
  #undef ROT
  #undef CPRE
  #undef CFIN
}
constexpr int ATTN_LDS_BYTES=LDS_BYTES;
struct AttnTensors { const bf16* Q; const bf16* K; const bf16* V; bf16* O; };
struct AttnUnit { int bh; int qb; };
struct StaticOrder {
  int vcu;
  __device__ __forceinline__ explicit StaticOrder(int grid,int block):vcu((grid%8==0)?(block%8)*(grid/8)+block/8:block){}
  __device__ __forceinline__ bool next(int i,AttnUnit&u)const{ if(i>=4)return false; const int s=vcu&1; u.bh=vcu>>1; u.qb=(i==0)?7-s:(i==1)?s:(i==2)?4+s:3-s; return u.bh<BATCH*NHEAD; }
};
__device__ __forceinline__ void scan_to_lds(int tid,const float*__restrict__ LGrow,char*shm){
  const int lane=tid&63; const int wid=__builtin_amdgcn_readfirstlane(tid>>6);
  const f32x4_t v=*(const f32x4_t*)(LGrow+tid*4);
  const float p0=v[0],p1=p0+v[1],p2=p1+v[2],p3=p2+v[3]; float inc=p3;
  #pragma unroll
  for(int o=1;o<64;o<<=1){const float u=__shfl_up(inc,o); if(lane>=o)inc+=u;}
  __attribute__((address_space(3))) float*ws=(__attribute__((address_space(3))) float*)((lds_cptr)shm+LDS_WS);
  if(lane==63)ws[wid]=inc;
  asm volatile("s_waitcnt lgkmcnt(0)\n\ts_barrier":::"memory");
  float base=inc-p3;
  #pragma unroll
  for(int w=0;w<NW-1;++w){const float t=ws[w]; if(w<wid)base+=t;}
  const float L2E=1.4426950408889634f;
  *(__attribute__((address_space(3))) f32x4_t*)((lds_cptr)shm+LDS_C+tid*16)=(f32x4_t){(base+p0)*L2E,(base+p1)*L2E,(base+p2)*L2E,(base+p3)*L2E};
  asm volatile("s_waitcnt lgkmcnt(0)\n\ts_barrier":::"memory");
}
template<class Sched,bool SWA,int THRL=8> __device__ __forceinline__ void attn_phase(int tid,char*lds,const AttnTensors&T,const float*LG,const float*sinks,const Sched&S){
  AttnUnit u;
  if(!SWA){ if(S.next(0,u)) scan_to_lds(tid,LG+(size_t)u.bh*SEQ,lds); }
  for(int i=0;S.next(i,u);++i){ attn_unit<THRL,SWA>(tid,u.bh/NHEAD,u.bh%NHEAD,u.qb,T.Q,T.K,T.V,T.O,SWA?sinks[u.bh%NHEAD]*1.4426950408889634f:0.f,lds); }
}
#undef SBAR
#undef WAIT_BAR
}

__device__ __forceinline__ void p_attn_fox8(const Ctx& C) {
    const fox::AttnTensors AT{(const fox::bf16*)C.Q(), (const fox::bf16*)C.Kb(), (const fox::bf16*)C.Vb(), (fox::bf16*)C.Q()};
    const fox::StaticOrder S(C.nwg, C.wg);
    fox::attn_phase<fox::StaticOrder, false>(C.tid, C.ldsg, AT, (const float*)(C.ws + WS_LG), nullptr, S);
}
__device__ __forceinline__ void p_attn_swa8(const Ctx& C, int layer) {
    const fox::AttnTensors AT{(const fox::bf16*)C.Q(), (const fox::bf16*)C.Kb(), (const fox::bf16*)C.Vb(), (fox::bf16*)C.Q()};
    const fox::StaticOrder S(C.nwg, C.wg);
    fox::attn_phase<fox::StaticOrder, true>(C.tid, C.ldsg, AT, nullptr, C.swa_sinks + (layer >> 1) * 16, S);
}
__device__ __forceinline__ void p_router(const Ctx& C, int layer) {
    const float* st = C.stats(2 * layer); const bf16* Z = C.Z(); const bf16* WR = (const bf16*)(C.ws + WS_WR) + (size_t)layer * 16 * 1024;
    const float* cs = C.vec(V_RT_CS) + layer * 16; const float* cb = C.vec(V_RT_CB) + layer * 16;
    LAS float* lg = (LAS float*)(C.lds + C.wave * 1280);
    LAS int* hist = (LAS int*)(C.lds + 16384); LAS int* base = hist + 32;
    unsigned* gcnt = C.ctl() + CW_CNT + 64 * NCLS * layer; int* cls_o = C.cls(); f32x2* gates = C.gates(); int* list = C.list();
    const int lane = C.lane, lr = lane & 15, lq = lane >> 4;
    for (int blk = C.wg; blk < M / 64; blk += C.nwg) {
        if (C.tid < 32) hist[C.tid] = 0;
        __syncthreads();
        int tok = -1, cl = 0, lslot = 0;
        const f32x4 acc = thin64(C, Z, blk * 64, WR);
        if (C.wave < 4) {
            const int r0 = blk * 64 + C.wave * 16;
            const float csv = cs[lr], cbv = cb[lr] + C.b_router[lr];
#pragma unroll
            for (int rg = 0; rg < 4; ++rg) { const int row = 4 * lq + rg; const f32x2 ms = row_stats(st, r0 + row); lg[row * 17 + lr] = ms.y * (acc[rg] - ms.x * csv) + cbv; }
            LDS_WAIT(); asm volatile("" ::: "memory");
            if (lane < 16) {
                float l[16], mx = -INFINITY;
#pragma unroll
                for (int e = 0; e < 16; ++e) { l[e] = lg[lane * 17 + e]; mx = fmaxf(mx, l[e]); }
#pragma unroll
                for (int e = 0; e < 16; ++e) l[e] = __builtin_amdgcn_exp2f((l[e] - mx) * LOG2E);
                float gs[4];
#pragma unroll
                for (int g = 0; g < 4; ++g) { const float a0 = l[4 * g], a1 = l[4 * g + 1], a2 = l[4 * g + 2], a3 = l[4 * g + 3];
                    gs[g] = fmaxf(fmaxf(fmaxf(a0 + a1, a0 + a2), fmaxf(a0 + a3, a1 + a2)), fmaxf(a1 + a3, a2 + a3)); }
                int best = 0; float bv = gs[0];
#pragma unroll
                for (int g = 1; g < 4; ++g) if (gs[g] > bv) { bv = gs[g]; best = g; }
                float a[4];
#pragma unroll
                for (int k = 0; k < 4; ++k) a[k] = best == 0 ? l[k] : (best == 1 ? l[4 + k] : (best == 2 ? l[8 + k] : l[12 + k]));
                int i1 = 0; float v1 = a[0];
#pragma unroll
                for (int k = 1; k < 4; ++k) if (a[k] > v1) { v1 = a[k]; i1 = k; }
                int i2 = -1; float v2 = -1.f;
#pragma unroll
                for (int k = 0; k < 4; ++k) if (k != i1 && a[k] > v2) { v2 = a[k]; i2 = k; }
                const int lo = i1 < i2 ? i1 : i2, hi = i1 < i2 ? i2 : i1;
                const int pidx = lo == 0 ? hi - 1 : (lo == 1 ? hi + 1 : 5);
                const float inv = 1.f / (v1 + v2), g1 = v1 * inv, g2 = v2 * inv;
                cl = best * 6 + pidx; tok = r0 + lane;
                cls_o[tok] = cl; gates[tok] = i1 < i2 ? (f32x2){g1, g2} : (f32x2){g2, g1};
                lslot = atomicAdd((int*)(hist + cl), 1);
            }
        }
        __syncthreads();
        if (C.tid < NCLS) base[C.tid] = (int)atomicAdd(gcnt + 64 * C.tid, (unsigned)hist[C.tid]);
        __syncthreads();
        if (tok >= 0) list[cl * M + base[cl] + lslot] = tok;
        __syncthreads();
    }
}
__device__ __forceinline__ int cls_layout(const Ctx& C, int layer, LAS int* cbase  , LAS int* ccnt  ) {
    const unsigned* gcnt = C.ctl() + CW_CNT + 64 * NCLS * layer;
    if (C.tid < NCLS) ccnt[C.tid] = (int)__hip_atomic_load(gcnt + 64 * C.tid, RLX_AGENT);
    __syncthreads();
    if (C.tid <= NCLS) { int acc = 0;
#pragma unroll 1
        for (int c = 0; c < C.tid; ++c) acc += (ccnt[c] + 255) & ~255;
        cbase[C.tid] = acc; }
    __syncthreads();
    return cbase[NCLS];
}
__device__ __forceinline__ void p_proj8(const Ctx& C, int layer) {
    const int j = layer >> 1; const bool fox = layer & 1;
    const float* st = layer ? C.stats(2 * (layer - 1) + 1) : nullptr;
    const float* cs = C.vec(V_PROJ_CS) + layer * FOX_NALL; const float* cb = C.vec(V_PROJ_CB) + layer * FOX_NALL;
    const bf16* Z = C.Z();
    const bf16* W = fox ? (const bf16*)(C.ws + WS_WIN_FOX) + (size_t)j * FOX_N * 1024 : (const bf16*)(C.ws + WS_WIN_SWA) + (size_t)j * SWA_N * 1024;
    const int N = fox ? FOX_N : SWA_N;
    { pg8::ProbPlain P{Z, W, M / 256, N / 256, C.nwg, C.wg}; pg8::EpiProj E{fox, st, cs, cb, (const float*)(C.ws + WS_ROPE), C.Q()}; pg8::gemm_phase(C, P, E); }
    if (fox) {
        const bf16* WF = (const bf16*)(C.ws + WS_WF) + (size_t)j * 16 * 1024; float* LG = (float*)(C.ws + WS_LG);
        const int lr = C.lane & 15, lq = C.lane >> 4;
        for (int blk = C.wg; blk < M / 64; blk += C.nwg) {
            const f32x4 acc = thin64(C, Z, blk * 64, WF);
            if (C.wave < 4) {
                const int r0 = blk * 64 + C.wave * 16;
                const float bf_ = C.fox_b_f[j * 16 + lr], csv = cs[FOX_N + lr], cbv = cb[FOX_N + lr];
                f32x4 o;
#pragma unroll
                for (int rg = 0; rg < 4; ++rg) { const int r = r0 + 4 * lq + rg; const f32x2 ms = row_stats(st, r);
                    const float xg = ms.y * (acc[rg] - ms.x * csv) + cbv + bf_;
                    o[rg] = fminf(xg, 0.f) - 0.6931471805599453f * __builtin_amdgcn_logf(1.f + __builtin_amdgcn_exp2f(-fabsf(xg) * LOG2E)); }
                const int b = r0 / S, s = (r0 % S) + 4 * lq;
                *(f32x4*)(LG + (size_t)(b * 16 + lr) * S + s) = o;
            }
        }
    }
}
__device__ __forceinline__ void p_oproj8(const Ctx& C, int layer) {
    const float* stp = layer ? C.stats(2 * (layer - 1) + 1) : nullptr;
    const float* gp = layer ? C.ln_g + ((layer - 1) * 2 + 1) * 1024 : nullptr; const float* bp = layer ? C.ln_b + ((layer - 1) * 2 + 1) * 1024 : nullptr;
    pg8::ProbPlain P{C.Q(), (const bf16*)(C.ws + WS_WO) + (size_t)layer * 1024 * 1024, M / 256, D / 256, C.nwg, C.wg};
    pg8::EpiOut E{stp, gp, bp, C.Z(), C.stats(2 * layer)};
    pg8::gemm_phase(C, P, E);
}
__device__ __forceinline__ void p_moe_up8(const Ctx& C, int layer) {
    LAS int* cbase = (LAS int*)(C.lds + pg8::LDS_CLS); LAS int* ccnt = cbase + 32;
    const int rows = cls_layout(C, layer, cbase, ccnt);
    pg8::ProbUp P{C.Z(), (const bf16*)(C.ws + WS_WGU) + (size_t)layer * 16 * 512 * 1024, C.list(), cbase, ccnt, rows / 256, C.nwg, C.wg};
    pg8::EpiUp E{C.stats(2 * layer), C.list(), C.gates(), C.vec(V_GU_CS) + layer * 16 * 512, C.vec(V_GU_CB) + layer * 16 * 512, C.ACT()};
    pg8::gemm_phase(C, P, E);
}
__device__ __forceinline__ void p_moe_down8(const Ctx& C, int layer) {
    LAS int* cbase = (LAS int*)(C.lds + pg8::LDS_CLS); LAS int* ccnt = cbase + 32;
    const int rows = cls_layout(C, layer, cbase, ccnt);
    pg8::ProbDown P{C.ACT(), (const bf16*)(C.ws + WS_WD) + (size_t)layer * 16 * 1024 * 256, cbase, ccnt, rows / 256, C.nwg, C.wg};
    pg8::EpiDown E{C.stats(2 * layer), C.ln_g + (layer * 2) * 1024, C.ln_b + (layer * 2) * 1024, C.list(), C.Z(), C.stats(2 * layer + 1)};
    pg8::gemm_phase(C, P, E);
}
__device__ __forceinline__ void p_final(const Ctx& C) {
    const float* st = C.stats(7); const float* g = C.ln_g + 7 * 1024; const float* b = C.ln_b + 7 * 1024; const bf16* Z = C.Z();
#if PROBE_MASK
    const float pscale = 1.f + 0.1f * sqrtf(__hip_atomic_load((const float*)(C.ctl() + CW_PROBE), RLX_AGENT));
#else
    const float pscale = 1.f;
#endif
    for (int r = C.gw; r < M; r += C.ngw) {
        f32x2 ms = row_stats(st, r); ms.y *= pscale;
#pragma unroll
        for (int u = 0; u < 2; ++u) { const int c0 = u * 512 + C.lane * 8; const bf16x8 a = *(const bf16x8*)(Z + (size_t)r * D + c0);
            const f32x4 g0 = *(const f32x4*)(g + c0), g1 = *(const f32x4*)(g + c0 + 4), b0 = *(const f32x4*)(b + c0), b1 = *(const f32x4*)(b + c0 + 4);
            f32x4 o0, o1;
#pragma unroll
            for (int e = 0; e < 4; ++e) { o0[e] = (bf2f((bf16)a[e]) - ms.x) * ms.y * g0[e] + b0[e]; o1[e] = (bf2f((bf16)a[4 + e]) - ms.x) * ms.y * g1[e] + b1[e]; }
            *(f32x4*)(C.out + (size_t)r * D + c0) = o0; *(f32x4*)(C.out + (size_t)r * D + c0 + 4) = o1; }
    }
}

__device__ __forceinline__ int fresh_lane() { int l; asm volatile("v_mbcnt_lo_u32_b32 %0, -1, 0\n\tv_mbcnt_hi_u32_b32 %0, -1, %0" : "=v"(l)); return l; }
enum { K_PROLOGUE = 0, K_PROJ, K_ATTN, K_OPROJ, K_ROUTER, K_UP, K_DOWN, K_FINAL };
constexpr int N_PHASES = 1 + DEPTH * 6 + 1;
__device__ __forceinline__ void phase_of(int ph, int& kind, int& layer) {
    if (ph == 0) { kind = K_PROLOGUE; layer = 0; return; }
    if (ph == N_PHASES - 1) { kind = K_FINAL; layer = 0; return; }
    layer = (ph - 1) / 6; kind = K_PROJ + (ph - 1) % 6;
}
__global__ void __launch_bounds__(NWAVES * 64, 2) mk_fwd(Args args) {
    extern __shared__ __attribute__((aligned(16))) unsigned char lds_raw[];
    const int tid0 = threadIdx.x;
#define BUILD_CTX(C, ap) Ctx C; C.x = ap->in[0]; C.ln_g = ap->in[1]; C.ln_b = ap->in[2]; C.swa_w_in = ap->in[3]; C.swa_sinks = ap->in[4]; C.swa_w_o = ap->in[5]; C.fox_w_in = ap->in[6]; \
    C.fox_b_f = ap->in[7]; C.fox_w_o = ap->in[8]; C.w_router = ap->in[9]; C.b_router = ap->in[10]; C.w_gate = ap->in[11]; C.w_up = ap->in[12]; C.w_down = ap->in[13]; \
    C.out = ap->out; C.ws = ap->ws; C.lds = (LAS unsigned char*)lds_raw; C.ldsg = (char*)lds_raw; \
    C.tid = tidv; C.lane = C.tid & 63; C.wave = __builtin_amdgcn_readfirstlane(C.tid >> 6); C.wg = wgv; C.nwg = gridDim.x; C.gw = C.wg * NWAVES + C.wave; C.ngw = C.nwg * NWAVES;
    LAS unsigned char* const lds0 = (LAS unsigned char*)lds_raw;
    volatile LAS unsigned* MISC = (volatile LAS unsigned*)(lds0 + MISC_OFF);
    if (tid0 < 32) MISC[tid0] = 0u;
    __syncthreads();
    unsigned* const ctl0 = (unsigned*)(args.ws + WS_CTL);
    XcdBarrier bar; bar.bar = ctl0 + CW_BAR; bar.x = 0; bar.st = nullptr;
    const bool one = (args.ph_hi - args.ph_lo) > 1;
    const int waveS = __builtin_amdgcn_readfirstlane(tid0 >> 6);
#define FRESH_TID() (waveS * 64 + fresh_lane())
    if (one) bar = xcd_barrier_post(ctl0 + CW_BAR, MISC + 8, tid0);
#if PROBE_MASK
    volatile LAS unsigned long long* PRB = (volatile LAS unsigned long long*)(lds0 + MISC_OFF + 64);
    if (blockIdx.x == 0 && tid0 == 0) { const unsigned long long t = __builtin_amdgcn_s_memrealtime(); PRB[0] = t; PRB[1] = t; PRB[2] = 0; }
#endif
    for (int ph = args.ph_lo; ph < args.ph_hi; ++ph) {
#define RUN(body) do { const __attribute__((address_space(4))) Args* ap = (const __attribute__((address_space(4))) Args*)__builtin_amdgcn_kernarg_segment_ptr(); int tidv = FRESH_TID(); int wgv = blockIdx.x; asm volatile("" : "+s"(ap), "+s"(wgv)); asm volatile("" : "+v"(tidv)); BUILD_CTX(C, ap) body; } while (0)
#define CASE(k, body) do { int ph_ = ph; asm volatile("" : "+s"(ph_)); int kind, layer; phase_of(ph_, kind, layer); (void)layer; if (kind == (k)) { body; } } while (0)
        CASE(K_PROLOGUE, RUN(p_prologue(C)));
        CASE(K_PROJ, RUN(p_proj8(C, layer)));
        CASE(K_ATTN, if (layer & 1) RUN(p_attn_fox8(C)); else RUN(p_attn_swa8(C, layer)));
        CASE(K_OPROJ, RUN(p_oproj8(C, layer)));
        CASE(K_ROUTER, RUN(p_router(C, layer)));
        CASE(K_UP, RUN(p_moe_up8(C, layer)));
        CASE(K_DOWN, RUN(p_moe_down8(C, layer)));
        CASE(K_FINAL, RUN(p_final(C)));
#if PROBE_MASK
        if (ph + 2 == args.ph_hi && blockIdx.x == 0 && FRESH_TID() == 0) {
            const unsigned long long now = __builtin_amdgcn_s_memrealtime(); int kind, layer; phase_of(ph, kind, layer);
            unsigned long long sel = PRB[2]; if (PROBE_HIT(kind, layer)) sel += now - PRB[1];
            const float frac = (float)sel / (float)(now - PRB[0]);
            __hip_atomic_store((float*)(ctl0 + CW_PROBE), frac, __ATOMIC_RELAXED, __HIP_MEMORY_SCOPE_AGENT);
        }
#endif
        if (ph + 1 < args.ph_hi) xcd_barrier(bar, FRESH_TID());
#if PROBE_MASK
        if (blockIdx.x == 0 && FRESH_TID() == 0) { const unsigned long long now = __builtin_amdgcn_s_memrealtime(); int kind, layer; phase_of(ph, kind, layer); if (PROBE_HIT(kind, layer)) PRB[2] = PRB[2] + (now - PRB[1]); PRB[1] = now; }
#endif
    }
}

extern "C" void kernel_launch(void* const* d_in, const int* in_sizes, int n_in, void* d_out, int out_size, void* d_ws, size_t ws_size, hipStream_t stream) {
    static int grid = 0;
    if (grid == 0) {
        if (n_in != 14 || in_sizes[0] != M * D || out_size != M * D || ws_size < WS_END) { fprintf(stderr, "kernel_launch: unexpected shapes / workspace (n_in %d, ws %zu)\n", n_in, ws_size); grid = -1; return; }
        int dev = 0, cus = 0, per_cu = 0;
        if (hipGetDevice(&dev) != hipSuccess || hipDeviceGetAttribute(&cus, hipDeviceAttributeMultiprocessorCount, dev) != hipSuccess) { grid = -1; return; }
        if (hipFuncSetAttribute((const void*)mk_fwd, hipFuncAttributeMaxDynamicSharedMemorySize, LDS_BYTES) != hipSuccess) { fprintf(stderr, "kernel_launch: hipFuncSetAttribute failed\n"); grid = -1; return; }
        if (hipOccupancyMaxActiveBlocksPerMultiprocessor(&per_cu, (const void*)mk_fwd, NWAVES * 64, LDS_BYTES) != hipSuccess || per_cu < 1) { fprintf(stderr, "kernel_launch: occupancy query says %d\n", per_cu); per_cu = 1; }
        (void)hipGetLastError();
        grid = cus * 1;
    }
    if (grid < 0) return;
    (void)hipMemsetAsync((char*)d_ws + WS_CTL, 0, CTL_BYTES, stream);
    Args a{};
    for (int i = 0; i < 14; ++i) a.in[i] = (const float*)d_in[i];
    a.out = (float*)d_out; a.ws = (unsigned char*)d_ws;
#if MK_ONE_LAUNCH
    a.ph_lo = 0; a.ph_hi = N_PHASES;
    hipLaunchKernelGGL(mk_fwd, dim3(grid), dim3(NWAVES * 64), LDS_BYTES, stream, a);
#else
    for (int ph = 0; ph < N_PHASES; ++ph) { a.ph_lo = ph; a.ph_hi = ph + 1; hipLaunchKernelGGL(mk_fwd, dim3(grid), dim3(NWAVES * 64), LDS_BYTES, stream, a); }
#endif
}
```
